# Optimizing an MI355X kernel written in HIP

```python
import jax
import jax.numpy as jnp
from jax import lax
import numpy as np

D_MODEL = 1024
BATCH = 8
SEQ = 4096
DEPTH = 2

GRID_W = 64
CTX_LEN = 256

NA_HEADS = 8
NA_HEAD_DIM = 64
NA_WIDTH = NA_HEADS * NA_HEAD_DIM
NA_WIN_ROWS = 8
NA_WIN_COLS = 16
FNET_GROUPS = 4
FNET_GROUP_DIM = 128
FNET_WIDTH = FNET_GROUPS * FNET_GROUP_DIM
RET_HEADS = 4
RET_QK_DIM = 128
RET_V_DIM = 256
RET_QK_WIDTH = RET_HEADS * RET_QK_DIM
RET_V_WIDTH = RET_HEADS * RET_V_DIM
RET_CHUNK = 128
ROPE_BASE = 10000.0

N_BRANCHES = 3
IN_SPLITS = (NA_WIDTH, NA_WIDTH, NA_WIDTH, FNET_WIDTH, RET_QK_WIDTH, RET_QK_WIDTH, RET_V_WIDTH, RET_V_WIDTH, N_BRANCHES * D_MODEL)
IN_WIDTH = sum(IN_SPLITS)

N_EXPERTS = 256
TOP_K = 8
N_GROUPS = 8
TOPK_GROUPS = 4
EXPERTS_PER_GROUP = N_EXPERTS // N_GROUPS
EXPERT_DIM = 256
SHARED_DIM = 256
ROUTED_SCALE = 2.5
MOE_BLOCK = 128

DN_ALPHA = (2.0 * DEPTH) ** 0.25
DN_BETA = (8.0 * DEPTH) ** -0.25
LN_EPS = 1e-6
GN_EPS = 1e-5

kernel_name = 'hybrid_natten_fnet_retention_moe_dit'


def layer_norm(x, w=None, b=None):
    xf = x.astype(jnp.float32)
    mu = jnp.mean(xf, axis=-1, keepdims=True)
    var = jnp.mean(jnp.square(xf - mu), axis=-1, keepdims=True)
    y = (xf - mu) * lax.rsqrt(var + LN_EPS)
    if w is not None:
        y = y * w.astype(jnp.float32) + b.astype(jnp.float32)
    return y.astype(x.dtype)


def modulate(x, shift, scale):
    return layer_norm(x) * (1.0 + scale) + shift


def swiglu(x, w_gate, w_up, w_down):
    return (jax.nn.silu(x @ w_gate) * (x @ w_up)) @ w_down


def split_heads(t, n_heads):
    return t.reshape(t.shape[0], t.shape[1], n_heads, -1)


def axial_rope(t, row, col):
    half = t.shape[-1] // 2
    n_pairs = half // 2
    inv_freq = ROPE_BASE ** (-jnp.arange(n_pairs, dtype=jnp.float32) / n_pairs)

    def rotate(u, pos):
        ang = pos.astype(jnp.float32)[:, None] * inv_freq[None, :]
        cos = jnp.cos(ang)[None, :, None, :].astype(u.dtype)
        sin = jnp.sin(ang)[None, :, None, :].astype(u.dtype)
        u1, u2 = u[..., :n_pairs], u[..., n_pairs:]
        return jnp.concatenate([u1 * cos - u2 * sin, u1 * sin + u2 * cos], axis=-1)

    return jnp.concatenate([rotate(t[..., :half], row), rotate(t[..., half:], col)], axis=-1)


def neighbourhood_attention(q, k, v, k_ctx, v_ctx, rpb, rows):
    B, N, H, Dh = q.shape
    kh = min(NA_WIN_ROWS, rows)
    scale = Dh ** -0.5
    q = q.reshape(B, rows, GRID_W, H, Dh)
    k = k.reshape(B, rows, GRID_W, H, Dh)
    v = v.reshape(B, rows, GRID_W, H, Dh)
    r = jnp.arange(rows)
    r0 = jnp.clip(r - kh // 2, 0, rows - kh)
    key_rows = r0[:, None] + jnp.arange(kh)[None, :]
    k_band = k[:, key_rows]
    v_band = v[:, key_rows]
    cidx = jnp.arange(GRID_W)
    c0 = jnp.clip(cidx - NA_WIN_COLS // 2, 0, GRID_W - NA_WIN_COLS)
    col_ok = (cidx[None, :] >= c0[:, None]) & (cidx[None, :] < c0[:, None] + NA_WIN_COLS)
    dr = key_rows - r[:, None] + (NA_WIN_ROWS - 1)
    dc = jnp.clip(cidx[None, :] - cidx[:, None], -(NA_WIN_COLS - 1), NA_WIN_COLS - 1) + (NA_WIN_COLS - 1)
    bias = rpb[:, dr[:, None, :, None], dc[None, :, None, :]].astype(jnp.float32)
    s_win = jnp.einsum('brqhd,brkwhd->bhrqkw', q, k_band).astype(jnp.float32) * scale + bias[None]
    s_win = jnp.where(col_ok[:, None, :], s_win, -jnp.inf)
    s_ctx = jnp.einsum('brqhd,blhd->bhrql', q, k_ctx).astype(jnp.float32) * scale
    n_win = kh * GRID_W
    s = jnp.concatenate([s_win.reshape(B, H, rows, GRID_W, n_win), s_ctx], axis=-1)
    p = jax.nn.softmax(s, axis=-1).astype(v.dtype)
    p_win = p[..., :n_win].reshape(B, H, rows, GRID_W, kh, GRID_W)
    p_ctx = p[..., n_win:]
    o = jnp.einsum('bhrqkw,brkwhd->brqhd', p_win, v_band) + jnp.einsum('bhrql,blhd->brqhd', p_ctx, v_ctx)
    return o.reshape(B, N, H * Dh)


def context_attention(q, k, v):
    B, L, H, Dh = q.shape
    s = jnp.einsum('blhd,bmhd->bhlm', q, k).astype(jnp.float32) * (Dh ** -0.5)
    p = jax.nn.softmax(s, axis=-1).astype(v.dtype)
    return jnp.einsum('bhlm,bmhd->blhd', p, v).reshape(B, L, H * Dh)


def fourier_mix(u):
    B, N, _ = u.shape
    ug = u.reshape(B, N, FNET_GROUPS, FNET_GROUP_DIM).astype(jnp.float32)
    f = jnp.fft.fft2(ug, axes=(1, 3), norm='ortho').real
    return f.reshape(B, N, FNET_WIDTH).astype(u.dtype)


def retention_chunkwise(q, k, v, log_g, s0, inclusive):
    B, H, N, Dk = q.shape
    Dv = v.shape[-1]
    C = RET_CHUNK
    nc = N // C
    qc = q.astype(jnp.float32).reshape(B, H, nc, C, Dk)
    kc = k.astype(jnp.float32).reshape(B, H, nc, C, Dk)
    vc = v.astype(jnp.float32).reshape(B, H, nc, C, Dv)
    lg = log_g.astype(jnp.float32)[:, None]
    pos = jnp.arange(C, dtype=jnp.float32)
    diff = pos[:, None] - pos[None, :]
    in_band = (diff >= 0) if inclusive else (diff > 0)
    decay_in = jnp.where(in_band, jnp.exp(lg[:, :, None] * jnp.maximum(diff, 0.0)), 0.0)
    scores = jnp.einsum('bhncd,bhnmd->bhncm', qc, kc) * decay_in[None, :, None]
    o_inner = jnp.einsum('bhncm,bhnme->bhnce', scores, vc)
    k_decay = jnp.exp(lg * (C - 1 - pos))
    q_decay = jnp.exp(lg * (pos + 1))
    chunk_decay = jnp.exp(lg[:, 0] * C)[None, :, None, None]
    kv = jnp.einsum('bhnmd,bhnme->nbhde', kc * k_decay[None, :, None, :, None], vc)

    def step(state, kv_chunk):
        return chunk_decay * state + kv_chunk, state

    s_final, s_prev = lax.scan(step, s0.astype(jnp.float32), kv)
    o_cross = jnp.einsum('bhncd,nbhde->bhnce', qc * q_decay[None, :, None, :, None], s_prev)
    return (o_inner + o_cross).reshape(B, H, N, Dv), s_final


def bidirectional_retention(q, k, v, log_g_fwd, log_g_bwd, s0_fwd, s0_bwd):
    o_f, s_f = retention_chunkwise(q, k, v, log_g_fwd, s0_fwd, True)
    o_b, s_b = retention_chunkwise(q[:, :, ::-1], k[:, :, ::-1], v[:, :, ::-1], log_g_bwd, s0_bwd, False)
    return o_f + o_b[:, :, ::-1], s_f, s_b


def retention_output(o, gate, gn_w):
    B, H, N, Dv = o.shape
    mu = jnp.mean(o, axis=-1, keepdims=True)
    var = jnp.mean(jnp.square(o - mu), axis=-1, keepdims=True)
    y = ((o - mu) * lax.rsqrt(var + GN_EPS)).transpose(0, 2, 1, 3).reshape(B, N, H * Dv)
    y = y * gn_w.astype(jnp.float32)
    return y.astype(gate.dtype) * jax.nn.silu(gate)


def merge_branches(gate_logits, y_na, y_fn, y_ret, w_o_na, w_fourier, w_o_ret, w_out):
    gates = jax.nn.sigmoid(gate_logits.reshape(gate_logits.shape[0], gate_logits.shape[1], N_BRANCHES, D_MODEL))
    y = (gates[..., 0, :] * (y_na @ w_o_na) + gates[..., 1, :] * (y_fn @ w_fourier)
         + gates[..., 2, :] * (y_ret @ w_o_ret))
    return y @ w_out


def token_mixer(h, h_ctx, w_in, na_rpb, w_o_na, w_fourier, log_g_fwd, log_g_bwd, ret_gn_w, w_o_ret, w_out, update_ctx):
    B, N, _ = h.shape
    rows = N // GRID_W
    split_at = [int(s) for s in np.cumsum(IN_SPLITS)[:-1]]
    qa, ka, va, ub, qr, kr, vr, gr, gl = jnp.split(h @ w_in, split_at, axis=-1)
    qa_c, ka_c, va_c, ub_c, qr_c, kr_c, vr_c, gr_c, gl_c = jnp.split(h_ctx @ w_in, split_at, axis=-1)

    y_na = neighbourhood_attention(split_heads(qa, NA_HEADS), split_heads(ka, NA_HEADS), split_heads(va, NA_HEADS),
                                   split_heads(ka_c, NA_HEADS), split_heads(va_c, NA_HEADS), na_rpb, rows)
    y_fn = fourier_mix(ub)
    t = jnp.arange(N)
    row, col = t // GRID_W, t % GRID_W
    q_scale = RET_QK_DIM ** -0.5

    def ret_heads(qx, kx, vx, with_rope):
        qx, kx, vx = split_heads(qx, RET_HEADS), split_heads(kx, RET_HEADS), split_heads(vx, RET_HEADS)
        if with_rope:
            qx, kx = axial_rope(qx, row, col), axial_rope(kx, row, col)
        return (qx * q_scale).transpose(0, 2, 1, 3), kx.transpose(0, 2, 1, 3), vx.transpose(0, 2, 1, 3)

    zero_state = jnp.zeros((B, RET_HEADS, RET_QK_DIM, RET_V_DIM), jnp.float32)
    qc_h, kc_h, vc_h = ret_heads(qr_c, kr_c, vr_c, False)
    o_ret_c, s_fwd, s_bwd = bidirectional_retention(qc_h, kc_h, vc_h, log_g_fwd, log_g_bwd, zero_state, zero_state)
    q_h, k_h, v_h = ret_heads(qr, kr, vr, True)
    o_ret, _, _ = bidirectional_retention(q_h, k_h, v_h, log_g_fwd, log_g_bwd, s_fwd, s_bwd)
    y_ret = retention_output(o_ret, gr, ret_gn_w)
    y = merge_branches(gl, y_na, y_fn, y_ret, w_o_na, w_fourier, w_o_ret, w_out)
    if not update_ctx:
        return y, None
    y_na_c = context_attention(split_heads(qa_c, NA_HEADS), split_heads(ka_c, NA_HEADS), split_heads(va_c, NA_HEADS))
    y_fn_c = fourier_mix(ub_c)
    y_ret_c = retention_output(o_ret_c, gr_c, ret_gn_w)
    y_c = merge_branches(gl_c, y_na_c, y_fn_c, y_ret_c, w_o_na, w_fourier, w_o_ret, w_out)
    return y, y_c


def routed_experts(h, top_e, top_w, w_gate, w_up, w_down):
    T, D = h.shape
    A = T * TOP_K
    n_slots = -(-(A + N_EXPERTS * (MOE_BLOCK - 1)) // MOE_BLOCK) * MOE_BLOCK
    n_blocks = n_slots // MOE_BLOCK
    e_flat = top_e.reshape(A)
    order = jnp.argsort(e_flat)
    e_sorted = e_flat[order]
    tok_sorted = (order // TOP_K).astype(jnp.int32)
    w_sorted = top_w.reshape(A)[order]
    counts = jnp.bincount(e_flat, length=N_EXPERTS)
    padded = (counts + MOE_BLOCK - 1) // MOE_BLOCK * MOE_BLOCK
    pad_end = jnp.cumsum(padded)
    pad_start = pad_end - padded
    seg_start = jnp.cumsum(counts) - counts
    dest = pad_start[e_sorted] + (jnp.arange(A) - seg_start[e_sorted])
    slot_tok = jnp.full((n_slots,), T, jnp.int32).at[dest].set(tok_sorted)
    slot_w = jnp.zeros((n_slots,), h.dtype).at[dest].set(w_sorted)
    block_e = jnp.minimum(jnp.searchsorted(pad_end, jnp.arange(n_blocks) * MOE_BLOCK, side='right'), N_EXPERTS - 1)
    h_pad = jnp.concatenate([h, jnp.zeros((1, D), h.dtype)], axis=0)

    def expert_block(args):
        tok, wt, e = args
        return swiglu(h_pad[tok], w_gate[e], w_up[e], w_down[e]) * wt[:, None]

    y = lax.map(expert_block, (slot_tok.reshape(n_blocks, MOE_BLOCK), slot_w.reshape(n_blocks, MOE_BLOCK), block_e))
    return jax.ops.segment_sum(y.reshape(n_slots, D), slot_tok, num_segments=T + 1)[:T]


def moe_ffn(h, router_w, router_bias, exp_w_gate, exp_w_up, exp_w_down, sh_w_gate, sh_w_up, sh_w_down):
    T = h.shape[0]
    scores = jax.nn.sigmoid((h @ router_w).astype(jnp.float32))
    sel = scores + router_bias.astype(jnp.float32)
    grp_score = lax.top_k(sel.reshape(T, N_GROUPS, EXPERTS_PER_GROUP), 2)[0].sum(-1)
    _, top_g = lax.top_k(grp_score, TOPK_GROUPS)
    g_mask = jnp.any(top_g[..., None] == jnp.arange(N_GROUPS), axis=-2)
    sel = jnp.where(jnp.repeat(g_mask, EXPERTS_PER_GROUP, axis=-1), sel, -jnp.inf)
    _, top_e = lax.top_k(sel, TOP_K)
    w = jnp.take_along_axis(scores, top_e, axis=-1)
    w = w / jnp.sum(w, axis=-1, keepdims=True) * ROUTED_SCALE
    routed = routed_experts(h, top_e, w.astype(h.dtype), exp_w_gate, exp_w_up, exp_w_down)
    return routed + swiglu(h, sh_w_gate, sh_w_up, sh_w_down)


def setup_inputs(seed: int = 0) -> dict:
    key = jax.random.key(seed)
    ks = jax.random.split(key, 27)
    f32 = jnp.float32
    D = D_MODEL

    def nrm(k, shape, std):
        return jax.random.normal(k, shape, f32) * std

    base = 1.0 - 2.0 ** (-5.0 - np.arange(RET_HEADS))
    decay_logit = jnp.asarray(np.log(base / (1.0 - base)), f32)
    return {
        'x': nrm(ks[0], (BATCH, SEQ, D), 1.0),
        'c': nrm(ks[1], (BATCH, D), 1.0),
        'ctx': nrm(ks[2], (BATCH, CTX_LEN, D), 1.0),
        'c_ctx': nrm(ks[3], (D,), 1.0),
        'ada_w': nrm(ks[4], (DEPTH, D, 6 * D), 0.5 * D ** -0.5),
        'ada_b': nrm(ks[5], (DEPTH, 6 * D), 0.02),
        'w_in': nrm(ks[6], (DEPTH, D, IN_WIDTH), D ** -0.5),
        'na_rpb': nrm(ks[7], (DEPTH, NA_HEADS, 2 * NA_WIN_ROWS - 1, 2 * NA_WIN_COLS - 1), 0.1),
        'w_o_na': nrm(ks[8], (DEPTH, NA_WIDTH, D), DN_BETA * NA_WIDTH ** -0.5),
        'w_fourier': nrm(ks[9], (DEPTH, FNET_WIDTH, D), DN_BETA * FNET_WIDTH ** -0.5),
        'ret_decay_fwd': decay_logit + nrm(ks[10], (DEPTH, RET_HEADS), 0.01),
        'ret_decay_bwd': decay_logit + nrm(ks[11], (DEPTH, RET_HEADS), 0.01),
        'ret_gn_w': 1.0 + nrm(ks[12], (DEPTH, RET_V_WIDTH), 0.02),
        'w_o_ret': nrm(ks[13], (DEPTH, RET_V_WIDTH, D), DN_BETA * RET_V_WIDTH ** -0.5),
        'w_out': nrm(ks[14], (DEPTH, D, D), DN_BETA * D ** -0.5),
        'ln_mix_w': 1.0 + nrm(ks[15], (DEPTH, D), 0.02),
        'ln_mix_b': nrm(ks[16], (DEPTH, D), 0.02),
        'router_w': nrm(ks[17], (DEPTH, D, N_EXPERTS), D ** -0.5),
        'router_bias': nrm(ks[18], (DEPTH, N_EXPERTS), 0.01),
        'exp_w_gate': nrm(ks[19], (DEPTH, N_EXPERTS, D, EXPERT_DIM), D ** -0.5),
        'exp_w_up': nrm(ks[20], (DEPTH, N_EXPERTS, D, EXPERT_DIM), D ** -0.5),
        'exp_w_down': nrm(ks[21], (DEPTH, N_EXPERTS, EXPERT_DIM, D), DN_BETA * EXPERT_DIM ** -0.5),
        'sh_w_gate': nrm(ks[22], (DEPTH, D, SHARED_DIM), D ** -0.5),
        'sh_w_up': nrm(ks[23], (DEPTH, D, SHARED_DIM), D ** -0.5),
        'sh_w_down': nrm(ks[24], (DEPTH, SHARED_DIM, D), DN_BETA * SHARED_DIM ** -0.5),
        'ln_ffn_w': 1.0 + nrm(ks[25], (DEPTH, D), 0.02),
        'ln_ffn_b': nrm(ks[26], (DEPTH, D), 0.02),
    }


def reference(x, c, ctx, c_ctx, ada_w, ada_b, w_in, na_rpb, w_o_na, w_fourier, ret_decay_fwd, ret_decay_bwd,
              ret_gn_w, w_o_ret, w_out, ln_mix_w, ln_mix_b, router_w, router_bias, exp_w_gate, exp_w_up,
              exp_w_down, sh_w_gate, sh_w_up, sh_w_down, ln_ffn_w, ln_ffn_b):
    B, N, D = x.shape
    L = ctx.shape[1]
    xc = ctx
    for l in range(DEPTH):
        update_ctx = l < DEPTH - 1
        mod = jax.nn.silu(c) @ ada_w[l] + ada_b[l]
        mod_c = jax.nn.silu(c_ctx) @ ada_w[l] + ada_b[l]
        sh1, sc1, g1, sh2, sc2, g2 = jnp.split(mod[:, None, :], 6, axis=-1)
        sh1_c, sc1_c, g1_c, sh2_c, sc2_c, g2_c = jnp.split(mod_c, 6, axis=-1)
        log_g_fwd = jax.nn.log_sigmoid(ret_decay_fwd[l].astype(jnp.float32))
        log_g_bwd = jax.nn.log_sigmoid(ret_decay_bwd[l].astype(jnp.float32))
        y, y_c = token_mixer(modulate(x, sh1, sc1), modulate(xc, sh1_c, sc1_c), w_in[l], na_rpb[l], w_o_na[l],
                             w_fourier[l], log_g_fwd, log_g_bwd, ret_gn_w[l], w_o_ret[l], w_out[l], update_ctx)
        x = layer_norm(DN_ALPHA * x + g1 * y, ln_mix_w[l], ln_mix_b[l])
        h = modulate(x, sh2, sc2).reshape(B * N, D)
        moe_args = (router_w[l], router_bias[l], exp_w_gate[l], exp_w_up[l], exp_w_down[l],
                    sh_w_gate[l], sh_w_up[l], sh_w_down[l])
        if update_ctx:
            xc = layer_norm(DN_ALPHA * xc + g1_c * y_c, ln_mix_w[l], ln_mix_b[l])
            h_c = modulate(xc, sh2_c, sc2_c).reshape(B * L, D)
            f = moe_ffn(jnp.concatenate([h, h_c], axis=0), *moe_args)
            f_lat = f[:B * N].reshape(B, N, D)
            xc = layer_norm(DN_ALPHA * xc + g2_c * f[B * N:].reshape(B, L, D), ln_ffn_w[l], ln_ffn_b[l])
        else:
            f_lat = moe_ffn(h, *moe_args).reshape(B, N, D)
        x = layer_norm(DN_ALPHA * x + g2 * f_lat, ln_ffn_w[l], ln_ffn_b[l])
    return x
```

```cpp
#include <hip/hip_runtime.h>
#include <cstdio>
#include <cstdint>

#define LAS __attribute__((address_space(3)))
#define GAS __attribute__((address_space(1)))
typedef unsigned short bf16;
typedef short bf16x8 __attribute__((ext_vector_type(8)));
typedef short bf16x4 __attribute__((ext_vector_type(4)));
typedef float f32x4 __attribute__((ext_vector_type(4)));
typedef float f32x2 __attribute__((ext_vector_type(2)));
typedef unsigned u32x4 __attribute__((ext_vector_type(4)));
typedef unsigned u32x2 __attribute__((ext_vector_type(2)));

constexpr int D = 1024, NB = 8, NSEQ = 4096, NCTX = 256, GW = 64;
constexpr int T_LAT = NB * NSEQ, T_CTX = NB * NCTX, T_ALL = T_LAT + T_CTX;
constexpr int INW = 8192;
constexpr int C_QA = 0, C_KA = 512, C_VA = 1024, C_UB = 1536, C_QR = 2048, C_KR = 2560, C_VR = 3072, C_GR = 4096, C_GL = 5120;
constexpr int NE = 256, TOPK = 8, EDIM = 256;
constexpr int NCH = 34;
constexpr float DN_ALPHA = 1.41421356237309515f;
constexpr float LN_EPS = 1e-6f, GN_EPS = 1e-5f;
constexpr int MAX_TILES = 1343 + 136;

constexpr size_t MiB = 1u << 20;
constexpr size_t WS_CTL = 0, CTL_BYTES = 1 * MiB;
constexpr size_t WS_MOD = 1 * MiB;
constexpr size_t WS_ROPE = 2 * MiB;
constexpr size_t WS_META = 3 * MiB;
constexpr size_t WS_WNE = 8 * MiB, WNE_STRIDE = 24 * MiB;
constexpr size_t WNE_WIN = 0, WNE_ONA = 16 * MiB, WNE_WF = 17 * MiB, WNE_ORET = 19 * MiB, WNE_WOUT = 21 * MiB, WNE_ROUT = 23 * MiB;
constexpr size_t WS_DFT = 56 * MiB;
constexpr size_t WS_DFTC = 120 * MiB;
constexpr size_t WS_WGU = 128 * MiB;
constexpr size_t WS_WD = 386 * MiB;
constexpr size_t WS_X = 520 * MiB;
constexpr size_t WS_H = 656 * MiB;
constexpr size_t WS_R = 724 * MiB;
constexpr size_t WS_P = WS_R;
constexpr size_t WS_YNA = WS_R + 544 * MiB;
constexpr size_t WS_FF = WS_R + 578 * MiB;
constexpr size_t WS_YRET = WS_R + 646 * MiB;
constexpr size_t WS_UT = WS_R + 714 * MiB;
constexpr size_t WS_UTC = WS_UT + 32 * MiB;
constexpr size_t WS_KV = WS_R + 748 * MiB;
constexpr size_t WS_SPREV = WS_R + 1020 * MiB;
constexpr size_t WS_YSUM = WS_KV;
constexpr size_t WS_YSUMB = WS_KV + 136 * MiB;
constexpr size_t WS_TMIX = WS_R;
constexpr size_t WS_LOGIT = WS_R + 136 * MiB;
constexpr size_t WS_TOPE = WS_R + 170 * MiB;
constexpr size_t WS_TOPW = WS_R + 172 * MiB;
constexpr size_t WS_TPOS = WS_R + 174 * MiB;
constexpr size_t WS_TSLOT = WS_R + 176 * MiB;
constexpr size_t WS_STOK = WS_R + 178 * MiB;
constexpr size_t WS_SW = WS_R + 180 * MiB;
constexpr size_t WS_ACT = WS_R + 182 * MiB;
constexpr size_t WS_YSLOT = WS_R + 368 * MiB;
constexpr size_t WS_END = 1880 * MiB;
constexpr int CW_BAR = 4096;
constexpr int CW_CNT = 16384;
constexpr int CW_CHK = 20000;

constexpr int LDS_BYTES = 159744;
constexpr int MISC_OFF = 159232;

#define LDS_WAIT() asm volatile("s_waitcnt lgkmcnt(0)" ::: "memory")
#define VM_WAIT() asm volatile("s_waitcnt vmcnt(0)" ::: "memory")
__device__ __forceinline__ unsigned f2bf(float f) { unsigned u = __builtin_bit_cast(unsigned, f); return (u + 0x7fffu + ((u >> 16) & 1u)) >> 16; }
__device__ __forceinline__ float bf2f(unsigned b) { return __builtin_bit_cast(float, (b & 0xffffu) << 16); }
__device__ __forceinline__ unsigned pk2(float lo, float hi) { return f2bf(lo) | (f2bf(hi) << 16); }
__device__ __forceinline__ float bflo(unsigned w) { return __builtin_bit_cast(float, w << 16); }
__device__ __forceinline__ float bfhi(unsigned w) { return __builtin_bit_cast(float, w & 0xffff0000u); }
__device__ __forceinline__ float wave_sum(float v) {
#pragma unroll
    for (int o = 1; o < 64; o <<= 1) v += __shfl_xor(v, o);
    return v;
}
__device__ __forceinline__ float sigmoidf_(float x) { return 1.f / (1.f + __expf(-x)); }
__device__ __forceinline__ float siluf_(float x) { return x / (1.f + __expf(-x)); }

#define XB_TMO      128
#define XB_XCNT(j)  (256  + 64 * (j))
#define XB_XSUB(j)  (1280 + 64 * (j))
#define XB_XGEN(j)  (2304 + 64 * (j))
#define XB_TOP      3328
#define XB_TOPGEN   3392
#define XCD_BAR_WORDS 3456
#define XB_SPIN_CAP (1u << 18)
__device__ __forceinline__ unsigned xb_ld(unsigned* p)              { return __hip_atomic_load(p, __ATOMIC_RELAXED, __HIP_MEMORY_SCOPE_AGENT); }
__device__ __forceinline__ unsigned xb_add(unsigned* p, unsigned v) { return __hip_atomic_fetch_add(p, v, __ATOMIC_RELAXED, __HIP_MEMORY_SCOPE_AGENT); }
__device__ __forceinline__ unsigned xb_xcc_id() { return (unsigned)__builtin_amdgcn_s_getreg((3 << 11) | 20) & 0xFu; }
#define XB_SPIN(cond, bar) do { unsigned _sp = 0; while (cond) { __builtin_amdgcn_s_sleep(1); \
    if ((++_sp & 255u) == 0u) { if (xb_ld(&(bar)[XB_TMO])) break; if (_sp > XB_SPIN_CAP) { atomicAdd(&(bar)[XB_TMO], 1u); break; } } } } while (0)
struct XcdBarrier { unsigned* bar; unsigned x; volatile LAS unsigned* st; };
__device__ __forceinline__ XcdBarrier xcd_barrier_post(unsigned* bar, volatile LAS unsigned* st) {
    XcdBarrier b; b.bar = bar; b.x = xb_xcc_id(); b.st = st;
    if (threadIdx.x == 0) (void)xb_add(&bar[XB_XCNT(b.x)], 1u);
    return b;
}
__device__ __forceinline__ void xcd_barrier_complete(unsigned* bar, unsigned x, unsigned& nloc, unsigned& nx) {
    const unsigned G = gridDim.x * gridDim.y * gridDim.z;
    unsigned sum, cnt, mine, sp = 0u;
    for (;;) {
        sum = 0u; cnt = 0u; mine = 0u;
#pragma unroll
        for (unsigned j = 0; j < 16; ++j) { const unsigned c = xb_ld(&bar[XB_XCNT(j)]); sum += c; cnt += (c > 0u) ? 1u : 0u; mine = (j == x) ? c : mine; }
        if (sum == G) break;
        __builtin_amdgcn_s_sleep(1);
        if ((++sp & 255u) == 0u) { if (xb_ld(&bar[XB_TMO])) break; if (sp > XB_SPIN_CAP) { atomicAdd(&bar[XB_TMO], 1u); break; } }
    }
    nloc = mine > 0u ? mine : 1u; nx = cnt > 0u ? cnt : 1u;
}
__device__ __forceinline__ void xcd_barrier(const XcdBarrier& b) {
    asm volatile("s_waitcnt vmcnt(0)" ::: "memory");
    __syncthreads();
    if (threadIdx.x == 0) {
        unsigned* bar = b.bar;
        __builtin_amdgcn_s_waitcnt(0);
        unsigned nloc = b.st[0], nx = b.st[1];
        if (nloc == 0u) { xcd_barrier_complete(bar, b.x, nloc, nx); b.st[0] = nloc; b.st[1] = nx; }
        const unsigned old = xb_add(&bar[XB_XSUB(b.x)], 1u);
        const unsigned gen = old / nloc;
        if (old + 1u == (gen + 1u) * nloc) {
            __builtin_amdgcn_fence(__ATOMIC_RELEASE, "agent");
            asm volatile("s_waitcnt vmcnt(0)" ::: "memory");
            const unsigned og = xb_add(&bar[XB_TOP], 1u);
            const unsigned tg = og / nx;
            if (og + 1u == (tg + 1u) * nx) xb_add(&bar[XB_TOPGEN], 1u);
            else XB_SPIN(xb_ld(&bar[XB_TOPGEN]) == tg, bar);
            __builtin_amdgcn_fence(__ATOMIC_ACQUIRE, "agent");
            xb_add(&bar[XB_XGEN(b.x)], 1u);
            asm volatile("s_waitcnt vmcnt(0)" ::: "memory");
        } else {
            XB_SPIN(xb_ld(&bar[XB_XGEN(b.x)]) == gen, bar);
            __builtin_amdgcn_fence(__ATOMIC_ACQUIRE, "agent");
            asm volatile("s_waitcnt vmcnt(0)" ::: "memory");
        }
    }
    __syncthreads();
}
namespace pg8 {
constexpr int BM = 256, BK = 64, HALF = 128, HTB = HALF * BK * 2, STAGE_BYTES = 8 * HTB, NXCD = 8, WGM = 8;
__host__ __device__ __forceinline__ int lds_byte(int r, int c) { const int st = (r >> 4) * 2 + (c >> 5), rr = r & 15, cc = c & 31, ob = rr * 64 + cc * 2; return st * 1024 + (ob ^ (((ob >> 9) & 1) << 5)); }
__host__ __device__ __forceinline__ void stage_rc(int b, int& R, int& C) { const int st = b / 1024, sb = b % 1024, swz = sb ^ (((sb >> 9) & 1) << 5); R = (st >> 1) * 16 + swz / 64; C = (st & 1) * 32 + (swz % 64) / 2; }
__host__ __device__ __forceinline__ int perm32(int rho) { const int n = rho >> 4, i = rho & 15; return 8 * (i >> 2) + 4 * n + (i & 3); }

struct Unit { int pm, pn, e, aux; };
__device__ __forceinline__ unsigned cvt_pk_bf16(float lo, float hi) { unsigned r; asm volatile("v_cvt_pk_bf16_f32 %0, %1, %2" : "=v"(r) : "v"(lo), "v"(hi)); return r; }

__device__ __forceinline__ bool static_tile(int nM, int nN, int G, int c, int i, int& pm, int& pn) {
    const int nwg = nM * nN; const long L = (long)i * G + c; if (L >= nwg) return false;
    int wgid = (int)L; { const int q = nwg / NXCD, r = nwg % NXCD, xcd = wgid % NXCD, off = wgid / NXCD; wgid = (xcd < r ? xcd * (q + 1) : r * (q + 1) + (xcd - r) * q) + off; }
    const int nig = WGM * nN, gid = wgid / nig, fm = gid * WGM, gsz = (nM - fm) < WGM ? (nM - fm) : WGM;
    pm = fm + ((wgid % nig) % gsz); pn = (wgid % nig) / gsz; return true;
}

template <class Prob, class Epi, bool ALIGN_EPI = true>
__device__ __forceinline__ void gemm_phase(LAS unsigned char* lds, const Prob& S, const Epi& E) {
    int tid_ = threadIdx.x; asm volatile("" : "+v"(tid_));
    const int tid = tid_, wid = __builtin_amdgcn_readfirstlane(tid >> 6), lane = tid & 63, wr = wid >> 2, wc = wid & 3, fr = lane & 15, fq = lane >> 4;
    int K_ = S.K; asm volatile("" : "+s"(K_));
    const int K = K_, nt = K / BK;
    unsigned voffA[2], voffB[2]; int RA[2], CA[2];
#pragma unroll
    for (int i = 0; i < 2; ++i) { int R, C; stage_rc(tid * 16 + i * 8192, R, C); const int Rb = Epi::PERM ? ((R & ~31) + perm32(R & 31)) : R;
        RA[i] = R; CA[i] = C; voffA[i] = (unsigned)(R * K + C) * 2u; voffB[i] = (unsigned)(Rb * K + C) * 2u; }
    const size_t kstep = (size_t)(BK * 2);
    const size_t hstep = (size_t)HALF * K * 2;
    const unsigned ldsw = (unsigned)wid * 1024u;
    const int aoff = lds_byte(wr * 64 + fr, fq * 8), boff = lds_byte(wc * 32 + fr, fq * 8);
#define PG8_SA(b, h) (((b) * 2 + (h)) * HTB)
#define PG8_SB(b, h) ((4 + (b) * 2 + (h)) * HTB)
#define PG8_STAGE(bufoff, gbase, voff) do { _Pragma("unroll") for (int _i = 0; _i < 2; ++_i) \
        __builtin_amdgcn_global_load_lds((const unsigned*)((const char*)(gbase) + (voff)[_i]), (LAS unsigned*)(lds + (bufoff) + ldsw + _i * 8192), 16, 0, 0); } while (0)
#define PG8_STAGE_A(bufoff, kp, h, g0, g1) do { if constexpr (Prob::GATHER) { if ((h) == 0) PG8_STAGE(bufoff, kp, g0); else PG8_STAGE(bufoff, kp, g1); } \
        else PG8_STAGE(bufoff, (kp) + (h) * hstep, voffA); } while (0)
#define PG8_LDA(dst, b, h) do { _Pragma("unroll") for (int m = 0; m < 4; ++m) _Pragma("unroll") for (int k = 0; k < 2; ++k) dst[m][k] = *(const LAS bf16x8*)(lds + PG8_SA(b, h) + aoff + m * 2048 + k * 1024); } while (0)
#define PG8_LDB(dst, b, h) do { _Pragma("unroll") for (int n = 0; n < 2; ++n) _Pragma("unroll") for (int k = 0; k < 2; ++k) dst[n][k] = *(const LAS bf16x8*)(lds + PG8_SB(b, h) + boff + n * 2048 + k * 1024); } while (0)
#define PG8_MMA(ai, bj, At, Bt) do { __builtin_amdgcn_s_setprio(1); _Pragma("unroll") for (int m = 0; m < 4; ++m) _Pragma("unroll") for (int n = 0; n < 2; ++n) _Pragma("unroll") for (int k = 0; k < 2; ++k) \
        acc[ai][bj][m][n] = __builtin_amdgcn_mfma_f32_16x16x32_bf16(Bt[n][k], At[m][k], acc[ai][bj][m][n], 0, 0, 0); __builtin_amdgcn_s_setprio(0); } while (0)
#define PG8_WAIT_V(n) asm volatile("s_waitcnt vmcnt(" #n ")" ::: "memory")
#define PG8_WAIT_L(n) asm volatile("s_waitcnt lgkmcnt(" #n ")" ::: "memory")
#define PG8_BAR __builtin_amdgcn_s_barrier()
#define PG8_SCHED __builtin_amdgcn_sched_barrier(0)
    Unit cur, nxt; int ui = 0;
    if (!S.next(0, cur)) return;
    f32x4 acc[2][2][4][2];
#pragma unroll
    for (int a = 0; a < 2; ++a)
#pragma unroll
        for (int b = 0; b < 2; ++b)
#pragma unroll
            for (int m = 0; m < 4; ++m)
#pragma unroll
                for (int n = 0; n < 2; ++n) acc[a][b][m][n] = (f32x4){0.f, 0.f, 0.f, 0.f};
    bf16x8 At[4][2], B0[2][2], B1[2][2];
    const char* cA = S.a_tile(cur); const char* cB = S.b_tile(cur);
    unsigned gc0[2] = {0u, 0u}, gc1[2] = {0u, 0u}, gn0[2] = {0u, 0u}, gn1[2] = {0u, 0u};
    if constexpr (Prob::GATHER) {
#pragma unroll
        for (int i = 0; i < 2; ++i) { const int r0 = S.gidx[cur.pm * 256 + RA[i]], r1 = S.gidx[cur.pm * 256 + 128 + RA[i]];
            gc0[i] = (unsigned)(r0 * K + CA[i]) * 2u; gc1[i] = (unsigned)(r1 * K + CA[i]) * 2u; }
    }
    PG8_STAGE(PG8_SB(0, 0), cB, voffB); PG8_STAGE(PG8_SB(0, 1), cB + hstep, voffB); PG8_STAGE_A(PG8_SA(0, 0), cA, 0, gc0, gc1); PG8_STAGE_A(PG8_SA(0, 1), cA, 1, gc0, gc1);
    if (wr == 1) PG8_BAR;
    PG8_WAIT_V(2); PG8_BAR;
    PG8_STAGE(PG8_SB(1, 0), cB + kstep, voffB); PG8_STAGE_A(PG8_SA(1, 0), cA + kstep, 0, gc0, gc1); PG8_STAGE(PG8_SB(1, 1), cB + hstep + kstep, voffB);
    PG8_WAIT_V(6); PG8_BAR;
    for (;;) {
        const bool has_next = S.next(ui + 1, nxt);
        const char* nA = has_next ? S.a_tile(nxt) : cA; const char* nB = has_next ? S.b_tile(nxt) : cB;
        if constexpr (Prob::GATHER) {
            if (has_next) {
#pragma unroll
                for (int i = 0; i < 2; ++i) { const int r0 = S.gidx[nxt.pm * 256 + RA[i]], r1 = S.gidx[nxt.pm * 256 + 128 + RA[i]];
                    gn0[i] = (unsigned)(r0 * K + CA[i]) * 2u; gn1[i] = (unsigned)(r1 * K + CA[i]) * 2u; }
            } else { gn0[0] = gc0[0]; gn0[1] = gc0[1]; gn1[0] = gc1[0]; gn1[1] = gc1[1]; }
        }
        for (int t = 0; t < nt; t += 2) {
            const bool last = (t == nt - 2);
            const char* a1 = cA + (size_t)(t + 1) * kstep;
            const char* a2 = last ? nA : cA + (size_t)(t + 2) * kstep; const char* b2 = last ? nB : cB + (size_t)(t + 2) * kstep;
            const char* a3 = a2 + kstep; const char* b3 = b2 + kstep;
            unsigned g20[2], g21[2];
            g20[0] = last ? gn0[0] : gc0[0]; g20[1] = last ? gn0[1] : gc0[1]; g21[0] = last ? gn1[0] : gc1[0]; g21[1] = last ? gn1[1] : gc1[1];
            PG8_LDB(B0, 0, 0); PG8_LDB(B1, 0, 1); PG8_SCHED; PG8_LDA(At, 0, 0); PG8_STAGE_A(PG8_SA(1, 1), a1, 1, gc0, gc1);
            PG8_WAIT_V(8); PG8_WAIT_L(0); PG8_BAR; PG8_MMA(0, 0, At, B0); PG8_MMA(0, 1, At, B1); PG8_BAR; PG8_SCHED;
            PG8_LDA(At, 0, 1); PG8_STAGE(PG8_SB(0, 0), b2, voffB); PG8_STAGE(PG8_SB(0, 1), b2 + hstep, voffB); PG8_STAGE_A(PG8_SA(0, 0), a2, 0, g20, g21);
            PG8_WAIT_V(8); PG8_WAIT_L(0); PG8_BAR; PG8_MMA(1, 0, At, B0); PG8_MMA(1, 1, At, B1); PG8_BAR; PG8_SCHED;
            PG8_LDB(B0, 1, 0); PG8_LDB(B1, 1, 1); PG8_SCHED; PG8_LDA(At, 1, 0); PG8_STAGE_A(PG8_SA(0, 1), a2, 1, g20, g21);
            PG8_WAIT_V(8); PG8_WAIT_L(0); PG8_BAR; PG8_MMA(0, 0, At, B0); PG8_MMA(0, 1, At, B1); PG8_BAR; PG8_SCHED;
            PG8_LDA(At, 1, 1); PG8_STAGE(PG8_SB(1, 0), b3, voffB); PG8_STAGE(PG8_SB(1, 1), b3 + hstep, voffB); PG8_STAGE_A(PG8_SA(1, 0), a3, 0, g20, g21);
            PG8_WAIT_V(8); PG8_WAIT_L(0); PG8_BAR; PG8_MMA(1, 0, At, B0); PG8_MMA(1, 1, At, B1); PG8_BAR; PG8_SCHED;
        }
        if constexpr (ALIGN_EPI) { if (wr == 0) PG8_BAR; }
        E(acc, cur, wr, wc, fr, fq);
        if (!has_next) break;
#pragma unroll
        for (int a = 0; a < 2; ++a)
#pragma unroll
            for (int b = 0; b < 2; ++b)
#pragma unroll
                for (int m = 0; m < 4; ++m)
#pragma unroll
                    for (int n = 0; n < 2; ++n) acc[a][b][m][n] = (f32x4){0.f, 0.f, 0.f, 0.f};
        cur = nxt; cA = nA; cB = nB; ++ui;
        if constexpr (Prob::GATHER) { gc0[0] = gn0[0]; gc0[1] = gn0[1]; gc1[0] = gn1[0]; gc1[1] = gn1[1]; }
        if constexpr (ALIGN_EPI) { if (wr == 1) PG8_BAR; }
    }
    PG8_WAIT_V(0);
    if constexpr (!ALIGN_EPI) { if (wr == 0) PG8_BAR; }
    PG8_BAR;
#undef PG8_SA
#undef PG8_SB
#undef PG8_STAGE
#undef PG8_STAGE_A
#undef PG8_LDA
#undef PG8_LDB
#undef PG8_MMA
#undef PG8_WAIT_V
#undef PG8_WAIT_L
#undef PG8_BAR
#undef PG8_SCHED
}
}
namespace pg8 {
struct ProbDense {
    static constexpr bool GATHER = false; const int* gidx;
    int K; const bf16* A; const bf16* Bt; int nM, nN, G, c;
    __device__ __forceinline__ bool next(int i, Unit& u) const { u.e = 0; u.aux = 0; return static_tile(nM, nN, G, c, i, u.pm, u.pn); }
    __device__ __forceinline__ const char* a_tile(const Unit& u) const { return (const char*)A + (size_t)u.pm * 256 * K * 2; }
    __device__ __forceinline__ const char* b_tile(const Unit& u) const { return (const char*)Bt + (size_t)u.pn * 256 * K * 2; }
};
struct ProbBatched {
    static constexpr bool GATHER = false; const int* gidx;
    int K; const bf16* A; const bf16* Bt; size_t bstride  ; int nPm, nPn, nb, G, c;
    __device__ __forceinline__ bool next(int i, Unit& u) const {
        const int L = i * G + c; if (L >= nb * nPm * nPn) return false;
        const int per = nPm * nPn, b = L / per, r = L % per; u.e = b; u.pm = r / nPn; u.pn = r % nPn; u.aux = 0; return true; }
    __device__ __forceinline__ const char* a_tile(const Unit& u) const { return (const char*)A + (size_t)u.pm * 256 * K * 2; }
    __device__ __forceinline__ const char* b_tile(const Unit& u) const { return (const char*)(Bt + (size_t)u.e * bstride) + (size_t)u.pn * 256 * K * 2; }
};
struct ProbGU {
    static constexpr bool GATHER = true; const int* gidx;
    int K; const bf16* A; const bf16* W; const int* meta; const int* tile_e; int G, c;
    __device__ __forceinline__ bool next(int i, Unit& u) const {
        const int L = i * G + c, ntile = __builtin_amdgcn_readfirstlane(meta[1]); if (L >= ntile * 2) return false;
        u.pm = L >> 1; u.pn = L & 1; u.e = __builtin_amdgcn_readfirstlane(tile_e[u.pm]); u.aux = 0; return true; }
    __device__ __forceinline__ const char* a_tile(const Unit&) const { return (const char*)A; }
    __device__ __forceinline__ const char* b_tile(const Unit& u) const { return (const char*)W + ((size_t)u.e * 512 + (size_t)u.pn * 256) * 1024 * 2; }
};
struct ProbDown {
    static constexpr bool GATHER = false; const int* gidx;
    int K; const bf16* A; const bf16* W; const int* meta; const int* tile_e; int G, c;
    __device__ __forceinline__ bool next(int i, Unit& u) const {
        const int L = i * G + c, ntile = __builtin_amdgcn_readfirstlane(meta[1]); if (L >= ntile * 4) return false;
        u.pm = L >> 2; u.pn = L & 3; u.e = __builtin_amdgcn_readfirstlane(tile_e[u.pm]); u.aux = 0; return true; }
    __device__ __forceinline__ const char* a_tile(const Unit& u) const { return (const char*)A + (size_t)u.pm * 256 * 256 * 2; }
    __device__ __forceinline__ const char* b_tile(const Unit& u) const { return (const char*)W + ((size_t)u.e * 1024 + (size_t)u.pn * 256) * 256 * 2; }
};

typedef f32x4 Acc[2][2][4][2];
struct EpiBf16Plain {
    static constexpr bool PERM = true; bf16* O; int ldc;
    __device__ __forceinline__ void operator()(const Acc& acc, const Unit& u, int wr, int wc, int fr, int fq) const {
        bf16* base = O + (size_t)(u.pm * 256 + wr * 64 + fr) * ldc + u.pn * 256 + wc * 32 + 8 * fq;
#pragma unroll
        for (int ai = 0; ai < 2; ++ai)
#pragma unroll
            for (int m = 0; m < 4; ++m) { bf16* rowp = base + (size_t)(ai * HALF + m * 16) * ldc;
#pragma unroll
                for (int bj = 0; bj < 2; ++bj) { const f32x4 v0 = acc[ai][bj][m][0], v1 = acc[ai][bj][m][1];
                    u32x4 w; w.x = cvt_pk_bf16(v0[0], v0[1]); w.y = cvt_pk_bf16(v0[2], v0[3]); w.z = cvt_pk_bf16(v1[0], v1[1]); w.w = cvt_pk_bf16(v1[2], v1[3]);
                    *(u32x4*)(rowp + bj * HALF) = w; } }
    }
};
struct EpiFourier {
    static constexpr bool PERM = true; bf16* FF; int rowbase, rows_b, hp;
    __device__ __forceinline__ void operator()(const Acc& acc, const Unit& u, int wr, int wc, int fr, int fq) const {
        const int reim = u.pm / hp, pr = u.pm % hp;
        bf16* base = FF + (size_t)(rowbase + u.e * rows_b + pr * 256 + wr * 64 + fr) * 1024 + reim * 512 + u.pn * 256 + wc * 32 + 8 * fq;
#pragma unroll
        for (int ai = 0; ai < 2; ++ai)
#pragma unroll
            for (int m = 0; m < 4; ++m) { bf16* rowp = base + (size_t)(ai * HALF + m * 16) * 1024;
#pragma unroll
                for (int bj = 0; bj < 2; ++bj) { const f32x4 v0 = acc[ai][bj][m][0], v1 = acc[ai][bj][m][1];
                    u32x4 w; w.x = cvt_pk_bf16(v0[0], v0[1]); w.y = cvt_pk_bf16(v0[2], v0[3]); w.z = cvt_pk_bf16(v1[0], v1[1]); w.w = cvt_pk_bf16(v1[2], v1[3]);
                    *(u32x4*)(rowp + bj * HALF) = w; } }
    }
};
struct EpiF32 {
    static constexpr bool PERM = false; float* C; int ldc;
    __device__ __forceinline__ void operator()(const Acc& acc, const Unit& u, int wr, int wc, int fr, int fq) const {
        float* base = C + (size_t)(u.pm * 256 + wr * 64 + fr) * ldc + u.pn * 256 + wc * 32 + 4 * fq;
#pragma unroll
        for (int ai = 0; ai < 2; ++ai)
#pragma unroll
            for (int m = 0; m < 4; ++m) { float* rowp = base + (size_t)(ai * HALF + m * 16) * ldc;
#pragma unroll
                for (int bj = 0; bj < 2; ++bj)
#pragma unroll
                    for (int n = 0; n < 2; ++n) *(f32x4*)(rowp + bj * HALF + n * 16) = acc[ai][bj][m][n]; }
    }
};
template <int MODE  > struct EpiGate {
    static constexpr bool PERM = false; float* Y; bf16* YB; const bf16* P; int br;
    __device__ __forceinline__ void operator()(const Acc& acc, const Unit& u, int wr, int wc, int fr, int fq) const {
        const int row0 = u.pm * 256 + wr * 64 + fr, col0 = u.pn * 256 + wc * 32 + 4 * fq;
#pragma unroll
        for (int ai = 0; ai < 2; ++ai)
#pragma unroll
            for (int m = 0; m < 4; ++m) { const size_t row = (size_t)(row0 + ai * HALF + m * 16);
#pragma unroll
                for (int bj = 0; bj < 2; ++bj)
#pragma unroll
                    for (int n = 0; n < 2; ++n) { const int col = col0 + bj * HALF + n * 16;
                        const u32x2 gw = *(const u32x2*)(P + row * INW + C_GL + br * 1024 + col);
                        f32x4 g; g[0] = sigmoidf_(bflo(gw.x)); g[1] = sigmoidf_(bfhi(gw.x)); g[2] = sigmoidf_(bflo(gw.y)); g[3] = sigmoidf_(bfhi(gw.y));
                        f32x4 v = acc[ai][bj][m][n] * g;
                        if (MODE >= 1) v += *(const f32x4*)(Y + row * 1024 + col);
                        if (MODE <= 1) *(f32x4*)(Y + row * 1024 + col) = v;
                        else { u32x2 w; w.x = cvt_pk_bf16(v[0], v[1]); w.y = cvt_pk_bf16(v[2], v[3]); *(u32x2*)(YB + row * 1024 + col) = w; } } }
    }
};
struct EpiWout {
    static constexpr bool PERM = false; float* tmix; const float* xlat; const float* xctx; const float* modl  ; int goff  ;
    __device__ __forceinline__ void operator()(const Acc& acc, const Unit& u, int wr, int wc, int fr, int fq) const {
        const int rowt = u.pm * 256; const bool isctx = rowt >= T_LAT;
        const int v = isctx ? 8 : rowt / NSEQ;
        const float* xs = isctx ? xctx + (size_t)(rowt - T_LAT) * 1024 : xlat + (size_t)rowt * 1024;
        const float* gv = modl + v * 6144 + goff;
        const int r0 = wr * 64 + fr, col0 = u.pn * 256 + wc * 32 + 4 * fq;
        f32x4 gg[2][2];
#pragma unroll
        for (int bj = 0; bj < 2; ++bj)
#pragma unroll
            for (int n = 0; n < 2; ++n) gg[bj][n] = *(const f32x4*)(gv + col0 + bj * HALF + n * 16);
#pragma unroll
        for (int ai = 0; ai < 2; ++ai)
#pragma unroll
            for (int m = 0; m < 4; ++m) { const int r = r0 + ai * HALF + m * 16;
#pragma unroll
                for (int bj = 0; bj < 2; ++bj)
#pragma unroll
                    for (int n = 0; n < 2; ++n) { const int col = col0 + bj * HALF + n * 16;
                        const f32x4 xv = *(const f32x4*)(xs + (size_t)r * 1024 + col);
                        *(f32x4*)(tmix + (size_t)(rowt + r) * 1024 + col) = xv * DN_ALPHA + gg[bj][n] * acc[ai][bj][m][n]; } }
    }
};
struct EpiSwiglu {
    static constexpr bool PERM = true; bf16* ACT;
    __device__ __forceinline__ void operator()(const Acc& acc, const Unit& u, int wr, int wc, int fr, int fq) const {
        bf16* base = ACT + (size_t)(u.pm * 256 + wr * 64 + fr) * 256 + u.pn * 128 + wc * 32 + 8 * fq;
#pragma unroll
        for (int ai = 0; ai < 2; ++ai)
#pragma unroll
            for (int m = 0; m < 4; ++m) { bf16* rowp = base + (size_t)(ai * HALF + m * 16) * 256;
                const f32x4 g0 = acc[ai][0][m][0], g1 = acc[ai][0][m][1], u0 = acc[ai][1][m][0], u1 = acc[ai][1][m][1];
                f32x4 a, b;
#pragma unroll
                for (int j = 0; j < 4; ++j) { a[j] = siluf_(g0[j]) * u0[j]; b[j] = siluf_(g1[j]) * u1[j]; }
                u32x4 w; w.x = cvt_pk_bf16(a[0], a[1]); w.y = cvt_pk_bf16(a[2], a[3]); w.z = cvt_pk_bf16(b[0], b[1]); w.w = cvt_pk_bf16(b[2], b[3]);
                *(u32x4*)rowp = w; }
    }
};
struct EpiDown {
    static constexpr bool PERM = true; bf16* Y; const float* sw;
    __device__ __forceinline__ void operator()(const Acc& acc, const Unit& u, int wr, int wc, int fr, int fq) const {
        const int r0 = u.pm * 256 + wr * 64 + fr;
        bf16* base = Y + (size_t)r0 * 1024 + u.pn * 256 + wc * 32 + 8 * fq;
#pragma unroll
        for (int ai = 0; ai < 2; ++ai)
#pragma unroll
            for (int m = 0; m < 4; ++m) { bf16* rowp = base + (size_t)(ai * HALF + m * 16) * 1024; const float w8 = sw[r0 + ai * HALF + m * 16];
#pragma unroll
                for (int bj = 0; bj < 2; ++bj) { const f32x4 v0 = acc[ai][bj][m][0] * w8, v1 = acc[ai][bj][m][1] * w8;
                    u32x4 w; w.x = cvt_pk_bf16(v0[0], v0[1]); w.y = cvt_pk_bf16(v0[2], v0[3]); w.z = cvt_pk_bf16(v1[0], v1[1]); w.w = cvt_pk_bf16(v1[2], v1[3]);
                    *(u32x4*)(rowp + bj * HALF) = w; } }
    }
};
}
struct Frame {
    LAS unsigned char* lds; int tid, lane, wave, G, bid;
    unsigned char* ws;
};
__device__ __forceinline__ const float* karg(int i) {
    unsigned long long p = (unsigned long long)__builtin_amdgcn_kernarg_segment_ptr();
    asm volatile("" : "+s"(p));
    return ((const float* const __attribute__((address_space(4)))*)p)[i];
}
#define KIN(i) karg(i)
enum { I_X = 0, I_C, I_CTX, I_CCTX, I_ADAW, I_ADAB, I_WIN, I_RPB, I_WONA, I_WFOUR, I_DECF, I_DECB, I_GNW, I_WORET, I_WOUT, I_LNMW, I_LNMB,
       I_ROUTW, I_ROUTB, I_EWG, I_EWU, I_EWD, I_SWG, I_SWU, I_SWD, I_LNFW, I_LNFB };
#define WSP(T, off) ((T*)(F.ws + (off)))
constexpr int NWAVES = 8;

__device__ __forceinline__ void tr_item(const float* W, int N, int k0, int n0, bf16* WT, int ldt, int drow0, LAS float* scr, int lane) {
#pragma unroll 8
    for (int i = 0; i < 32; ++i) { const int kk = 2 * i + (lane >> 5); scr[kk * 33 + (lane & 31)] = W[(size_t)(k0 + kk) * N + n0 + (lane & 31)]; }
    LDS_WAIT(); asm volatile("" ::: "memory");
    const int c = lane & 7;
#pragma unroll
    for (int j = 0; j < 4; ++j) { const int n = (lane >> 3) + 8 * j; const LAS float* s = scr + (8 * c) * 33 + n;
        u32x4 o; o.x = pk2(s[0 * 33], s[1 * 33]); o.y = pk2(s[2 * 33], s[3 * 33]); o.z = pk2(s[4 * 33], s[5 * 33]); o.w = pk2(s[6 * 33], s[7 * 33]);
        *(u32x4*)(WT + (size_t)(drow0 + n) * ldt + k0 + 8 * c) = o; }
    LDS_WAIT(); asm volatile("" ::: "memory");
}

__device__ __forceinline__ void row_load(const float* p, int lane, f32x4 (&v)[4]) {
#pragma unroll
    for (int j = 0; j < 4; ++j) v[j] = *(const f32x4*)(p + 4 * lane + 256 * j);
}
__device__ __forceinline__ void row_ln(f32x4 (&v)[4]) {
    float s = 0.f;
#pragma unroll
    for (int j = 0; j < 4; ++j) s += (v[j][0] + v[j][1]) + (v[j][2] + v[j][3]);
    const float mean = wave_sum(s) * (1.f / D); float s2 = 0.f;
#pragma unroll
    for (int j = 0; j < 4; ++j) { v[j] = v[j] - mean; s2 += (v[j][0] * v[j][0] + v[j][1] * v[j][1]) + (v[j][2] * v[j][2] + v[j][3] * v[j][3]); }
    const float rstd = 1.f / sqrtf(wave_sum(s2) * (1.f / D) + LN_EPS);
#pragma unroll
    for (int j = 0; j < 4; ++j) v[j] = v[j] * rstd;
}
__device__ __forceinline__ void row_affine(f32x4 (&v)[4], const float* w, const float* b, int lane, bool one_plus) {
#pragma unroll
    for (int j = 0; j < 4; ++j) { f32x4 ww = *(const f32x4*)(w + 4 * lane + 256 * j); const f32x4 bb = *(const f32x4*)(b + 4 * lane + 256 * j);
        if (one_plus) ww = ww + 1.f; v[j] = v[j] * ww + bb; }
}
__device__ __forceinline__ void row_store_bf16(bf16* p, int lane, const f32x4 (&v)[4]) {
#pragma unroll
    for (int j = 0; j < 4; ++j) { u32x2 w; w.x = pk2(v[j][0], v[j][1]); w.y = pk2(v[j][2], v[j][3]); *(u32x2*)(p + 4 * lane + 256 * j) = w; }
}
__device__ __forceinline__ void row_store_f32(float* p, int lane, const f32x4 (&v)[4]) {
#pragma unroll
    for (int j = 0; j < 4; ++j) *(f32x4*)(p + 4 * lane + 256 * j) = v[j];
}
__device__ __forceinline__ const float* mod_vec(const Frame& F, int l, int row) {
    const int v = row >= T_LAT ? 8 : row / NSEQ; return WSP(const float, WS_MOD) + ((size_t)l * 9 + v) * 6144;
}

__device__ __forceinline__ void phase_init(const Frame& F_) {
    Frame F = F_; asm volatile("" : "+v"(F.tid)); F.lane = F.tid & 63;
    const int gw = F.bid * NWAVES + F.wave, NGW = F.G * NWAVES;
    {
        LAS float* red = (LAS float*)F.lds;
        float* mod = WSP(float, WS_MOD);
        for (int u = F.bid; u < 2 * 96; u += F.G) {
            const int l = u / 96, n0 = (u % 96) * 64;
            const float* aw = KIN(I_ADAW) + (size_t)l * D * 6144;
            float acc[9];
#pragma unroll
            for (int v = 0; v < 9; ++v) acc[v] = 0.f;
            for (int k = F.wave * 128; k < F.wave * 128 + 128; ++k) {
                const float wv = aw[(size_t)k * 6144 + n0 + F.lane];
#pragma unroll
                for (int v = 0; v < 9; ++v) { const float cv = v < 8 ? KIN(I_C)[v * D + k] : KIN(I_CCTX)[k]; acc[v] += siluf_(cv) * wv; }
            }
#pragma unroll
            for (int v = 0; v < 9; ++v) red[(F.wave * 9 + v) * 64 + F.lane] = acc[v];
            __syncthreads();
            for (int o = F.tid; o < 9 * 64; o += 512) { const int v = o / 64, ln = o % 64; float s = 0.f;
#pragma unroll
                for (int w = 0; w < 8; ++w) s += red[(w * 9 + v) * 64 + ln];
                mod[((size_t)l * 9 + v) * 6144 + n0 + ln] = s + KIN(I_ADAB)[(size_t)l * 6144 + n0 + ln]; }
            __syncthreads();
        }
    }
    {
        float* rc = WSP(float, WS_ROPE); float* rs = rc + 2048;
        for (int i = F.bid * 512 + F.tid; i < 2048; i += F.G * 512) { const int pos = i / 32, f = i % 32;
            const double ang = (double)pos * pow(10000.0, -(double)f / 32.0); rc[i] = (float)cos(ang); rs[i] = (float)sin(ang); }
    }
    {
        bf16* dft = WSP(bf16, WS_DFT); const float sc = 1.0f / 724.0773439350247f;
        for (size_t i = (size_t)F.bid * 512 + F.tid; i < (size_t)8192 * 512; i += (size_t)F.G * 512) {
            const int row = (int)(i / 512), n0 = (int)(i % 512) * 8, reim = row / 4096, np = row % 4096; float v[8];
#pragma unroll
            for (int j = 0; j < 8; ++j) { const int m = ((n0 + j) * np) & 4095; const float x = (float)m * (1.0f / 2048.0f); v[j] = (reim ? -sinpif(x) : cospif(x)) * sc; }
            u32x4 o; o.x = pk2(v[0], v[1]); o.y = pk2(v[2], v[3]); o.z = pk2(v[4], v[5]); o.w = pk2(v[6], v[7]);
            *(u32x4*)(dft + (size_t)row * 4096 + n0) = o;
        }
        bf16* dftc = WSP(bf16, WS_DFTC); const float scc = 1.0f / 181.01933598375618f;
        for (int i = F.bid * 512 + F.tid; i < 512 * 32; i += F.G * 512) {
            const int row = i / 32, n0 = (i % 32) * 8, reim = row / 256, np = row % 256; float v[8];
#pragma unroll
            for (int j = 0; j < 8; ++j) { const int m = ((n0 + j) * np) & 255; const float x = (float)m * (1.0f / 128.0f); v[j] = (reim ? -sinpif(x) : cospif(x)) * scc; }
            u32x4 o; o.x = pk2(v[0], v[1]); o.y = pk2(v[2], v[3]); o.z = pk2(v[4], v[5]); o.w = pk2(v[6], v[7]);
            *(u32x4*)(dftc + (size_t)row * 256 + n0) = o;
        }
    }
    {
        LAS float* scr = (LAS float*)(F.lds + 16384 + F.wave * 16384);
        constexpr int I_IN = 16 * 256, I_NA = 8 * 32, I_RET = 16 * 32, I_OUT = 16 * 32, I_RT = 16 * 8, PER = I_IN + I_NA + I_RET + I_OUT + I_RT;
        for (int it = gw; it < 2 * PER; it += NGW) {
            const int l = it / PER; int r = it % PER; unsigned char* wb = F.ws + WS_WNE + (size_t)l * WNE_STRIDE;
            const float* W; int K, N; bf16* WT;
            if (r < I_IN) { W = KIN(I_WIN) + (size_t)l * 1024 * 8192; K = 1024; N = 8192; WT = (bf16*)(wb + WNE_WIN); }
            else if ((r -= I_IN) < I_NA) { W = KIN(I_WONA) + (size_t)l * 512 * 1024; K = 512; N = 1024; WT = (bf16*)(wb + WNE_ONA); }
            else if ((r -= I_NA) < I_RET) { W = KIN(I_WORET) + (size_t)l * 1024 * 1024; K = 1024; N = 1024; WT = (bf16*)(wb + WNE_ORET); }
            else if ((r -= I_RET) < I_OUT) { W = KIN(I_WOUT) + (size_t)l * 1024 * 1024; K = 1024; N = 1024; WT = (bf16*)(wb + WNE_WOUT); }
            else { r -= I_OUT; W = KIN(I_ROUTW) + (size_t)l * 1024 * 256; K = 1024; N = 256; WT = (bf16*)(wb + WNE_ROUT); }
            const int nblk = N / 32, kb = r / nblk, nb = r % nblk;
            tr_item(W, N, kb * 64, nb * 32, WT, K, nb * 32, scr, F.lane);
        }
        for (int it = gw; it < 2 * 1024 * 16; it += NGW) {
            const int l = it / (1024 * 16), r = it % (1024 * 16), kk = r / 16, nb = r % 16, reim = kk / 512, g = (kk % 512) / 128, c = kk % 128, n = nb * 64 + F.lane;
            const float* wf = KIN(I_WFOUR) + (size_t)l * 512 * 1024 + (size_t)g * 128 * 1024 + n; float acc = 0.f;
            for (int cp = 0; cp < 128; ++cp) { const float x = (float)((c * cp) & 127) * (1.0f / 64.0f); const float gv = reim ? sinpif(x) : cospif(x); acc += gv * wf[(size_t)cp * 1024]; }
            bf16* WT = (bf16*)(F.ws + WS_WNE + (size_t)l * WNE_STRIDE + WNE_WF);
            WT[(size_t)n * 1024 + kk] = (bf16)f2bf(acc);
        }
    }
}

__device__ __forceinline__ void phase_prep(const Frame& F_, int l) {
    Frame F = F_; asm volatile("" : "+v"(F.tid)); F.lane = F.tid & 63;
    const int gw = F.bid * NWAVES + F.wave, NGW = F.G * NWAVES;
    LAS float* scr = (LAS float*)(F.lds + F.wave * 16384);
    bf16* WGU = WSP(bf16, WS_WGU); bf16* WD = WSP(bf16, WS_WD);
    for (int it = gw; it < 257 * 384; it += NGW) {
        const int e = it / 384, r = it % 384, which = r / 128, q = r % 128;
        if (which < 2) {
            const float* We = which ? KIN(I_EWU) : KIN(I_EWG); const float* Ws = which ? KIN(I_SWU) : KIN(I_SWG);
            const float* W = e < 256 ? We + ((size_t)l * 256 + e) * 1024 * 256 : Ws + (size_t)l * 1024 * 256;
            const int kb = q / 8, nb = q % 8, n0 = nb * 32;
            tr_item(W, 256, kb * 64, n0, WGU + (size_t)e * 512 * 1024, 1024, 256 * (n0 / 128) + (n0 % 128) + which * 128, scr, F.lane);
        } else {
            const float* W = e < 256 ? KIN(I_EWD) + ((size_t)l * 256 + e) * 256 * 1024 : KIN(I_SWD) + (size_t)l * 256 * 1024;
            const int kb = q / 32, nb = q % 32;
            tr_item(W, 1024, kb * 64, nb * 32, WD + (size_t)e * 1024 * 256, 256, nb * 32, scr, F.lane);
        }
    }
    if (l == 0) {
        bf16* H = WSP(bf16, WS_H);
        for (int row = gw; row < T_ALL; row += NGW) {
            const float* src = row < T_LAT ? KIN(I_X) + (size_t)row * D : KIN(I_CTX) + (size_t)(row - T_LAT) * D;
            f32x4 v[4]; row_load(src, F.lane, v); row_ln(v);
            const float* mv = mod_vec(F, 0, row); row_affine(v, mv + 1024, mv, F.lane, true);
            row_store_bf16(H + (size_t)row * D, F.lane, v);
        }
    }
}

__device__ __forceinline__ void phase_ln_mix(const Frame& F_, int l, int nrows) {
    Frame F = F_; asm volatile("" : "+v"(F.tid)); F.lane = F.tid & 63;
    const int gw = F.bid * NWAVES + F.wave, NGW = F.G * NWAVES;
    const float* tm = WSP(const float, WS_TMIX); float* X = WSP(float, WS_X); bf16* H = WSP(bf16, WS_H);
    for (int row = gw; row < nrows; row += NGW) {
        f32x4 v[4]; row_load(tm + (size_t)row * D, F.lane, v); row_ln(v);
        row_affine(v, KIN(I_LNMW) + (size_t)l * D, KIN(I_LNMB) + (size_t)l * D, F.lane, false);
        row_store_f32(X + (size_t)row * D, F.lane, v);
        row_ln(v);
        const float* mv = mod_vec(F, l, row); row_affine(v, mv + 4096, mv + 3072, F.lane, true);
        row_store_bf16(H + (size_t)row * D, F.lane, v);
    }
}
typedef __attribute__((ext_vector_type(4))) float facc;
__device__ __forceinline__ facc mma16(bf16x8 a, bf16x8 b, facc c) { return __builtin_amdgcn_mfma_f32_16x16x32_bf16(a, b, c, 0, 0, 0); }
__device__ __forceinline__ bf16x8 lds_gather8(const LAS bf16* p, int stride) {
    bf16x8 r;
#pragma unroll
    for (int j = 0; j < 8; ++j) r[j] = (short)p[j * stride];
    return r;
}
__device__ __forceinline__ bf16x8 pack8(const facc& a, const facc& b) {
    u32x4 w; w.x = pg8::cvt_pk_bf16(a[0], a[1]); w.y = pg8::cvt_pk_bf16(a[2], a[3]); w.z = pg8::cvt_pk_bf16(b[0], b[1]); w.w = pg8::cvt_pk_bf16(b[2], b[3]);
    return __builtin_bit_cast(bf16x8, w);
}
constexpr float LOG2E = 1.4426950408889634f;

__device__ __forceinline__ void ut_tile(const Frame& F, const bf16* P, int rowbase, int n0, int c0, bf16* UT, int ldn, LAS bf16* tl) {
    const int lane = F.lane;
#pragma unroll
    for (int i = 0; i < 8; ++i) { const int r = (lane >> 3) + 8 * i, pc = lane & 7;
        const u32x4 v = *(const u32x4*)(P + (size_t)(rowbase + n0 + r) * INW + C_UB + c0 + pc * 8);
        LAS unsigned* d = (LAS unsigned*)(tl + r * 66 + pc * 8); d[0] = v.x; d[1] = v.y; d[2] = v.z; d[3] = v.w; }
    LDS_WAIT(); asm volatile("" ::: "memory");
#pragma unroll
    for (int i = 0; i < 8; ++i) { const int ch = (lane >> 3) + 8 * i, np = lane & 7;
        const bf16x8 v = lds_gather8(tl + (np * 8) * 66 + ch, 66);
        *(bf16x8*)(UT + (size_t)(c0 + ch) * ldn + n0 + np * 8) = v; }
    LDS_WAIT(); asm volatile("" ::: "memory");
}
__device__ __forceinline__ void phase_ut(const Frame& F_, int l) {
    Frame F = F_; asm volatile("" : "+v"(F.tid)); F.lane = F.tid & 63;
    const int gw = F.bid * NWAVES + F.wave, NGW = F.G * NWAVES;
    const bf16* P = WSP(const bf16, WS_P); LAS bf16* tl = (LAS bf16*)(F.lds + F.wave * 8704);
    const int ntl = NB * 64 * 8, ntc = (l == 0) ? NB * 4 * 8 : 0;
    for (int it = gw; it < ntl + ntc; it += NGW) {
        if (it < ntl) { const int b = it / 512, r = it % 512; ut_tile(F, P, b * NSEQ, (r / 8) * 64, (r % 8) * 64, WSP(bf16, WS_UT) + (size_t)b * 512 * 4096, 4096, tl); }
        else { const int q = it - ntl, b = q / 32, r = q % 32; ut_tile(F, P, T_LAT + b * NCTX, (r / 8) * 64, (r % 8) * 64, WSP(bf16, WS_UTC) + (size_t)b * 512 * 256, 256, tl); }
    }
}

constexpr int NA_VP = 72, NA_CTXBASE = 576, NA_RPB_OFF = 832 * NA_VP * 2;
template <bool WIN>
__device__ __forceinline__ void na_chunk(const Frame& F, const char* kb  , const bf16x8 (&qf)[2], int kidx0  ,
                                         int kc0, int qrow_minus_r0, int qc, float& m, float& lsum, facc (&o)[4]) {
    const int lane = F.lane, fr = lane & 15, g = lane >> 4;
    const LAS float* rpb = (const LAS float*)(F.lds + NA_RPB_OFF);
    const int c0 = qc - 8 < 0 ? 0 : (qc - 8 > 48 ? 48 : qc - 8);
    const unsigned lane_off = (unsigned)(fr * INW + 8 * g) * 2u;
    facc s[16];
#pragma unroll
    for (int t = 0; t < 16; ++t) {
        const char* kp = WIN ? kb + (size_t)((t >> 1) * 64 + 16 * (t & 1)) * INW * 2 : kb + (size_t)(16 * t) * INW * 2;
        const bf16x8 k0 = *(const bf16x8*)(kp + lane_off), k1 = *(const bf16x8*)(kp + lane_off + 64);
        facc a = {0.f, 0.f, 0.f, 0.f};
        a = mma16(k0, qf[0], a); a = mma16(k1, qf[1], a);
        if (WIN) {
            const int dr = (t >> 1) - qrow_minus_r0 + 7;
#pragma unroll
            for (int r = 0; r < 4; ++r) { const int kc = kc0 + 16 * (t & 1) + 4 * g + r; int dc = kc - qc; dc = dc < -15 ? -15 : (dc > 15 ? 15 : dc);
                const bool ok = kc >= c0 && kc < c0 + 16; const float bias = rpb[dr * 31 + dc + 15];
                const float sv = a[r] * 0.125f + bias; a[r] = ok ? sv : -1e30f; }
        } else {
#pragma unroll
            for (int r = 0; r < 4; ++r) a[r] *= 0.125f;
        }
        s[t] = a;
        if ((t & 1) == 1) __builtin_amdgcn_sched_barrier(0);
    }
    float mx = -1e30f;
#pragma unroll
    for (int t = 0; t < 16; ++t) mx = fmaxf(mx, fmaxf(fmaxf(s[t][0], s[t][1]), fmaxf(s[t][2], s[t][3])));
    mx = fmaxf(mx, __shfl_xor(mx, 16)); mx = fmaxf(mx, __shfl_xor(mx, 32));
    const float mn = fmaxf(m, mx), alpha = __builtin_amdgcn_exp2f((m - mn) * LOG2E);
    m = mn; lsum *= alpha;
#pragma unroll
    for (int dt = 0; dt < 4; ++dt) o[dt] = o[dt] * alpha;
#pragma unroll
    for (int t = 0; t < 16; ++t) {
#pragma unroll
        for (int r = 0; r < 4; ++r) { const float p = __builtin_amdgcn_exp2f((s[t][r] - mn) * LOG2E); s[t][r] = p; lsum += p; }
    }
#pragma unroll
    for (int i = 0; i < 8; ++i) {
        const bf16x8 pb = pack8(s[2 * i], s[2 * i + 1]);
        const int kidx = WIN ? kidx0 + i * 64 : kidx0 + 32 * i;
        unsigned vbase = (unsigned)(kidx + 4 * g) * (NA_VP * 2) + fr * 2;
        asm volatile("" : "+v"(vbase));
        const LAS bf16* vp = (const LAS bf16*)(F.lds + vbase);
#pragma unroll
        for (int dt = 0; dt < 4; ++dt) {
            bf16x8 va;
#pragma unroll
            for (int j = 0; j < 4; ++j) { va[j] = (short)vp[j * NA_VP + 16 * dt]; va[4 + j] = (short)vp[(16 + j) * NA_VP + 16 * dt]; }
            o[dt] = mma16(va, pb, o[dt]);
        }
        __builtin_amdgcn_sched_barrier(0);
    }
}
template <bool CTX>
__device__ __forceinline__ void na_wave(const Frame& F, const bf16* P, bf16* YNA, int h, int tq  , int ctxrow0, int krow_tok0  ,
                                        int kc0, int kidx_w0  , int qrow_minus_r0  , int qc  ) {
    const int lane = F.lane, g = lane >> 4;
    bf16x8 qf[2];
#pragma unroll
    for (int ks = 0; ks < 2; ++ks) qf[ks] = *(const bf16x8*)(P + (size_t)tq * INW + C_QA + h * 64 + ks * 32 + 8 * g);
    float m = -1e30f, lsum = 0.f; facc o[4];
#pragma unroll
    for (int dt = 0; dt < 4; ++dt) o[dt] = (facc){0.f, 0.f, 0.f, 0.f};
    if (!CTX) na_chunk<true>(F, (const char*)P + ((size_t)(krow_tok0 + kc0) * INW + C_KA + h * 64) * 2, qf, kidx_w0, kc0, qrow_minus_r0, qc, m, lsum, o);
    na_chunk<false>(F, (const char*)P + ((size_t)ctxrow0 * INW + C_KA + h * 64) * 2, qf, NA_CTXBASE, 0, 0, 0, m, lsum, o);
    lsum += __shfl_xor(lsum, 16); lsum += __shfl_xor(lsum, 32);
    const float inv = 1.f / lsum;
#pragma unroll
    for (int dt = 0; dt < 4; ++dt) { u32x2 w; w.x = pk2(o[dt][0] * inv, o[dt][1] * inv); w.y = pk2(o[dt][2] * inv, o[dt][3] * inv);
        *(u32x2*)(YNA + (size_t)tq * 512 + h * 64 + 16 * dt + 4 * g) = w; }
}
__device__ __forceinline__ void na_load_keys(const Frame& F, const bf16* P, int h, int tokrow0, int nkeys, int kidx0) {
    LAS bf16* Vl = (LAS bf16*)F.lds;
    for (int i = F.tid; i < nkeys * 8; i += 512) { const int key = i >> 3, pc = i & 7;
        const u32x4 v = *(const u32x4*)(P + (size_t)(tokrow0 + key) * INW + C_VA + h * 64 + pc * 8);
        LAS unsigned* d = (LAS unsigned*)(Vl + (kidx0 + key) * NA_VP + pc * 8); d[0] = v.x; d[1] = v.y; d[2] = v.z; d[3] = v.w; }
}
__device__ __forceinline__ void phase_na(const Frame& F_, int l) {
    Frame F = F_; asm volatile("" : "+v"(F.tid)); F.lane = F.tid & 63;
    const bf16* P = WSP(const bf16, WS_P); bf16* YNA = WSP(bf16, WS_YNA);
    const int nlat = NB * 8 * 32, nctx = (l == 0) ? NB * 8 : 0;
    LAS float* rpb = (LAS float*)(F.lds + NA_RPB_OFF);
    for (int u = F.bid; u < nlat + nctx; u += F.G) {
        __syncthreads();
        if (u < nlat) {
            const int b = u / 256, h = (u % 256) / 32, rp = u % 32, ra_ = 2 * rp, rb_ = 2 * rp + 1;
            const int r0a = ra_ - 4 < 0 ? 0 : (ra_ - 4 > 56 ? 56 : ra_ - 4), r0b = rb_ - 4 < 0 ? 0 : (rb_ - 4 > 56 ? 56 : rb_ - 4);
            const int nrows = r0b + 8 - r0a;
            na_load_keys(F, P, h, b * NSEQ + r0a * 64, nrows * 64, 0);
            na_load_keys(F, P, h, T_LAT + b * NCTX, NCTX, NA_CTXBASE);
            for (int i = F.tid; i < 15 * 31; i += 512) rpb[i] = KIN(I_RPB)[((size_t)l * 8 + h) * 465 + i];
            __syncthreads();
            const int qrow = (F.wave >> 2) ? rb_ : ra_, j = F.wave & 3, r0 = (F.wave >> 2) ? r0b : r0a;
            const int kc0 = (j == 0) ? 0 : (j == 1 ? 8 : (j == 2 ? 24 : 32));
            const int qc = 16 * j + (F.lane & 15);
            na_wave<false>(F, P, YNA, h, b * NSEQ + qrow * 64 + qc, T_LAT + b * NCTX, b * NSEQ + r0 * 64, kc0, (r0 - r0a) * 64 + kc0, qrow - r0, qc);
        } else {
            const int q = u - nlat, b = q / 8, h = q % 8;
            na_load_keys(F, P, h, T_LAT + b * NCTX, NCTX, NA_CTXBASE);
            __syncthreads();
#pragma unroll 1
            for (int qt = F.wave; qt < 16; qt += 8)
                na_wave<true>(F, P, YNA, h, T_LAT + b * NCTX + qt * 16 + (F.lane & 15), T_LAT + b * NCTX, 0, 0, 0, 0, 0);
        }
    }
    __syncthreads();
}

constexpr int R_KP = 136, R_VP = 264;
constexpr int R_OFF_A = 0, R_OFF_B = 128 * R_KP * 2, R_OFF_V = 2 * 128 * R_KP * 2, R_OFF_RED = R_OFF_V + 128 * R_VP * 2, R_OFF_ST = R_OFF_RED + 8192;
__device__ __forceinline__ float log_sigmoidf_(float x) { return -log1pf(__expf(-x)); }
__device__ __forceinline__ int chunk_row0(int b, int ch) { return ch < 32 ? b * NSEQ + ch * 128 : T_LAT + b * NCTX + (ch - 32) * 128; }
__device__ __forceinline__ void ret_stage_qk(const Frame& F, const bf16* P, int row0, int col0, int ch, LAS bf16* out0, LAS bf16* out1, float lg0, float lg1, int mode  , float scale) {
    const float* rc = WSP(const float, WS_ROPE); const float* rs = rc + 2048;
    for (int i = F.tid; i < 1024; i += 512) {
        const int m = i >> 3, pp = i & 7, d0 = (pp & 3) * 8 + (pp >> 2) * 64;
        const u32x4 a = *(const u32x4*)(P + (size_t)(row0 + m) * INW + col0 + d0), bq = *(const u32x4*)(P + (size_t)(row0 + m) * INW + col0 + d0 + 32);
        float x1[8], x2[8];
        x1[0] = bflo(a.x); x1[1] = bfhi(a.x); x1[2] = bflo(a.y); x1[3] = bfhi(a.y); x1[4] = bflo(a.z); x1[5] = bfhi(a.z); x1[6] = bflo(a.w); x1[7] = bfhi(a.w);
        x2[0] = bflo(bq.x); x2[1] = bfhi(bq.x); x2[2] = bflo(bq.y); x2[3] = bfhi(bq.y); x2[4] = bflo(bq.z); x2[5] = bfhi(bq.z); x2[6] = bflo(bq.w); x2[7] = bfhi(bq.w);
        if (ch < 32) {
            const int n = ch * 128 + m, pos = (pp >> 2) ? (n & 63) : (n >> 6), fi = pos * 32 + (pp & 3) * 8;
#pragma unroll
            for (int e = 0; e < 8; ++e) { const float cs = rc[fi + e], sn = rs[fi + e], y1 = x1[e] * cs - x2[e] * sn, y2 = x1[e] * sn + x2[e] * cs; x1[e] = y1; x2[e] = y2; }
        }
        float w0 = scale, w1 = scale;
        if (mode == 1) { w0 = __expf(lg0 * (float)(127 - m)); w1 = __expf(lg1 * (float)m); }
        {
            LAS unsigned* p1 = (LAS unsigned*)(out0 + m * R_KP + d0); LAS unsigned* p2 = (LAS unsigned*)(out0 + m * R_KP + d0 + 32);
#pragma unroll
            for (int e = 0; e < 4; ++e) { p1[e] = pk2(x1[2 * e] * w0, x1[2 * e + 1] * w0); p2[e] = pk2(x2[2 * e] * w0, x2[2 * e + 1] * w0); }
        }
        if (out1) {
            LAS unsigned* p1 = (LAS unsigned*)(out1 + m * R_KP + d0); LAS unsigned* p2 = (LAS unsigned*)(out1 + m * R_KP + d0 + 32);
#pragma unroll
            for (int e = 0; e < 4; ++e) { p1[e] = pk2(x1[2 * e] * w1, x1[2 * e + 1] * w1); p2[e] = pk2(x2[2 * e] * w1, x2[2 * e + 1] * w1); }
        }
    }
}
__device__ __forceinline__ void ret_stage_v(const Frame& F, const bf16* P, int row0, int col0) {
    LAS bf16* Vl = (LAS bf16*)(F.lds + R_OFF_V);
    for (int i = F.tid; i < 4096; i += 512) { const int m = i >> 5, pc = i & 31;
        const u32x4 v = *(const u32x4*)(P + (size_t)(row0 + m) * INW + col0 + pc * 8);
        LAS unsigned* d = (LAS unsigned*)(Vl + m * R_VP + pc * 8); d[0] = v.x; d[1] = v.y; d[2] = v.z; d[3] = v.w; }
}
__device__ __forceinline__ void phase_r1(const Frame& F_, int l) {
    Frame F = F_; asm volatile("" : "+v"(F.tid)); F.lane = F.tid & 63;
    const bf16* P = WSP(const bf16, WS_P); float* KV = WSP(float, WS_KV);
    const int lane = F.lane, fr0 = lane & 15, g0 = lane >> 4;
    for (int u = F.bid; u < NB * 4 * NCH; u += F.G) {
        const int b = u / (4 * NCH), h = (u / NCH) % 4, ch = u % NCH, row0 = chunk_row0(b, ch);
        const float lgf = log_sigmoidf_(KIN(I_DECF)[l * 4 + h]), lgb = log_sigmoidf_(KIN(I_DECB)[l * 4 + h]);
        int fr = fr0, g = g0; asm volatile("" : "+v"(fr), "+v"(g));
        __syncthreads();
        ret_stage_qk(F, P, row0, C_KR + h * 128, ch, (LAS bf16*)(F.lds + R_OFF_A), (LAS bf16*)(F.lds + R_OFF_B), lgf, lgb, 1, 1.f);
        ret_stage_v(F, P, row0, C_VR + h * 256);
        __syncthreads();
        const int dir = F.wave >> 2, eq = F.wave & 3;
        const LAS bf16* Kl = (const LAS bf16*)(F.lds + (dir ? R_OFF_B : R_OFF_A)); const LAS bf16* Vl = (const LAS bf16*)(F.lds + R_OFF_V);
        facc acc[4][8];
#pragma unroll
        for (int et = 0; et < 4; ++et)
#pragma unroll
            for (int dt = 0; dt < 8; ++dt) acc[et][dt] = (facc){0.f, 0.f, 0.f, 0.f};
#pragma unroll 1
        for (int ks = 0; ks < 4; ++ks) {
            bf16x8 va[4];
#pragma unroll
            for (int et = 0; et < 4; ++et) va[et] = lds_gather8(Vl + (32 * ks + 8 * g) * R_VP + 64 * eq + 16 * et + fr, R_VP);
#pragma unroll
            for (int dt = 0; dt < 8; ++dt) { const bf16x8 kb = lds_gather8(Kl + (32 * ks + 8 * g) * R_KP + 16 * dt + fr, R_KP);
#pragma unroll
                for (int et = 0; et < 4; ++et) acc[et][dt] = mma16(va[et], kb, acc[et][dt]);
                if (dt & 1) __builtin_amdgcn_sched_barrier(0); }
        }
        float* out = KV + ((((size_t)(b * 4 + h) * NCH + ch) * 2 + dir) << 15);
#pragma unroll
        for (int et = 0; et < 4; ++et)
#pragma unroll
            for (int dt = 0; dt < 8; ++dt)
#pragma unroll
                for (int r = 0; r < 4; ++r) out[(size_t)(64 * eq + 16 * et + 4 * g + r) * 128 + 16 * dt + fr] = acc[et][dt][r];
    }
    __syncthreads();
}
__device__ __forceinline__ void phase_r2(const Frame& F_, int l) {
    Frame F = F_; asm volatile("" : "+v"(F.tid)); F.lane = F.tid & 63;
    const float* KV = WSP(const float, WS_KV); bf16* SP = WSP(bf16, WS_SPREV);
    for (int id = F.bid * 512 + F.tid; id < 64 * 4096; id += F.G * 512) {
        const int comb = id >> 12, el = (id & 4095) * 8, bh = comb >> 1, dir = comb & 1, h = bh & 3;
        const float lg = log_sigmoidf_(dir ? KIN(I_DECB)[l * 4 + h] : KIN(I_DECF)[l * 4 + h]), gC = __expf(lg * 128.f);
        float S[8];
#pragma unroll
        for (int j = 0; j < 8; ++j) S[j] = 0.f;
#pragma unroll 1
        for (int s0 = 0; s0 < NCH; s0 += 8) {
            f32x4 kv[8][2];
#pragma unroll
            for (int q = 0; q < 8; ++q) { const int s = s0 + q;
                if (s < NCH) { const int ch = dir == 0 ? (s < 2 ? 32 + s : s - 2) : (s < 2 ? 33 - s : 33 - s);
                    const float* p = KV + ((((size_t)bh * NCH + ch) * 2 + dir) << 15) + el; kv[q][0] = *(const f32x4*)p; kv[q][1] = *(const f32x4*)(p + 4); } }
#pragma unroll
            for (int q = 0; q < 8; ++q) { const int s = s0 + q;
                if (s < NCH) { const int ch = dir == 0 ? (s < 2 ? 32 + s : s - 2) : (s < 2 ? 33 - s : 33 - s);
                    u32x4 w; w.x = pk2(S[0], S[1]); w.y = pk2(S[2], S[3]); w.z = pk2(S[4], S[5]); w.w = pk2(S[6], S[7]);
                    *(u32x4*)(SP + ((((size_t)bh * NCH + ch) * 2 + dir) << 15) + el) = w;
#pragma unroll
                    for (int j = 0; j < 4; ++j) { S[j] = gC * S[j] + kv[q][0][j]; S[4 + j] = gC * S[4 + j] + kv[q][1][j]; } } }
        }
    }
}
__device__ __forceinline__ void phase_r3(const Frame& F_, int l) {
    Frame F = F_; asm volatile("" : "+v"(F.tid)); F.lane = F.tid & 63;
    const bf16* P = WSP(const bf16, WS_P); const bf16* SP = WSP(const bf16, WS_SPREV); bf16* YR = WSP(bf16, WS_YRET);
    const int lane = F.lane, fr0 = lane & 15, g0 = lane >> 4, w = F.wave;
    const int nch = (l == 0) ? NCH : 32;
    LAS bf16* Ql = (LAS bf16*)(F.lds + R_OFF_A); LAS bf16* Kl = (LAS bf16*)(F.lds + R_OFF_B); const LAS bf16* Vl = (const LAS bf16*)(F.lds + R_OFF_V);
    LAS float* red = (LAS float*)(F.lds + R_OFF_RED); LAS float* stt = (LAS float*)(F.lds + R_OFF_ST);
    for (int u = F.bid; u < NB * 4 * nch; u += F.G) {
        const int b = u / (4 * nch), h = (u / nch) % 4, ch = u % nch, row0 = chunk_row0(b, ch);
        const float lgf = log_sigmoidf_(KIN(I_DECF)[l * 4 + h]), lgb = log_sigmoidf_(KIN(I_DECB)[l * 4 + h]);
        int fr = fr0, g = g0; asm volatile("" : "+v"(fr), "+v"(g));
        __syncthreads();
        ret_stage_qk(F, P, row0, C_QR + h * 128, ch, Ql, nullptr, 0.f, 0.f, 0, 0.08838834764831845f);
        ret_stage_qk(F, P, row0, C_KR + h * 128, ch, Kl, nullptr, 0.f, 0.f, 0, 1.f);
        ret_stage_v(F, P, row0, C_VR + h * 256);
        __syncthreads();
        facc st[8];
#pragma unroll
        for (int mt = 0; mt < 8; ++mt) st[mt] = (facc){0.f, 0.f, 0.f, 0.f};
#pragma unroll
        for (int ks = 0; ks < 4; ++ks) {
            const bf16x8 qb = *(const LAS bf16x8*)(Ql + (16 * w + fr) * R_KP + 32 * ks + 8 * g);
#pragma unroll
            for (int mt = 0; mt < 8; ++mt) { const bf16x8 ka = *(const LAS bf16x8*)(Kl + (16 * mt + fr) * R_KP + 32 * ks + 8 * g); st[mt] = mma16(ka, qb, st[mt]); }
        }
        __syncthreads();
        {
            const int c = 16 * w + fr;
#pragma unroll
            for (int mt = 0; mt < 8; ++mt) { float v[4];
#pragma unroll
                for (int r = 0; r < 4; ++r) { const int m = 16 * mt + 4 * g + r; const float dcy = (c >= m) ? __expf(lgf * (float)(c - m)) : __expf(lgb * (float)(m - c)); v[r] = st[mt][r] * dcy; }
                u32x2 pw; pw.x = pk2(v[0], v[1]); pw.y = pk2(v[2], v[3]);
                *(LAS u32x2*)(Kl + c * R_KP + 16 * mt + 4 * g) = pw; }
        }
        __syncthreads();
        facc acc[2][8], X[2][8];
#pragma unroll
        for (int et = 0; et < 2; ++et)
#pragma unroll
            for (int ct = 0; ct < 8; ++ct) acc[et][ct] = (facc){0.f, 0.f, 0.f, 0.f};
#pragma unroll 1
        for (int ks = 0; ks < 4; ++ks) {
            bf16x8 va[2];
#pragma unroll
            for (int et = 0; et < 2; ++et) va[et] = lds_gather8(Vl + (32 * ks + 8 * g) * R_VP + 32 * w + 16 * et + fr, R_VP);
#pragma unroll
            for (int ct = 0; ct < 8; ++ct) { const bf16x8 pb = *(const LAS bf16x8*)(Kl + (16 * ct + fr) * R_KP + 32 * ks + 8 * g);
#pragma unroll
                for (int et = 0; et < 2; ++et) acc[et][ct] = mma16(va[et], pb, acc[et][ct]); }
            __builtin_amdgcn_sched_barrier(0);
        }
#pragma unroll 1
        for (int dir = 0; dir < 2; ++dir) {
            const bf16* sp = SP + ((((size_t)(b * 4 + h) * NCH + ch) * 2 + dir) << 15);
#pragma unroll
            for (int et = 0; et < 2; ++et)
#pragma unroll
                for (int ct = 0; ct < 8; ++ct) X[et][ct] = (facc){0.f, 0.f, 0.f, 0.f};
#pragma unroll
            for (int ks = 0; ks < 4; ++ks) {
                bf16x8 sa[2];
#pragma unroll
                for (int et = 0; et < 2; ++et) sa[et] = *(const bf16x8*)(sp + (size_t)(32 * w + 16 * et + fr) * 128 + 32 * ks + 8 * g);
#pragma unroll
                for (int ct = 0; ct < 8; ++ct) { const bf16x8 qb = *(const LAS bf16x8*)(Ql + (16 * ct + fr) * R_KP + 32 * ks + 8 * g);
#pragma unroll
                    for (int et = 0; et < 2; ++et) X[et][ct] = mma16(sa[et], qb, X[et][ct]); }
                __builtin_amdgcn_sched_barrier(0);
            }
#pragma unroll
            for (int ct = 0; ct < 8; ++ct) { const int c = 16 * ct + fr; const float dq = dir == 0 ? __expf(lgf * (float)(c + 1)) : __expf(lgb * (float)(128 - c));
#pragma unroll
                for (int et = 0; et < 2; ++et) acc[et][ct] += X[et][ct] * dq; }
        }
#pragma unroll
        for (int ct = 0; ct < 8; ++ct) { float s = 0.f, ss = 0.f;
#pragma unroll
            for (int et = 0; et < 2; ++et)
#pragma unroll
                for (int r = 0; r < 4; ++r) { const float v = acc[et][ct][r]; s += v; ss += v * v; }
            s += __shfl_xor(s, 16); s += __shfl_xor(s, 32); ss += __shfl_xor(ss, 16); ss += __shfl_xor(ss, 32);
            if (g == 0) { red[(w * 128 + 16 * ct + fr) * 2] = s; red[(w * 128 + 16 * ct + fr) * 2 + 1] = ss; } }
        __syncthreads();
        if (F.tid < 128) { float s = 0.f, ss = 0.f;
#pragma unroll
            for (int q = 0; q < 8; ++q) { s += red[(q * 128 + F.tid) * 2]; ss += red[(q * 128 + F.tid) * 2 + 1]; }
            const float mean = s * (1.f / 256.f), var = fmaxf(ss * (1.f / 256.f) - mean * mean, 0.f);
            stt[F.tid * 2] = mean; stt[F.tid * 2 + 1] = 1.f / sqrtf(var + GN_EPS); }
        __syncthreads();
        const float* gnw = KIN(I_GNW) + (size_t)l * 1024 + h * 256;
#pragma unroll
        for (int et = 0; et < 2; ++et) { const int e = 32 * w + 16 * et + 4 * g; const f32x4 gw4 = *(const f32x4*)(gnw + e);
#pragma unroll
            for (int ct = 0; ct < 8; ++ct) { const int c = 16 * ct + fr; const float mean = stt[c * 2], rstd = stt[c * 2 + 1];
                const size_t tok = (size_t)(row0 + c);
                const u32x2 gt = *(const u32x2*)(P + tok * INW + C_GR + h * 256 + e);
                const float g0 = bflo(gt.x), g1 = bfhi(gt.x), g2 = bflo(gt.y), g3 = bfhi(gt.y);
                const float y0 = (acc[et][ct][0] - mean) * rstd * gw4[0] * siluf_(g0), y1 = (acc[et][ct][1] - mean) * rstd * gw4[1] * siluf_(g1);
                const float y2 = (acc[et][ct][2] - mean) * rstd * gw4[2] * siluf_(g2), y3 = (acc[et][ct][3] - mean) * rstd * gw4[3] * siluf_(g3);
                u32x2 o; o.x = pk2(y0, y1); o.y = pk2(y2, y3);
                *(u32x2*)(YR + tok * 1024 + h * 256 + e) = o; } }
    }
    __syncthreads();
}
__device__ __forceinline__ void phase_topk(const Frame& F_, int l, int Tm) {
    Frame F = F_; asm volatile("" : "+v"(F.tid)); F.lane = F.tid & 63;
    const int gw = F.bid * NWAVES + F.wave, NGW = F.G * NWAVES, lane = F.lane;
    const float* LG = WSP(const float, WS_LOGIT); int* TE = WSP(int, WS_TOPE); float* TW = WSP(float, WS_TOPW); int* TP = WSP(int, WS_TPOS);
    unsigned* cnt = WSP(unsigned, WS_CTL) + CW_CNT + l * 256;
    const f32x4 bias = *(const f32x4*)(KIN(I_ROUTB) + (size_t)l * 256 + 4 * lane);
    const float NEG = -__builtin_inff();
    for (int t = gw; t < Tm; t += NGW) {
        const f32x4 lg = *(const f32x4*)(LG + (size_t)t * 256 + 4 * lane);
        float sc[4], v[4];
#pragma unroll
        for (int i = 0; i < 4; ++i) { sc[i] = sigmoidf_(lg[i]); v[i] = sc[i] + bias[i]; }
        float m1 = fmaxf(fmaxf(v[0], v[1]), fmaxf(v[2], v[3]));
        float m2;
        { const float a = fmaxf(v[0], v[1]), b = fminf(v[0], v[1]), c = fmaxf(v[2], v[3]), d = fminf(v[2], v[3]); m2 = fmaxf(fminf(a, c), fmaxf(b, d)); }
#pragma unroll
        for (int o = 1; o < 8; o <<= 1) { const float b1 = __shfl_xor(m1, o), b2 = __shfl_xor(m2, o); const float n1 = fmaxf(m1, b1), n2 = fmaxf(fminf(m1, b1), fmaxf(m2, b2)); m1 = n1; m2 = n2; }
        const float gs = m1 + m2; const int grp = lane >> 3; int rank = 0;
#pragma unroll
        for (int j = 0; j < 8; ++j) { const float o = __shfl(gs, j * 8); rank += (o > gs || (o == gs && j < grp)) ? 1 : 0; }
        if (rank >= 4) { v[0] = NEG; v[1] = NEG; v[2] = NEG; v[3] = NEG; }
        int my_e = 0; float my_w = 0.f, wsum = 0.f;
#pragma unroll 1
        for (int k = 0; k < 8; ++k) {
            float bv = v[0]; int bi = 4 * lane;
#pragma unroll
            for (int i = 1; i < 4; ++i) if (v[i] > bv) { bv = v[i]; bi = 4 * lane + i; }
#pragma unroll
            for (int o = 1; o < 64; o <<= 1) { const float ov = __shfl_xor(bv, o); const int oi = __shfl_xor(bi, o); if (ov > bv || (ov == bv && oi < bi)) { bv = ov; bi = oi; } }
            const int own = bi >> 2, sub = bi & 3;
            const float mysc = sub == 0 ? sc[0] : (sub == 1 ? sc[1] : (sub == 2 ? sc[2] : sc[3]));
            const float wv = __shfl(mysc, own);
            if (lane == own) { if (sub == 0) v[0] = NEG; else if (sub == 1) v[1] = NEG; else if (sub == 2) v[2] = NEG; else v[3] = NEG; }
            wsum += wv; if (lane == k) { my_e = bi; my_w = wv; }
        }
        if (lane < 8) {
            TE[(size_t)t * 8 + lane] = my_e; TW[(size_t)t * 8 + lane] = my_w / wsum * 2.5f;
            TP[(size_t)t * 8 + lane] = (int)__hip_atomic_fetch_add(&cnt[my_e], 1u, __ATOMIC_RELAXED, __HIP_MEMORY_SCOPE_AGENT);
        }
    }
}
__device__ __forceinline__ void phase_slots(const Frame& F_, int l, int Tm) {
    Frame F = F_; asm volatile("" : "+v"(F.tid)); F.lane = F.tid & 63;
    const int gw = F.bid * NWAVES + F.wave, NGW = F.G * NWAVES, lane = F.lane;
    LAS int* tst = (LAS int*)F.lds; LAS int* cn = tst + 260;
    const unsigned* cnt = WSP(const unsigned, WS_CTL) + CW_CNT + l * 256;
    if (F.tid < 256) cn[F.tid] = (int)__hip_atomic_load(&cnt[F.tid], __ATOMIC_RELAXED, __HIP_MEMORY_SCOPE_AGENT);
    __syncthreads();
    if (F.tid == 0) { int s = 0; for (int e = 0; e < 256; ++e) { tst[e] = s; s += (cn[e] + 255) >> 8; } tst[256] = s; }
    __syncthreads();
    const int NT = tst[256];
    int* meta = WSP(int, WS_META); int* tile_e = meta + 64;
    int* ST = WSP(int, WS_STOK); float* SW = WSP(float, WS_SW);
    const int* TE = WSP(const int, WS_TOPE); const float* TW = WSP(const float, WS_TOPW); const int* TP = WSP(const int, WS_TPOS); int* TS = WSP(int, WS_TSLOT);
    if (F.bid == 0) {
        if (F.tid == 0) { meta[0] = NT; meta[1] = NT + Tm / 256; }
        if (F.tid < 256) { const int e = F.tid, n = (cn[e] + 255) >> 8; for (int j = 0; j < n; ++j) tile_e[tst[e] + j] = e; }
        for (int i = F.tid; i < Tm / 256; i += 512) tile_e[NT + i] = 256;
    }
    for (int t = gw; t < Tm; t += NGW) {
        if (lane < 8) { const int e = TE[(size_t)t * 8 + lane], slot = tst[e] * 256 + TP[(size_t)t * 8 + lane];
            ST[slot] = t; SW[slot] = TW[(size_t)t * 8 + lane]; TS[(size_t)t * 8 + lane] = slot; }
    }
#pragma unroll 1
    for (int e = gw; e < 256; e += NGW) { const int c = cn[e], n = (c + 255) >> 8;
#pragma unroll 1
        for (int s = c + lane; s < n * 256; s += 64) { ST[tst[e] * 256 + s] = 0; SW[tst[e] * 256 + s] = 0.f; } }
    int gstep = F.G * 512; asm volatile("" : "+s"(gstep));
#pragma unroll 1
    for (int t = F.bid * 512 + F.tid; t < Tm; t += gstep) { ST[NT * 256 + t] = t; SW[NT * 256 + t] = 1.f; }
    __syncthreads();
}
__device__ __forceinline__ void phase_combine(const Frame& F_, int l, int Tm) {
    Frame F = F_; asm volatile("" : "+v"(F.tid)); F.lane = F.tid & 63;
    const int gw = F.bid * NWAVES + F.wave, NGW = F.G * NWAVES, lane = F.lane;
    const int* meta = WSP(const int, WS_META); const int NT = meta[0];
    const int* TS = WSP(const int, WS_TSLOT); const bf16* YS = WSP(const bf16, WS_YSLOT); float* X = WSP(float, WS_X); bf16* H = WSP(bf16, WS_H);
    const float* lw = KIN(I_LNFW) + (size_t)l * D; const float* lb = KIN(I_LNFB) + (size_t)l * D;
    for (int t = gw; t < Tm; t += NGW) {
        int sl = 0; if (lane < 8) sl = TS[(size_t)t * 8 + lane];
        int slots[9];
#pragma unroll
        for (int k = 0; k < 8; ++k) slots[k] = __shfl(sl, k);
        slots[8] = NT * 256 + t;
        const float* mv = mod_vec(F, l, t);
        float v[16]; float s = 0.f;
#pragma unroll
        for (int j = 0; j < 2; ++j) { const int col = j * 512 + lane * 8; float f[8];
#pragma unroll
            for (int q = 0; q < 8; ++q) f[q] = 0.f;
#pragma unroll
            for (int k = 0; k < 9; ++k) { const u32x4 w = *(const u32x4*)(YS + (size_t)slots[k] * 1024 + col);
                f[0] += bflo(w.x); f[1] += bfhi(w.x); f[2] += bflo(w.y); f[3] += bfhi(w.y); f[4] += bflo(w.z); f[5] += bfhi(w.z); f[6] += bflo(w.w); f[7] += bfhi(w.w); }
            const f32x4 xa = *(const f32x4*)(X + (size_t)t * D + col), xb = *(const f32x4*)(X + (size_t)t * D + col + 4);
            const f32x4 ga = *(const f32x4*)(mv + 5120 + col), gb = *(const f32x4*)(mv + 5120 + col + 4);
#pragma unroll
            for (int q = 0; q < 4; ++q) { v[j * 8 + q] = DN_ALPHA * xa[q] + ga[q] * f[q]; v[j * 8 + 4 + q] = DN_ALPHA * xb[q] + gb[q] * f[4 + q]; }
#pragma unroll
            for (int q = 0; q < 8; ++q) s += v[j * 8 + q]; }
        float mean = wave_sum(s) * (1.f / D), s2 = 0.f;
#pragma unroll
        for (int q = 0; q < 16; ++q) { v[q] -= mean; s2 += v[q] * v[q]; }
        float rstd = 1.f / sqrtf(wave_sum(s2) * (1.f / D) + LN_EPS);
        s = 0.f;
#pragma unroll
        for (int j = 0; j < 2; ++j) { const int col = j * 512 + lane * 8;
            const f32x4 wa = *(const f32x4*)(lw + col), wb = *(const f32x4*)(lw + col + 4), ba = *(const f32x4*)(lb + col), bb = *(const f32x4*)(lb + col + 4);
#pragma unroll
            for (int q = 0; q < 4; ++q) { v[j * 8 + q] = v[j * 8 + q] * rstd * wa[q] + ba[q]; v[j * 8 + 4 + q] = v[j * 8 + 4 + q] * rstd * wb[q] + bb[q]; }
            float* dst = (l == 1) ? (float*)karg(27) + (size_t)t * D + col : X + (size_t)t * D + col;
            *(f32x4*)dst = (f32x4){v[j * 8], v[j * 8 + 1], v[j * 8 + 2], v[j * 8 + 3]}; *(f32x4*)(dst + 4) = (f32x4){v[j * 8 + 4], v[j * 8 + 5], v[j * 8 + 6], v[j * 8 + 7]};
#pragma unroll
            for (int q = 0; q < 8; ++q) s += v[j * 8 + q]; }
        if (l == 0) {
            mean = wave_sum(s) * (1.f / D); s2 = 0.f;
#pragma unroll
            for (int q = 0; q < 16; ++q) { v[q] -= mean; s2 += v[q] * v[q]; }
            rstd = 1.f / sqrtf(wave_sum(s2) * (1.f / D) + LN_EPS);
            const float* m1 = mod_vec(F, 1, t);
#pragma unroll
            for (int j = 0; j < 2; ++j) { const int col = j * 512 + lane * 8;
                const f32x4 sa = *(const f32x4*)(m1 + 1024 + col), sb = *(const f32x4*)(m1 + 1024 + col + 4), ha = *(const f32x4*)(m1 + col), hb = *(const f32x4*)(m1 + col + 4);
                float o[8];
#pragma unroll
                for (int q = 0; q < 4; ++q) { o[q] = v[j * 8 + q] * rstd * (1.f + sa[q]) + ha[q]; o[4 + q] = v[j * 8 + 4 + q] * rstd * (1.f + sb[q]) + hb[q]; }
                u32x4 w; w.x = pk2(o[0], o[1]); w.y = pk2(o[2], o[3]); w.z = pk2(o[4], o[5]); w.w = pk2(o[6], o[7]);
                *(u32x4*)(H + (size_t)t * D + col) = w; }
        }
    }
}
#ifndef MK_PER_PHASE
#define MK_PER_PHASE 0
#endif
constexpr int NPL = 14, NPHASE = 1 + 2 * NPL;
struct Args { const float* in[27]; float* out; unsigned char* ws; int ph_lo, ph_hi; };
static_assert(sizeof(Args) == 29 * 8 + 8, "Args has no padding");

__global__ void __launch_bounds__(NWAVES * 64, 2) mk_fwd(Args args) {
    extern __shared__ __attribute__((aligned(16))) unsigned char lds_raw[];
    Frame F;
    F.lds = (LAS unsigned char*)lds_raw;
    F.tid = threadIdx.x; F.lane = F.tid & 63; F.wave = __builtin_amdgcn_readfirstlane(F.tid >> 6); F.G = gridDim.x; F.bid = blockIdx.x;
    F.ws = args.ws;
    volatile LAS unsigned* MISC = (volatile LAS unsigned*)(F.lds + MISC_OFF);
    if (F.tid < 128) MISC[F.tid] = 0u;
    __syncthreads();
    unsigned* ctl = (unsigned*)(F.ws + WS_CTL);
    XcdBarrier bar; bar.bar = ctl + CW_BAR; bar.x = 0; bar.st = nullptr;
    if (!MK_PER_PHASE) bar = xcd_barrier_post(ctl + CW_BAR, MISC);
    const int lo = args.ph_lo, hi = args.ph_hi;
#ifndef PHMASK
#define PHMASK 0xFFFFFFFFu
#endif
#define PHON(k) ((PHMASK >> ((k) == 0 ? 0 : (((k) - 1) % NPL) + 1)) & 1u)
#define IN(k) (PHON(k) && lo <= (k) && (k) < hi)
#define SEAM(k) do { if (IN(k) && IN((k) + 1)) xcd_barrier(bar); } while (0)
    LAS unsigned char* ring = F.lds;

    if (IN(0)) { phase_init(F); } SEAM(0);

#pragma unroll 1
    for (int l = 0; l < 2; ++l) {
        const int pb = 1 + l * NPL;
        const int Mrows = (l == 0) ? T_ALL : T_LAT;
        unsigned char* wne = F.ws + WS_WNE + (size_t)l * WNE_STRIDE;
        if (IN(pb + 0)) { phase_prep(F, l); } SEAM(pb + 0);
        if (IN(pb + 1)) {
            pg8::ProbDense S{nullptr, 1024, WSP(const bf16, WS_H), (const bf16*)(wne + WNE_WIN), T_ALL / 256, INW / 256, F.G, F.bid};
            pg8::EpiBf16Plain E{WSP(bf16, WS_P), INW};
            pg8::gemm_phase<pg8::ProbDense, pg8::EpiBf16Plain>(ring, S, E);
        } SEAM(pb + 1);
        if (IN(pb + 2)) {
#ifndef NO_R1
            phase_r1(F, l);
#endif
#ifndef NO_UT
            phase_ut(F, l); __syncthreads();
#endif
#ifndef NO_NA
            phase_na(F, l);
#endif
        } SEAM(pb + 2);
        if (IN(pb + 3)) {
#ifndef NO_R2
            phase_r2(F, l);
#endif
            { pg8::ProbBatched S{nullptr, 4096, WSP(const bf16, WS_DFT), WSP(const bf16, WS_UT), (size_t)512 * 4096, 32, 2, NB, F.G, F.bid};
              pg8::EpiFourier E{WSP(bf16, WS_FF), 0, NSEQ, 16};
              pg8::gemm_phase<pg8::ProbBatched, pg8::EpiFourier>(ring, S, E); }
#ifndef NO_FC
            if (l == 0) {
              pg8::ProbBatched S{nullptr, 256, WSP(const bf16, WS_DFTC), WSP(const bf16, WS_UTC), (size_t)512 * 256, 2, 2, NB, F.G, F.bid};
              pg8::EpiFourier E{WSP(bf16, WS_FF), T_LAT, NCTX, 1};
              pg8::gemm_phase<pg8::ProbBatched, pg8::EpiFourier>(ring, S, E); }
#endif
        } SEAM(pb + 3);
        if (IN(pb + 4)) { phase_r3(F, l); } SEAM(pb + 4);
        if (IN(pb + 5)) {
            { pg8::ProbDense S{nullptr, 512, WSP(const bf16, WS_YNA), (const bf16*)(wne + WNE_ONA), Mrows / 256, 4, F.G, F.bid};
              pg8::EpiGate<0> E{WSP(float, WS_YSUM), WSP(bf16, WS_YSUMB), WSP(const bf16, WS_P), 0};
              pg8::gemm_phase<pg8::ProbDense, pg8::EpiGate<0>>(ring, S, E); }
            { pg8::ProbDense S{nullptr, 1024, WSP(const bf16, WS_FF), (const bf16*)(wne + WNE_WF), Mrows / 256, 4, F.G, F.bid};
              pg8::EpiGate<1> E{WSP(float, WS_YSUM), WSP(bf16, WS_YSUMB), WSP(const bf16, WS_P), 1};
              pg8::gemm_phase<pg8::ProbDense, pg8::EpiGate<1>>(ring, S, E); }
            { pg8::ProbDense S{nullptr, 1024, WSP(const bf16, WS_YRET), (const bf16*)(wne + WNE_ORET), Mrows / 256, 4, F.G, F.bid};
              pg8::EpiGate<2> E{WSP(float, WS_YSUM), WSP(bf16, WS_YSUMB), WSP(const bf16, WS_P), 2};
              pg8::gemm_phase<pg8::ProbDense, pg8::EpiGate<2>>(ring, S, E); }
        } SEAM(pb + 5);
        if (IN(pb + 6)) {
            pg8::ProbDense S{nullptr, 1024, WSP(const bf16, WS_YSUMB), (const bf16*)(wne + WNE_WOUT), Mrows / 256, 4, F.G, F.bid};
            pg8::EpiWout E{WSP(float, WS_TMIX), l == 0 ? KIN(I_X) : WSP(const float, WS_X), l == 0 ? KIN(I_CTX) : WSP(const float, WS_X) + (size_t)T_LAT * D,
                           WSP(const float, WS_MOD) + (size_t)l * 9 * 6144, 2048};
            pg8::gemm_phase<pg8::ProbDense, pg8::EpiWout>(ring, S, E);
        } SEAM(pb + 6);
        if (IN(pb + 7)) { phase_ln_mix(F, l, Mrows); } SEAM(pb + 7);
        if (IN(pb + 8)) {
            pg8::ProbDense S{nullptr, 1024, WSP(const bf16, WS_H), (const bf16*)(wne + WNE_ROUT), Mrows / 256, 1, F.G, F.bid};
            pg8::EpiF32 E{WSP(float, WS_LOGIT), 256};
            pg8::gemm_phase<pg8::ProbDense, pg8::EpiF32>(ring, S, E);
        } SEAM(pb + 8);
        if (IN(pb + 9)) { phase_topk(F, l, Mrows); } SEAM(pb + 9);
        if (IN(pb + 10)) { phase_slots(F, l, Mrows); } SEAM(pb + 10);
        if (IN(pb + 11)) {
            pg8::ProbGU S{WSP(const int, WS_STOK), 1024, WSP(const bf16, WS_H), WSP(const bf16, WS_WGU), WSP(const int, WS_META), WSP(const int, WS_META) + 64, F.G, F.bid};
            pg8::EpiSwiglu E{WSP(bf16, WS_ACT)};
            pg8::gemm_phase<pg8::ProbGU, pg8::EpiSwiglu>(ring, S, E);
        } SEAM(pb + 11);
        if (IN(pb + 12)) {
            pg8::ProbDown S{nullptr, 256, WSP(const bf16, WS_ACT), WSP(const bf16, WS_WD), WSP(const int, WS_META), WSP(const int, WS_META) + 64, F.G, F.bid};
            pg8::EpiDown E{WSP(bf16, WS_YSLOT), WSP(const float, WS_SW)};
            pg8::gemm_phase<pg8::ProbDown, pg8::EpiDown>(ring, S, E);
        } SEAM(pb + 12);
        if (IN(pb + 13)) { phase_combine(F, l, Mrows); } SEAM(pb + 13);
    }
#undef IN
#undef SEAM
}

extern "C" void kernel_launch(void* const* d_in, const int* in_sizes, int n_in, void* d_out, int out_size, void* d_ws, size_t ws_size, hipStream_t stream) {
    static int grid = 0;
    if (grid == 0) {
        if (n_in != 27 || out_size != T_LAT * D || ws_size < WS_END) { fprintf(stderr, "kernel_launch: unexpected problem (n_in %d out %d ws %zu)\n", n_in, out_size, ws_size); grid = -1; return; }
        int dev = 0, cus = 0;
        if (hipGetDevice(&dev) != hipSuccess || hipDeviceGetAttribute(&cus, hipDeviceAttributeMultiprocessorCount, dev) != hipSuccess) { grid = -1; return; }
        if (hipFuncSetAttribute((const void*)mk_fwd, hipFuncAttributeMaxDynamicSharedMemorySize, LDS_BYTES) != hipSuccess) { fprintf(stderr, "kernel_launch: hipFuncSetAttribute failed\n"); grid = -1; return; }
        int per_cu = 0;
        if (hipOccupancyMaxActiveBlocksPerMultiprocessor(&per_cu, (const void*)mk_fwd, NWAVES * 64, LDS_BYTES) != hipSuccess || per_cu < 1) fprintf(stderr, "kernel_launch: occupancy query reports %d\n", per_cu);
        (void)hipGetLastError();
        grid = cus;
    }
    if (grid < 0) return;
    if (hipMemsetAsync((char*)d_ws + WS_CTL, 0, CTL_BYTES, stream) != hipSuccess) return;
    Args a{};
    for (int i = 0; i < 27; ++i) a.in[i] = (const float*)d_in[i];
    a.out = (float*)d_out; a.ws = (unsigned char*)d_ws;
#if MK_PER_PHASE
    for (int p = 0; p < NPHASE; ++p) { a.ph_lo = p; a.ph_hi = p + 1; hipLaunchKernelGGL(mk_fwd, dim3(grid), dim3(NWAVES * 64), LDS_BYTES, stream, a); }
#else
    a.ph_lo = 0; a.ph_hi = NPHASE;
    hipLaunchKernelGGL(mk_fwd, dim3(grid), dim3(NWAVES * 64), LDS_BYTES, stream, a);
#endif
}
```

```cpp
#include <hip/hip_runtime.h>
#include <cstdio>
#include <cstdint>

#define LAS __attribute__((address_space(3)))
#define GAS __attribute__((address_space(1)))
typedef unsigned short bf16;
typedef short bf16x8 __attribute__((ext_vector_type(8)));
typedef short bf16x4 __attribute__((ext_vector_type(4)));
typedef float f32x4 __attribute__((ext_vector_type(4)));
typedef float f32x2 __attribute__((ext_vector_type(2)));
typedef unsigned u32x4 __attribute__((ext_vector_type(4)));
typedef unsigned u32x2 __attribute__((ext_vector_type(2)));

constexpr int D = 1024, NB = 8, NSEQ = 4096, NCTX = 256, GW = 64;
constexpr int T_LAT = NB * NSEQ, T_CTX = NB * NCTX, T_ALL = T_LAT + T_CTX;
constexpr int INW = 8192;
constexpr int C_QA = 0, C_KA = 512, C_VA = 1024, C_UB = 1536, C_QR = 2048, C_KR = 2560, C_VR = 3072, C_GR = 4096, C_GL = 5120;
constexpr int NE = 256, TOPK = 8, EDIM = 256;
constexpr int NCH = 34;
constexpr float DN_ALPHA = 1.41421356237309515f;
constexpr float LN_EPS = 1e-6f, GN_EPS = 1e-5f;
constexpr int MAX_TILES = 1343 + 136;

constexpr size_t MiB = 1u << 20;
constexpr size_t WS_CTL = 0, CTL_BYTES = 1 * MiB;
constexpr size_t WS_MOD = 1 * MiB;
constexpr size_t WS_ROPE = 2 * MiB;
constexpr size_t WS_META = 3 * MiB;
constexpr size_t WS_WNE = 8 * MiB, WNE_STRIDE = 24 * MiB;
constexpr size_t WNE_WIN = 0, WNE_ONA = 16 * MiB, WNE_WF = 17 * MiB, WNE_ORET = 19 * MiB, WNE_WOUT = 21 * MiB, WNE_ROUT = 23 * MiB;
#ifndef WIN_LD
#define WIN_LD 1152
#endif
constexpr size_t WS_DFT = 56 * MiB;
constexpr size_t WS_DFTC = 120 * MiB;
constexpr size_t WS_WGU = 128 * MiB;
constexpr size_t WS_WD = 386 * MiB;
constexpr size_t WS_X = 520 * MiB;
constexpr size_t WS_H = 656 * MiB;
constexpr size_t WS_R = 724 * MiB;
constexpr size_t WS_P = WS_R;
constexpr size_t WS_YNA = WS_R + 544 * MiB;
constexpr size_t WS_FF = WS_R + 578 * MiB;
constexpr size_t WS_YRET = WS_R + 646 * MiB;
constexpr size_t WS_UT = WS_R + 714 * MiB;
constexpr size_t WS_UTC = WS_UT + 32 * MiB;
constexpr size_t WS_KV = WS_R + 748 * MiB;
constexpr size_t WS_SPREV = WS_R + 1020 * MiB;
constexpr size_t WS_ZNA = WS_KV, WS_ZFF = WS_KV + 68 * MiB, WS_ZRET = WS_KV + 136 * MiB;
constexpr size_t WS_YSUMB = WS_KV + 204 * MiB;
constexpr size_t WS_YOUT = WS_KV;
constexpr size_t WS_TMIX = WS_R;
constexpr size_t WS_LOGIT = WS_R + 136 * MiB;
constexpr size_t WS_TOPE = WS_R + 170 * MiB;
constexpr size_t WS_TOPW = WS_R + 172 * MiB;
constexpr size_t WS_TPOS = WS_R + 174 * MiB;
constexpr size_t WS_TSLOT = WS_R + 176 * MiB;
constexpr size_t WS_STOK = WS_R + 178 * MiB;
constexpr size_t WS_SW = WS_R + 180 * MiB;
constexpr size_t WS_ACT = WS_R + 182 * MiB;
constexpr size_t WS_YSLOT = WS_R + 368 * MiB;
constexpr size_t WS_VT = WS_R + 1156 * MiB;
constexpr size_t WS_VTC = WS_VT + 32 * MiB;
constexpr size_t WS_H8 = WS_SPREV;
constexpr size_t WS_GR8 = WS_KV + 136 * MiB;
constexpr size_t WS_G8 = WS_R + 1190 * MiB;
constexpr size_t WS_END = 2016 * MiB;
constexpr int CW_BAR = 4096;
constexpr int CW_CNT = 16384;
constexpr int CW_CHK = 20000;

constexpr int LDS_BYTES = 159744;
constexpr int MISC_OFF = 159232;

__device__ __forceinline__ int lane_id_() { return (int)__builtin_amdgcn_mbcnt_hi(~0u, __builtin_amdgcn_mbcnt_lo(~0u, 0u)); }
#define LDS_WAIT() asm volatile("s_waitcnt lgkmcnt(0)" ::: "memory")
#define VM_WAIT() asm volatile("s_waitcnt vmcnt(0)" ::: "memory")
__device__ __forceinline__ unsigned f2bf(float f) { unsigned u = __builtin_bit_cast(unsigned, f); return (u + 0x7fffu + ((u >> 16) & 1u)) >> 16; }
__device__ __forceinline__ float bf2f(unsigned b) { return __builtin_bit_cast(float, (b & 0xffffu) << 16); }
__device__ __forceinline__ unsigned pk2(float lo, float hi) { unsigned r; asm volatile("v_cvt_pk_bf16_f32 %0, %1, %2" : "=v"(r) : "v"(lo), "v"(hi)); return r; }
__device__ __forceinline__ float bflo(unsigned w) { return __builtin_bit_cast(float, w << 16); }
__device__ __forceinline__ float bfhi(unsigned w) { return __builtin_bit_cast(float, w & 0xffff0000u); }
__device__ __forceinline__ float wave_sum(float v) {
#pragma unroll
    for (int o = 1; o < 64; o <<= 1) v += __shfl_xor(v, o);
    return v;
}
__device__ __forceinline__ float sigmoidf_(float x) { return __builtin_amdgcn_rcpf(1.f + __expf(-x)); }
__device__ __forceinline__ float siluf_(float x) { return x * __builtin_amdgcn_rcpf(1.f + __expf(-x)); }

#define XB_TMO      128
#define XB_XCNT(j)  (256  + 64 * (j))
#define XB_XSUB(j)  (1280 + 64 * (j))
#define XB_XGEN(j)  (2304 + 64 * (j))
#define XB_TOP      3328
#define XB_TOPGEN   3392
#define XCD_BAR_WORDS 3456
#define XB_SPIN_CAP (1u << 18)
__device__ __forceinline__ unsigned xb_ld(unsigned* p)              { return __hip_atomic_load(p, __ATOMIC_RELAXED, __HIP_MEMORY_SCOPE_AGENT); }
__device__ __forceinline__ unsigned xb_add(unsigned* p, unsigned v) { return __hip_atomic_fetch_add(p, v, __ATOMIC_RELAXED, __HIP_MEMORY_SCOPE_AGENT); }
__device__ __forceinline__ unsigned xb_xcc_id() { return (unsigned)__builtin_amdgcn_s_getreg((3 << 11) | 20) & 0xFu; }
#define XB_SPIN(cond, bar) do { unsigned _sp = 0; while (cond) { __builtin_amdgcn_s_sleep(1); \
    if ((++_sp & 255u) == 0u) { if (xb_ld(&(bar)[XB_TMO])) break; if (_sp > XB_SPIN_CAP) { atomicAdd(&(bar)[XB_TMO], 1u); break; } } } } while (0)
struct XcdBarrier { unsigned* bar; unsigned x; volatile LAS unsigned* st; };
__device__ __forceinline__ XcdBarrier xcd_barrier_post(unsigned* bar, volatile LAS unsigned* st, int wave_id) {
    XcdBarrier b; b.bar = bar; b.x = xb_xcc_id(); b.st = st;
    if (wave_id == 0 && lane_id_() == 0) (void)xb_add(&bar[XB_XCNT(b.x)], 1u);
    return b;
}
__device__ __forceinline__ void xcd_barrier_complete(unsigned* bar, unsigned x, unsigned& nloc, unsigned& nx) {
    const unsigned G = gridDim.x * gridDim.y * gridDim.z;
    unsigned sum, cnt, mine, sp = 0u;
    for (;;) {
        sum = 0u; cnt = 0u; mine = 0u;
#pragma unroll
        for (unsigned j = 0; j < 16; ++j) { const unsigned c = xb_ld(&bar[XB_XCNT(j)]); sum += c; cnt += (c > 0u) ? 1u : 0u; mine = (j == x) ? c : mine; }
        if (sum == G) break;
        __builtin_amdgcn_s_sleep(1);
        if ((++sp & 255u) == 0u) { if (xb_ld(&bar[XB_TMO])) break; if (sp > XB_SPIN_CAP) { atomicAdd(&bar[XB_TMO], 1u); break; } }
    }
    nloc = mine > 0u ? mine : 1u; nx = cnt > 0u ? cnt : 1u;
}
__device__ __forceinline__ void xcd_barrier(const XcdBarrier& b, int wave_id) {
    asm volatile("s_waitcnt vmcnt(0)" ::: "memory");
    __syncthreads();
    if (wave_id == 0 && lane_id_() == 0) {
        unsigned* bar = b.bar;
        __builtin_amdgcn_s_waitcnt(0);
        unsigned nloc = b.st[0], nx = b.st[1];
        if (nloc == 0u) { xcd_barrier_complete(bar, b.x, nloc, nx); b.st[0] = nloc; b.st[1] = nx; }
        const unsigned old = xb_add(&bar[XB_XSUB(b.x)], 1u);
        const unsigned gen = old / nloc;
        if (old + 1u == (gen + 1u) * nloc) {
            __builtin_amdgcn_fence(__ATOMIC_RELEASE, "agent");
            asm volatile("s_waitcnt vmcnt(0)" ::: "memory");
            const unsigned og = xb_add(&bar[XB_TOP], 1u);
            const unsigned tg = og / nx;
            if (og + 1u == (tg + 1u) * nx) xb_add(&bar[XB_TOPGEN], 1u);
            else XB_SPIN(xb_ld(&bar[XB_TOPGEN]) == tg, bar);
            __builtin_amdgcn_fence(__ATOMIC_ACQUIRE, "agent");
            xb_add(&bar[XB_XGEN(b.x)], 1u);
            asm volatile("s_waitcnt vmcnt(0)" ::: "memory");
        } else {
            XB_SPIN(xb_ld(&bar[XB_XGEN(b.x)]) == gen, bar);
            __builtin_amdgcn_fence(__ATOMIC_ACQUIRE, "agent");
            asm volatile("s_waitcnt vmcnt(0)" ::: "memory");
        }
    }
    __syncthreads();
}
namespace pg8 {
#ifndef SKEW_TICKS
#define SKEW_TICKS 27u
#endif
constexpr int BM = 256, BK = 64, HALF = 128, HTB = HALF * BK * 2, STAGE_BYTES = 8 * HTB, NXCD = 8, WGM = 8;
__host__ __device__ __forceinline__ int lds_byte(int r, int c) { const int st = (r >> 4) * 2 + (c >> 5), rr = r & 15, cc = c & 31, ob = rr * 64 + cc * 2; return st * 1024 + (ob ^ (((ob >> 9) & 1) << 5)); }
__host__ __device__ __forceinline__ void stage_rc(int b, int& R, int& C) { const int st = b / 1024, sb = b % 1024, swz = sb ^ (((sb >> 9) & 1) << 5); R = (st >> 1) * 16 + swz / 64; C = (st & 1) * 32 + (swz % 64) / 2; }
__host__ __device__ __forceinline__ int perm32(int rho) { const int n = rho >> 4, i = rho & 15; return 8 * (i >> 2) + 4 * n + (i & 3); }
__host__ __device__ __forceinline__ int perm64(int R) { return (R >> 5) * 64 + ((R >> 2) & 3) * 16 + ((R >> 4) & 1) * 4 + (R & 3); }

struct Unit { int pm, pn, e, aux; };
typedef int i8v_ __attribute__((ext_vector_type(8)));
__device__ __forceinline__ unsigned cvt_pk_bf16(float lo, float hi) { unsigned r; asm volatile("v_cvt_pk_bf16_f32 %0, %1, %2" : "=v"(r) : "v"(lo), "v"(hi)); return r; }

__device__ __forceinline__ bool static_tile(int nM, int nN, int G, int c, int i, int& pm, int& pn) {
    const int nwg = nM * nN; const long L = (long)i * G + c; if (L >= nwg) return false;
    int wgid = (int)L; { const int q = nwg / NXCD, r = nwg % NXCD, xcd = wgid % NXCD, off = wgid / NXCD; wgid = (xcd < r ? xcd * (q + 1) : r * (q + 1) + (xcd - r) * q) + off; }
    const int nig = WGM * nN, gid = wgid / nig, fm = gid * WGM, gsz = (nM - fm) < WGM ? (nM - fm) : WGM;
    pm = fm + ((wgid % nig) % gsz); pn = (wgid % nig) / gsz; return true;
}

template <class Prob, class Epi, bool ALIGN_EPI = true, int SKEW = 0  , int STAMP = -1  ,
          bool F8 = false  >
__device__ __forceinline__ void gemm_phase(LAS unsigned char* lds, const Prob& S, const Epi& E, int wave_id) {
    int lane_ = lane_id_(); asm volatile("" : "+v"(lane_));
    const int wid = wave_id, lane = lane_, tid = wid * 64 + lane, wr = wid >> 2, wc = wid & 3, fr = lane & 15, fq = lane >> 4;
    int K_ = S.K, la_ = S.lda(), lb_ = S.ldb(); asm volatile("" : "+s"(K_), "+s"(la_), "+s"(lb_));
    const int K = K_, nt = K / BK, lda = la_, ldb = lb_;
    unsigned voffA[2], voffB[2]; int RA[2], CA[2];
#pragma unroll
    for (int i = 0; i < 2; ++i) { int R, C; stage_rc(tid * 16 + i * 8192, R, C); const int Rb = (int)Epi::PERM == 2 ? perm64(R) : (Epi::PERM ? ((R & ~31) + perm32(R & 31)) : R);
        RA[i] = R; CA[i] = C; voffA[i] = (unsigned)(R * lda + C) * 2u; voffB[i] = (unsigned)(Rb * ldb + C) * 2u; }
    const size_t kstep = (size_t)(BK * 2);
    const size_t hstepA = (size_t)HALF * lda * 2, hstepB = (size_t)((int)Epi::PERM == 2 ? 8 : HALF) * ldb * 2;
    const unsigned ldsw = (unsigned)wid * 1024u;
    const int aoff = lds_byte(wr * 64 + fr, fq * 8), boff = lds_byte(wc * 32 + fr, fq * 8);
#define PG8_SA(b, h) (((b) * 2 + (h)) * HTB)
#define PG8_SB(b, h) ((4 + (b) * 2 + (h)) * HTB)
#define PG8_STAGE(bufoff, gbase, voff) do { _Pragma("unroll") for (int _i = 0; _i < 2; ++_i) \
        __builtin_amdgcn_global_load_lds((const unsigned*)((const char*)(gbase) + (voff)[_i]), (LAS unsigned*)(lds + (bufoff) + ldsw + _i * 8192), 16, 0, 0); } while (0)
#define PG8_STAGE_A(bufoff, kp, h, g0, g1) do { if constexpr (Prob::GATHER) { if ((h) == 0) PG8_STAGE(bufoff, kp, g0); else PG8_STAGE(bufoff, kp, g1); } \
        else PG8_STAGE(bufoff, (kp) + (h) * hstepA, voffA); } while (0)
#define PG8_LDA(dst, b, h) do { _Pragma("unroll") for (int m = 0; m < 4; ++m) _Pragma("unroll") for (int k = 0; k < 2; ++k) dst[m][k] = *(const LAS bf16x8*)(lds + PG8_SA(b, h) + aoff + m * 2048 + k * 1024); } while (0)
#define PG8_LDB(dst, b, h) do { _Pragma("unroll") for (int n = 0; n < 2; ++n) _Pragma("unroll") for (int k = 0; k < 2; ++k) dst[n][k] = *(const LAS bf16x8*)(lds + PG8_SB(b, h) + boff + n * 2048 + k * 1024); } while (0)
#define PG8_MMA(ai, bj, At, Bt) do { __builtin_amdgcn_s_setprio(1); _Pragma("unroll") for (int m = 0; m < 4; ++m) _Pragma("unroll") for (int n = 0; n < 2; ++n) { \
        if constexpr (F8) { typedef int i4_ __attribute__((ext_vector_type(4))); \
            const i8v_ b_ = __builtin_shufflevector(__builtin_bit_cast(i4_, Bt[n][0]), __builtin_bit_cast(i4_, Bt[n][1]), 0, 1, 2, 3, 4, 5, 6, 7), a_ = __builtin_shufflevector(__builtin_bit_cast(i4_, At[m][0]), __builtin_bit_cast(i4_, At[m][1]), 0, 1, 2, 3, 4, 5, 6, 7); \
            asm volatile("v_mfma_f32_16x16x128_f8f6f4 %0, %1, %2, %0" : "+v"(acc[ai][bj][m][n]) : "v"(b_), "v"(a_));   } \
        else { _Pragma("unroll") for (int k = 0; k < 2; ++k) acc[ai][bj][m][n] = __builtin_amdgcn_mfma_f32_16x16x32_bf16(Bt[n][k], At[m][k], acc[ai][bj][m][n], 0, 0, 0); } } __builtin_amdgcn_s_setprio(0); } while (0)
#define PG8_WAIT_V(n) asm volatile("s_waitcnt vmcnt(" #n ")" ::: "memory")
#define PG8_WAIT_L(n) asm volatile("s_waitcnt lgkmcnt(" #n ")" ::: "memory")
#define PG8_BAR __builtin_amdgcn_s_barrier()
#define PG8_SCHED __builtin_amdgcn_sched_barrier(0)
#ifdef SUBSEL
#define PG8_TS(k, add) do { if (STAMP >= 0 && blockIdx.x == 0 && wid == 0) { volatile LAS unsigned* sb_ = (volatile LAS unsigned*)(lds + MISC_OFF + 288); const unsigned n_ = (unsigned)__builtin_amdgcn_s_memrealtime(); if (add) sb_[STAMP + (k)] += n_ - sb_[15]; sb_[15] = n_; } } while (0)
#else
#define PG8_TS(k, add) do { } while (0)
#endif
    Unit cur, nxt; int ui = 0;
    if (!S.next(0, cur)) return;
    if constexpr (SKEW > 0) {
        const unsigned grp = (blockIdx.x >> 3) & 3u;
        if (grp) { const unsigned long long t0 = wall_clock64(), dt = (unsigned long long)(grp * (unsigned)SKEW);
            while (wall_clock64() - t0 < dt) __builtin_amdgcn_s_sleep(8); } }
    f32x4 acc[2][2][4][2];
#pragma unroll
    for (int a = 0; a < 2; ++a)
#pragma unroll
        for (int b = 0; b < 2; ++b)
#pragma unroll
            for (int m = 0; m < 4; ++m)
#pragma unroll
                for (int n = 0; n < 2; ++n) acc[a][b][m][n] = (f32x4){0.f, 0.f, 0.f, 0.f};
    bf16x8 At[4][2], B0[2][2], B1[2][2];
    const char* cA = S.a_tile(cur); const char* cB = S.b_tile(cur);
    unsigned gc0[2] = {0u, 0u}, gc1[2] = {0u, 0u}, gn0[2] = {0u, 0u}, gn1[2] = {0u, 0u};
    if constexpr (Prob::GATHER) {
#pragma unroll
        for (int i = 0; i < 2; ++i) { const int r0 = S.gidx[cur.aux * 256 + RA[i]], r1 = S.gidx[cur.aux * 256 + 128 + RA[i]];
            gc0[i] = (unsigned)(r0 * lda + CA[i]) * 2u; gc1[i] = (unsigned)(r1 * lda + CA[i]) * 2u; }
    }
    PG8_STAGE(PG8_SB(0, 0), cB, voffB); PG8_STAGE(PG8_SB(0, 1), cB + hstepB, voffB); PG8_STAGE_A(PG8_SA(0, 0), cA, 0, gc0, gc1); PG8_STAGE_A(PG8_SA(0, 1), cA, 1, gc0, gc1);
    if (wr == 1) PG8_BAR;
    PG8_WAIT_V(2); PG8_BAR;
    PG8_STAGE(PG8_SB(1, 0), cB + kstep, voffB); PG8_STAGE_A(PG8_SA(1, 0), cA + kstep, 0, gc0, gc1); PG8_STAGE(PG8_SB(1, 1), cB + hstepB + kstep, voffB);
    PG8_WAIT_V(6); PG8_BAR;
    for (;;) {
        const bool has_next = S.next(ui + 1, nxt);
        const char* nA = has_next ? S.a_tile(nxt) : cA; const char* nB = has_next ? S.b_tile(nxt) : cB;
        if constexpr (Prob::GATHER) {
            if (has_next) {
#pragma unroll
                for (int i = 0; i < 2; ++i) { const int r0 = S.gidx[nxt.aux * 256 + RA[i]], r1 = S.gidx[nxt.aux * 256 + 128 + RA[i]];
                    gn0[i] = (unsigned)(r0 * lda + CA[i]) * 2u; gn1[i] = (unsigned)(r1 * lda + CA[i]) * 2u; }
            } else { gn0[0] = gc0[0]; gn0[1] = gc0[1]; gn1[0] = gc1[0]; gn1[1] = gc1[1]; }
        }
        PG8_TS(1, ui > 0);
#ifdef EXP_KDUP
        constexpr bool kdup = (STAMP == EXP_KDUP);
#else
        constexpr bool kdup = false;
#endif
        const int ntx = kdup ? 2 * nt : nt;
        for (int t = 0; t < ntx; t += 2) {
            const bool last = (t == ntx - 2);
            const int tw = kdup ? (t & (nt - 1)) : t, t2 = kdup ? ((t + 2) & (nt - 1)) : t + 2;
            const char* a1 = cA + (size_t)(tw + 1) * kstep;
            const char* a2 = last ? nA : cA + (size_t)t2 * kstep; const char* b2 = last ? nB : cB + (size_t)t2 * kstep;
            const char* a3 = a2 + kstep; const char* b3 = b2 + kstep;
            unsigned g20[2], g21[2];
            g20[0] = last ? gn0[0] : gc0[0]; g20[1] = last ? gn0[1] : gc0[1]; g21[0] = last ? gn1[0] : gc1[0]; g21[1] = last ? gn1[1] : gc1[1];
            PG8_LDB(B0, 0, 0); PG8_LDB(B1, 0, 1); PG8_SCHED; PG8_LDA(At, 0, 0); PG8_STAGE_A(PG8_SA(1, 1), a1, 1, gc0, gc1);
            PG8_WAIT_V(8); PG8_WAIT_L(0); PG8_BAR; PG8_MMA(0, 0, At, B0); PG8_MMA(0, 1, At, B1); PG8_BAR; PG8_SCHED;
            PG8_LDA(At, 0, 1); PG8_STAGE(PG8_SB(0, 0), b2, voffB); PG8_STAGE(PG8_SB(0, 1), b2 + hstepB, voffB); PG8_STAGE_A(PG8_SA(0, 0), a2, 0, g20, g21);
            PG8_WAIT_V(8); PG8_WAIT_L(0); PG8_BAR; PG8_MMA(1, 0, At, B0); PG8_MMA(1, 1, At, B1); PG8_BAR; PG8_SCHED;
            PG8_LDB(B0, 1, 0); PG8_LDB(B1, 1, 1); PG8_SCHED; PG8_LDA(At, 1, 0); PG8_STAGE_A(PG8_SA(0, 1), a2, 1, g20, g21);
            PG8_WAIT_V(8); PG8_WAIT_L(0); PG8_BAR; PG8_MMA(0, 0, At, B0); PG8_MMA(0, 1, At, B1); PG8_BAR; PG8_SCHED;
            PG8_LDA(At, 1, 1); PG8_STAGE(PG8_SB(1, 0), b3, voffB); PG8_STAGE(PG8_SB(1, 1), b3 + hstepB, voffB); PG8_STAGE_A(PG8_SA(1, 0), a3, 0, g20, g21);
            PG8_WAIT_V(8); PG8_WAIT_L(0); PG8_BAR; PG8_MMA(1, 0, At, B0); PG8_MMA(1, 1, At, B1); PG8_BAR; PG8_SCHED;
        }
        PG8_TS(0, true);
        if constexpr (F8) asm volatile("s_nop 15\n\ts_nop 15" ::: "memory");
        if constexpr (kdup) {
#pragma unroll
            for (int a = 0; a < 2; ++a)
#pragma unroll
                for (int b = 0; b < 2; ++b)
#pragma unroll
                    for (int m = 0; m < 4; ++m)
#pragma unroll
                        for (int n = 0; n < 2; ++n) acc[a][b][m][n] *= 0.5f; }
        if constexpr (ALIGN_EPI) { if (wr == 0) PG8_BAR; }
        E(acc, cur, wr, wc, fr, fq);
#ifdef EXP_EPI2
        if constexpr (STAMP == EXP_EPI2) { asm volatile("" ::: "memory"); E(acc, cur, wr, wc, fr, fq); }
#endif
#ifdef EXP_WAIT0
        PG8_WAIT_V(0);
#endif
        if (!has_next) break;
#pragma unroll
        for (int a = 0; a < 2; ++a)
#pragma unroll
            for (int b = 0; b < 2; ++b)
#pragma unroll
                for (int m = 0; m < 4; ++m)
#pragma unroll
                    for (int n = 0; n < 2; ++n) acc[a][b][m][n] = (f32x4){0.f, 0.f, 0.f, 0.f};
        cur = nxt; cA = nA; cB = nB; ++ui;
        if constexpr (Prob::GATHER) { gc0[0] = gn0[0]; gc0[1] = gn0[1]; gc1[0] = gn1[0]; gc1[1] = gn1[1]; }
        if constexpr (ALIGN_EPI) { if (wr == 1) PG8_BAR; }
    }
    PG8_WAIT_V(0);
    if constexpr (!ALIGN_EPI) { if (wr == 0) PG8_BAR; }
    PG8_BAR;
#undef PG8_TS
#undef PG8_SA
#undef PG8_SB
#undef PG8_STAGE
#undef PG8_STAGE_A
#undef PG8_LDA
#undef PG8_LDB
#undef PG8_MMA
#undef PG8_WAIT_V
#undef PG8_WAIT_L
#undef PG8_BAR
#undef PG8_SCHED
}
}
namespace pg8 {
struct ProbDense {
    static constexpr bool GATHER = false; const LAS int* gidx;
    int K; const bf16* A; const bf16* Bt; int nM, nN, G, c;
    int ldA = 0, ldB = 0;
    __device__ __forceinline__ int lda() const { return ldA ? ldA : K; }
    __device__ __forceinline__ int ldb() const { return ldB ? ldB : K; }
    __device__ __forceinline__ bool next(int i, Unit& u) const { u.e = 0; u.aux = 0; return static_tile(nM, nN, G, c, i, u.pm, u.pn); }
    __device__ __forceinline__ const char* a_tile(const Unit& u) const { return (const char*)A + (size_t)u.pm * 256 * lda() * 2; }
    __device__ __forceinline__ const char* b_tile(const Unit& u) const { return (const char*)Bt + (size_t)u.pn * 256 * ldb() * 2; }
};
struct ProbBatched {
    static constexpr bool GATHER = false; const LAS int* gidx;
    int K; const bf16* A; const bf16* Bt; size_t bstride  ; int nPm, nPn, nb, G, c;
    __device__ __forceinline__ int lda() const { return K; } __device__ __forceinline__ int ldb() const { return K; }
    __device__ __forceinline__ bool next(int i, Unit& u) const {
        const int per = nPm * nPn; int b, r;
        if (G == 256 && nb == 8) { b = c & 7; r = i * 32 + (c >> 3); if (r >= per) return false; }
        else { const int L = i * G + c; if (L >= nb * per) return false; b = L / per; r = L % per; }
        u.e = b; u.pm = r / nPn; u.pn = r % nPn; u.aux = 0; return true; }
    __device__ __forceinline__ const char* a_tile(const Unit& u) const { return (const char*)A + (size_t)u.pm * 256 * K * 2; }
    __device__ __forceinline__ const char* b_tile(const Unit& u) const { return (const char*)(Bt + (size_t)u.e * bstride) + (size_t)u.pn * 256 * K * 2; }
};
constexpr int XT_OFF = 131072, XT_MAXU = 24, XT_UT = XT_OFF, XT_XI = XT_OFF + XT_MAXU * 16;
struct ProbGU {
    static constexpr bool GATHER = true; const LAS int* gidx  ;
    int K; const bf16* A; const bf16* W; const LAS int* ut;
    __device__ __forceinline__ int lda() const { return K; } __device__ __forceinline__ int ldb() const { return K; }
    __device__ __forceinline__ bool next(int i, Unit& u) const {
        if (i >= XT_MAXU) return false; if (__builtin_amdgcn_readfirstlane(ut[i * 4 + 3]) == 0) return false;
        u.pm = __builtin_amdgcn_readfirstlane(ut[i * 4]); u.pn = __builtin_amdgcn_readfirstlane(ut[i * 4 + 1]); u.e = __builtin_amdgcn_readfirstlane(ut[i * 4 + 2]); u.aux = i; return true; }
    __device__ __forceinline__ const char* a_tile(const Unit&) const { return (const char*)A; }
    __device__ __forceinline__ const char* b_tile(const Unit& u) const { return (const char*)W + ((size_t)u.e * 512 + (size_t)u.pn * 256) * K * 2; }
};
struct ProbDown {
    static constexpr bool GATHER = false; const LAS int* gidx;
    int K; const bf16* A; const bf16* W; const LAS int* ut;
    __device__ __forceinline__ int lda() const { return K; } __device__ __forceinline__ int ldb() const { return K; }
    __device__ __forceinline__ bool next(int i, Unit& u) const {
        if (i >= XT_MAXU) return false; if (__builtin_amdgcn_readfirstlane(ut[i * 4 + 3]) == 0) return false;
        u.pm = __builtin_amdgcn_readfirstlane(ut[i * 4]); u.pn = __builtin_amdgcn_readfirstlane(ut[i * 4 + 1]); u.e = __builtin_amdgcn_readfirstlane(ut[i * 4 + 2]); u.aux = i; return true; }
    __device__ __forceinline__ const char* a_tile(const Unit& u) const { return (const char*)A + (size_t)u.pm * 256 * K * 2; }
    __device__ __forceinline__ const char* b_tile(const Unit& u) const { return (const char*)W + ((size_t)u.e * 1024 + (size_t)u.pn * 256) * K * 2; }
};

typedef f32x4 Acc[2][2][4][2];
template <class T> __device__ __forceinline__ T* at(T* base, unsigned byte_off) { return (T*)((char*)base + byte_off); }
template <class T> __device__ __forceinline__ const T* at(const T* base, unsigned byte_off) { return (const T*)((const char*)base + byte_off); }
#ifndef USE_NT
template <class V> __device__ __forceinline__ void st_stream(V* p, const V& v) { *p = v; }
#else
template <class V> __device__ __forceinline__ void st_stream(V* p, const V& v) { __builtin_nontemporal_store(v, p); }
#endif
__device__ __forceinline__ u32x4 pack_bf16x8(const f32x4& v0, const f32x4& v1) { u32x4 w; w.x = cvt_pk_bf16(v0[0], v0[1]); w.y = cvt_pk_bf16(v0[2], v0[3]); w.z = cvt_pk_bf16(v1[0], v1[1]); w.w = cvt_pk_bf16(v1[2], v1[3]); return w; }
constexpr float YS_SCALE = 16.f, YS_INV = 1.f / 16.f;
__device__ __forceinline__ unsigned pack_fp8x4(float a, float b, float c, float d) {
    a = fminf(fmaxf(a, -448.f), 448.f); b = fminf(fmaxf(b, -448.f), 448.f); c = fminf(fmaxf(c, -448.f), 448.f); d = fminf(fmaxf(d, -448.f), 448.f);
    int w = 0; w = __builtin_amdgcn_cvt_pk_fp8_f32(a, b, w, false); w = __builtin_amdgcn_cvt_pk_fp8_f32(c, d, w, true); return (unsigned)w; }
__device__ __forceinline__ u32x2 pack_fp8x8(const f32x4& v0, const f32x4& v1, float sc) { u32x2 w; w.x = pack_fp8x4(v0[0] * sc, v0[1] * sc, v0[2] * sc, v0[3] * sc); w.y = pack_fp8x4(v1[0] * sc, v1[1] * sc, v1[2] * sc, v1[3] * sc); return w; }
struct EpiInproj {
    static constexpr int PERM = 2; bf16* O; unsigned char* G8; unsigned char* GR8; float inv  ;
    __device__ __forceinline__ void operator()(const Acc& acc0, const Unit& u, int wr, int wc, int fr, int fq) const {
        Acc acc;
#pragma unroll
        for (int a_ = 0; a_ < 2; ++a_)
#pragma unroll
            for (int b_ = 0; b_ < 2; ++b_)
#pragma unroll
                for (int m_ = 0; m_ < 4; ++m_)
#pragma unroll
                    for (int n_ = 0; n_ < 2; ++n_) acc[a_][b_][m_][n_] = acc0[a_][b_][m_][n_] * inv;
        const int row = u.pm * 256 + wr * 64 + fr, col = u.pn * 256 + wc * 64 + 16 * fq;
        if (u.pn >= C_GR / 256 && u.pn < C_GL / 256) {
            const unsigned o0 = (unsigned)(row * 1024 + col - C_GR);
#pragma unroll
            for (int ai = 0; ai < 2; ++ai)
#pragma unroll
                for (int m = 0; m < 4; ++m) { const u32x2 lo = pack_fp8x8(acc[ai][0][m][0], acc[ai][0][m][1], YS_SCALE), hi = pack_fp8x8(acc[ai][1][m][0], acc[ai][1][m][1], YS_SCALE);
                    u32x4 w; w.x = lo.x; w.y = lo.y; w.z = hi.x; w.w = hi.y; *(u32x4*)at(GR8, o0 + (unsigned)(ai * HALF + m * 16) * 1024u) = w; }
        } else if (u.pn < C_GL / 256) {
            const unsigned o0 = (unsigned)(row * INW + col) * 2u;
#pragma unroll
            for (int ai = 0; ai < 2; ++ai)
#pragma unroll
                for (int m = 0; m < 4; ++m)
#pragma unroll
                    for (int bj = 0; bj < 2; ++bj) *(u32x4*)at(O, o0 + (unsigned)(ai * HALF + m * 16) * (INW * 2u) + bj * 16) = pack_bf16x8(acc[ai][bj][m][0], acc[ai][bj][m][1]);
        } else {
            const unsigned o0 = (unsigned)(row * 3072 + col - C_GL);
#pragma unroll
            for (int ai = 0; ai < 2; ++ai)
#pragma unroll
                for (int m = 0; m < 4; ++m) { const u32x2 lo = pack_fp8x8(acc[ai][0][m][0], acc[ai][0][m][1], YS_SCALE), hi = pack_fp8x8(acc[ai][1][m][0], acc[ai][1][m][1], YS_SCALE);
                    u32x4 w; w.x = lo.x; w.y = lo.y; w.z = hi.x; w.w = hi.y; *(u32x4*)at(G8, o0 + (unsigned)(ai * HALF + m * 16) * 3072u) = w; }
        }
    }
};
struct EpiFp8Plain {
    static constexpr int PERM = 2; unsigned char* O; int ldc; float sc;
    __device__ __forceinline__ void operator()(const Acc& acc, const Unit& u, int wr, int wc, int fr, int fq) const {
        const unsigned o0 = (unsigned)((u.pm * 256 + wr * 64 + fr) * ldc + u.pn * 256 + wc * 64 + 16 * fq), rs = (unsigned)ldc;
#pragma unroll
        for (int ai = 0; ai < 2; ++ai)
#pragma unroll
            for (int m = 0; m < 4; ++m) { const u32x2 lo = pack_fp8x8(acc[ai][0][m][0], acc[ai][0][m][1], sc), hi = pack_fp8x8(acc[ai][1][m][0], acc[ai][1][m][1], sc);
                u32x4 w; w.x = lo.x; w.y = lo.y; w.z = hi.x; w.w = hi.y; *(u32x4*)at(O, o0 + (unsigned)(ai * HALF + m * 16) * rs) = w; }
    }
};
struct EpiBf16Plain {
    static constexpr int PERM = 1; bf16* O; int ldc;
    __device__ __forceinline__ void operator()(const Acc& acc, const Unit& u, int wr, int wc, int fr, int fq) const {
        const unsigned o0 = (unsigned)((u.pm * 256 + wr * 64 + fr) * ldc + u.pn * 256 + wc * 32 + 8 * fq) * 2u, rs = (unsigned)ldc * 2u;
#pragma unroll
        for (int ai = 0; ai < 2; ++ai)
#pragma unroll
            for (int m = 0; m < 4; ++m)
#pragma unroll
                for (int bj = 0; bj < 2; ++bj) { const u32x4 w = pack_bf16x8(acc[ai][bj][m][0], acc[ai][bj][m][1]); u32x4* p = (u32x4*)at(O, o0 + (unsigned)(ai * HALF + m * 16) * rs + bj * HALF * 2);
                    *p = w;
#ifdef EXP_DOUBLE_STORE
                    if (ldc == INW) { asm volatile("" ::: "memory"); *p = w; asm volatile("" ::: "memory"); }
#endif
                }
    }
};
struct EpiFourier {
    static constexpr int PERM = 1; unsigned char* FF  ; int rowbase, rows_b, hp, mirror; float osc  ;
    __device__ __forceinline__ void operator()(const Acc& acc, const Unit& u, int wr, int wc, int fr, int fq) const {
        const int reim = u.pm / hp, pr = u.pm % hp;
        const int n0 = pr * 256 + wr * 64 + fr, rb = rowbase + u.e * rows_b;
        const unsigned c0 = (unsigned)(reim * 512 + u.pn * 256 + wc * 32 + 8 * fq);
        const float sg = (mirror && reim) ? -osc : osc;
#pragma unroll
        for (int ai = 0; ai < 2; ++ai)
#pragma unroll
            for (int m = 0; m < 4; ++m) { const int np = n0 + ai * HALF + m * 16;
#pragma unroll
                for (int bj = 0; bj < 2; ++bj) {
                    *(u32x2*)at(FF, (unsigned)(rb + np) * 1024u + c0 + bj * HALF) = pack_fp8x8(acc[ai][bj][m][0], acc[ai][bj][m][1], osc);
                    if (mirror && np != 0) *(u32x2*)at(FF, (unsigned)(rb + rows_b - np) * 1024u + c0 + bj * HALF) = pack_fp8x8(acc[ai][bj][m][0], acc[ai][bj][m][1], sg); } }
    }
};
struct EpiF32 {
    static constexpr int PERM = 0; float* C; int ldc;
    __device__ __forceinline__ void operator()(const Acc& acc, const Unit& u, int wr, int wc, int fr, int fq) const {
        const unsigned o0 = (unsigned)((u.pm * 256 + wr * 64 + fr) * ldc + u.pn * 256 + wc * 32 + 4 * fq) * 4u, rs = (unsigned)ldc * 4u;
#pragma unroll
        for (int ai = 0; ai < 2; ++ai)
#pragma unroll
            for (int m = 0; m < 4; ++m)
#pragma unroll
                for (int bj = 0; bj < 2; ++bj)
#pragma unroll
                    for (int n = 0; n < 2; ++n) *(f32x4*)at(C, o0 + (unsigned)(ai * HALF + m * 16) * rs + (bj * HALF + n * 16) * 4) = acc[ai][bj][m][n];
    }
};
template <int MODE  > struct EpiGate {
    static constexpr int PERM = 0; float* Y; bf16* YB; const bf16* P; int br;
    __device__ __forceinline__ void operator()(const Acc& acc, const Unit& u, int wr, int wc, int fr, int fq) const {
        const int row0 = u.pm * 256 + wr * 64 + fr, col0 = u.pn * 256 + wc * 32 + 4 * fq;
        const unsigned e0 = (unsigned)(row0 * 1024 + col0), p0 = (unsigned)(row0 * INW + C_GL + br * 1024 + col0) * 2u;
#pragma unroll
        for (int ai = 0; ai < 2; ++ai)
#pragma unroll
            for (int m = 0; m < 4; ++m)
#pragma unroll
                for (int bj = 0; bj < 2; ++bj)
#pragma unroll
                    for (int n = 0; n < 2; ++n) { const unsigned rr = (unsigned)(ai * HALF + m * 16), cc = (unsigned)(bj * HALF + n * 16), e = e0 + rr * 1024u + cc;
                        const u32x2 gw = *(const u32x2*)at(P, p0 + rr * (INW * 2u) + cc * 2u);
                        f32x4 g; g[0] = sigmoidf_(bflo(gw.x)); g[1] = sigmoidf_(bfhi(gw.x)); g[2] = sigmoidf_(bflo(gw.y)); g[3] = sigmoidf_(bfhi(gw.y));
                        f32x4 v = acc[ai][bj][m][n] * g;
                        if (MODE >= 1) v += *(const f32x4*)at(Y, e * 4u);
                        if (MODE <= 1) *(f32x4*)at(Y, e * 4u) = v;
                        else { u32x2 w; w.x = cvt_pk_bf16(v[0], v[1]); w.y = cvt_pk_bf16(v[2], v[3]); *(u32x2*)at(YB, e * 2u) = w; } }
    }
};
struct EpiWout {
    static constexpr int PERM = 0; float* tmix; const float* xlat; const float* xctx; const float* modl  ; int goff  ;
    __device__ __forceinline__ void operator()(const Acc& acc, const Unit& u, int wr, int wc, int fr, int fq) const {
        const int rowt = u.pm * 256; const bool isctx = rowt >= T_LAT;
        const int v = isctx ? 8 : rowt / NSEQ;
        const float* xs = isctx ? xctx + (size_t)(rowt - T_LAT) * 1024 : xlat + (size_t)rowt * 1024;
        float* tm = tmix + (size_t)rowt * 1024;
        const float* gv = modl + v * 6144 + goff;
        const unsigned col0 = (unsigned)(u.pn * 256 + wc * 32 + 4 * fq), e0 = (unsigned)((wr * 64 + fr) * 1024) + col0;
        f32x4 gg[2][2];
#pragma unroll
        for (int bj = 0; bj < 2; ++bj)
#pragma unroll
            for (int n = 0; n < 2; ++n) gg[bj][n] = *(const f32x4*)at(gv, (col0 + bj * HALF + n * 16) * 4u);
#pragma unroll
        for (int ai = 0; ai < 2; ++ai)
#pragma unroll
            for (int m = 0; m < 4; ++m)
#pragma unroll
                for (int bj = 0; bj < 2; ++bj)
#pragma unroll
                    for (int n = 0; n < 2; ++n) { const unsigned e = (e0 + (unsigned)(ai * HALF + m * 16) * 1024u + (unsigned)(bj * HALF + n * 16)) * 4u;
                        const f32x4 xv = *(const f32x4*)at(xs, e);
                        *(f32x4*)at(tm, e) = xv * DN_ALPHA + gg[bj][n] * acc[ai][bj][m][n]; }
    }
};
struct EpiSwiglu {
    static constexpr int PERM = 1; unsigned char* ACT; float inv;
    __device__ __forceinline__ void operator()(const Acc& acc, const Unit& u, int wr, int wc, int fr, int fq) const {
        const unsigned o0 = (unsigned)((u.pm * 256 + wr * 64 + fr) * 256 + u.pn * 128 + wc * 32 + 8 * fq);
#pragma unroll
        for (int ai = 0; ai < 2; ++ai)
#pragma unroll
            for (int m = 0; m < 4; ++m) {
                const f32x4 g0 = acc[ai][0][m][0] * inv, g1 = acc[ai][0][m][1] * inv, u0 = acc[ai][1][m][0] * inv, u1 = acc[ai][1][m][1] * inv;
                f32x4 a, b;
#pragma unroll
                for (int j = 0; j < 4; ++j) { a[j] = siluf_(g0[j]) * u0[j]; b[j] = siluf_(g1[j]) * u1[j]; }
                *(u32x2*)at(ACT, o0 + (unsigned)(ai * HALF + m * 16) * 256u) = pack_fp8x8(a, b, YS_SCALE); }
    }
};
struct EpiDown {
    static constexpr int PERM = 2; unsigned char* Y; const LAS float* sw  ; float osc  ;
    __device__ __forceinline__ void operator()(const Acc& acc, const Unit& u, int wr, int wc, int fr, int fq) const {
        const int r0 = u.pm * 256 + wr * 64 + fr; const LAS float* swu = sw + u.aux * 256 + wr * 64 + fr;
        const unsigned o0 = (unsigned)(r0 * 1024 + u.pn * 256 + wc * 64 + 16 * fq);
#pragma unroll
        for (int ai = 0; ai < 2; ++ai)
#pragma unroll
            for (int m = 0; m < 4; ++m) { const float w8 = swu[ai * HALF + m * 16] * osc;
                if (w8 != 0.f) {
                    u32x4 w;
                    { const f32x4 v0 = acc[ai][0][m][0] * w8, v1 = acc[ai][0][m][1] * w8; w.x = pack_fp8x4(v0[0], v0[1], v0[2], v0[3]); w.y = pack_fp8x4(v1[0], v1[1], v1[2], v1[3]); }
                    { const f32x4 v0 = acc[ai][1][m][0] * w8, v1 = acc[ai][1][m][1] * w8; w.z = pack_fp8x4(v0[0], v0[1], v0[2], v0[3]); w.w = pack_fp8x4(v1[0], v1[1], v1[2], v1[3]); }
                    *(u32x4*)at(Y, o0 + (unsigned)(ai * HALF + m * 16) * 1024u) = w; } }
    }
};
}
struct Frame {
    LAS unsigned char* lds; int tid, lane, wave, G, bid;
    unsigned char* ws;
};
#ifndef GMASK
#define GMASK 0x1u
#endif
#define PHG_ON (((GMASK >> PHG) & 1u) != 0)
template <bool G> __device__ __forceinline__ const float* karg_t(int i) {
    unsigned long long p = (unsigned long long)__builtin_amdgcn_kernarg_segment_ptr();
    asm volatile("" : "+s"(p));
    if (!G) return ((const float* const __attribute__((address_space(4)))*)p)[i];
    return (const float*)(((const float __attribute__((address_space(1)))* const __attribute__((address_space(4)))*)p)[i]);
}
#define KIN(i) karg_t<PHG_ON>(i)
#define karg(i) KIN(i)
__device__ __forceinline__ int karg_int(int byte_off) {
    unsigned long long p = (unsigned long long)__builtin_amdgcn_kernarg_segment_ptr();
    asm volatile("" : "+s"(p));
    return *(const int __attribute__((address_space(4)))*)(p + byte_off);
}
#ifdef SUBSEL
__device__ __forceinline__ void substamp_(LAS unsigned char* lds, int k, bool add) {
    volatile LAS unsigned* sb = (volatile LAS unsigned*)(lds + MISC_OFF + 288);
    const unsigned n = (unsigned)__builtin_amdgcn_s_memrealtime();
    if (add) sb[k] += n - sb[15];
    sb[15] = n;
}
#define SUBSTAMP(k) do { if (F.bid == 0 && F.wave == 0) substamp_(F.lds, (k), true); } while (0)
#define SUBRESET() do { if (F.bid == 0 && F.wave == 0) substamp_(F.lds, 0, false); } while (0)
#else
#define SUBSTAMP(k) do { } while (0)
#define SUBRESET() do { } while (0)
#endif
enum { I_X = 0, I_C, I_CTX, I_CCTX, I_ADAW, I_ADAB, I_WIN, I_RPB, I_WONA, I_WFOUR, I_DECF, I_DECB, I_GNW, I_WORET, I_WOUT, I_LNMW, I_LNMB,
       I_ROUTW, I_ROUTB, I_EWG, I_EWU, I_EWD, I_SWG, I_SWU, I_SWD, I_LNFW, I_LNFB };
template <bool G> __device__ __forceinline__ unsigned char* ws_opaque_t(unsigned char* p) { unsigned long long v = (unsigned long long)p; asm volatile("" : "+s"(v));
    if (G) return (unsigned char*)(__attribute__((address_space(1))) unsigned char*)v;
    return (unsigned char*)v; }
#define ws_opaque(p) ws_opaque_t<PHG_ON>(p)
#define WSP(T, off) ((T*)(ws_opaque(F.ws) + (off)))
constexpr int NWAVES = 8;
#define PHG 1

__device__ __forceinline__ void tr_item(const float* W, int N, int k0, int n0, bf16* WT, int ldt, int drow0, LAS float* scr, int lane) {
#pragma unroll
    for (int hb = 0; hb < 2; ++hb) { float wv[16];
#pragma unroll
        for (int i = 0; i < 16; ++i) { const int kk = 2 * (16 * hb + i) + (lane >> 5); wv[i] = W[(size_t)(k0 + kk) * N + n0 + (lane & 31)]; }
#pragma unroll
        for (int i = 0; i < 16; ++i) { const int kk = 2 * (16 * hb + i) + (lane >> 5); scr[kk * 33 + (lane & 31)] = wv[i]; } }
    LDS_WAIT(); asm volatile("" ::: "memory");
    const int c = lane & 7;
#pragma unroll
    for (int j = 0; j < 4; ++j) { const int n = (lane >> 3) + 8 * j; const LAS float* s = scr + (8 * c) * 33 + n;
        u32x4 o; o.x = pk2(s[0 * 33], s[1 * 33]); o.y = pk2(s[2 * 33], s[3 * 33]); o.z = pk2(s[4 * 33], s[5 * 33]); o.w = pk2(s[6 * 33], s[7 * 33]);
        *(u32x4*)(WT + (size_t)(drow0 + n) * ldt + k0 + 8 * c) = o; }
    LDS_WAIT(); asm volatile("" ::: "memory");
}

__device__ __forceinline__ void row_load(const float* p, int lane, f32x4 (&v)[4]) {
#pragma unroll
    for (int j = 0; j < 4; ++j) v[j] = *(const f32x4*)(p + 4 * lane + 256 * j);
}
__device__ __forceinline__ void row_ln(f32x4 (&v)[4]) {
    float s = 0.f;
#pragma unroll
    for (int j = 0; j < 4; ++j) s += (v[j][0] + v[j][1]) + (v[j][2] + v[j][3]);
    const float mean = wave_sum(s) * (1.f / D); float s2 = 0.f;
#pragma unroll
    for (int j = 0; j < 4; ++j) { v[j] = v[j] - mean; s2 += (v[j][0] * v[j][0] + v[j][1] * v[j][1]) + (v[j][2] * v[j][2] + v[j][3] * v[j][3]); }
    const float rstd = 1.f / sqrtf(wave_sum(s2) * (1.f / D) + LN_EPS);
#pragma unroll
    for (int j = 0; j < 4; ++j) v[j] = v[j] * rstd;
}
__device__ __forceinline__ void row_affine(f32x4 (&v)[4], const float* w, const float* b, int lane, bool one_plus) {
#pragma unroll
    for (int j = 0; j < 4; ++j) { f32x4 ww = *(const f32x4*)(w + 4 * lane + 256 * j); const f32x4 bb = *(const f32x4*)(b + 4 * lane + 256 * j);
        if (one_plus) ww = ww + 1.f; v[j] = v[j] * ww + bb; }
}
__device__ __forceinline__ void row_store_bf16(bf16* p, int lane, const f32x4 (&v)[4]) {
#pragma unroll
    for (int j = 0; j < 4; ++j) { u32x2 w; w.x = pk2(v[j][0], v[j][1]); w.y = pk2(v[j][2], v[j][3]); *(u32x2*)(p + 4 * lane + 256 * j) = w; }
}
__device__ __forceinline__ void row_store_f32(float* p, int lane, const f32x4 (&v)[4]) {
#pragma unroll
    for (int j = 0; j < 4; ++j) *(f32x4*)(p + 4 * lane + 256 * j) = v[j];
}
__device__ __forceinline__ const float* mod_vec(const Frame& F, int l, int row) {
    const int v = row >= T_LAT ? 8 : row / NSEQ; return WSP(const float, WS_MOD) + ((size_t)l * 9 + v) * 6144;
}

constexpr int TRF_P = 72, TRF_BYTES = 128 * TRF_P * 2;
__device__ __forceinline__ void tr_item_fast(const float* W, int N, int k0, int n0, bf16* WT, int ldt, int drow0, LAS bf16* tl, int lane) {
    const int hf = lane >> 5, c = lane & 31;
    f32x4 v[16][2];
#pragma unroll
    for (int i = 0; i < 16; ++i)
#pragma unroll
        for (int q = 0; q < 2; ++q) v[i][q] = *(const f32x4*)(W + (size_t)(k0 + 4 * i + 2 * hf + q) * N + n0 + 4 * c);
#pragma unroll
    for (int i = 0; i < 16; ++i)
#pragma unroll
        for (int j = 0; j < 4; ++j) *(LAS unsigned*)(tl + (4 * c + j) * TRF_P + 4 * i + 2 * hf) = pk2(v[i][0][j], v[i][1][j]);
    LDS_WAIT(); asm volatile("" ::: "memory");
#pragma unroll
    for (int it = 0; it < 16; ++it) { const int p = it * 64 + lane, n = p >> 3, kc = p & 7;
        *(u32x4*)(WT + (size_t)(drow0 + n) * ldt + k0 + 8 * kc) = *(const LAS u32x4*)(tl + n * TRF_P + 8 * kc); }
    LDS_WAIT(); asm volatile("" ::: "memory");
}
__device__ __forceinline__ void tr_item_fast8(const float* W, int N, int k0, int n0, unsigned char* WT8, int ldt, int drow0, LAS unsigned char* tl, int lane, float wscale) {
    const int hf = lane >> 5, c = lane & 31;
    f32x4 v[8][4];
#pragma unroll
    for (int i = 0; i < 8; ++i)
#pragma unroll
        for (int q = 0; q < 4; ++q) v[i][q] = *(const f32x4*)(W + (size_t)(k0 + 8 * i + 4 * hf + q) * N + n0 + 4 * c);
#pragma unroll
    for (int i = 0; i < 8; ++i)
#pragma unroll
        for (int j = 0; j < 4; ++j) *(LAS unsigned*)(tl + (4 * c + j) * 80 + 8 * i + 4 * hf) = pg8::pack_fp8x4(v[i][0][j] * wscale, v[i][1][j] * wscale, v[i][2][j] * wscale, v[i][3][j] * wscale);
    LDS_WAIT(); asm volatile("" ::: "memory");
#pragma unroll
    for (int it = 0; it < 8; ++it) { const int p = it * 64 + lane, n = p >> 2, kc = p & 3;
        *(u32x4*)(WT8 + (size_t)(drow0 + n) * ldt + k0 + 16 * kc) = *(const LAS u32x4*)(tl + n * 80 + 16 * kc); }
    LDS_WAIT(); asm volatile("" ::: "memory");
}
constexpr float WGU_SCALE = 32.f;
#undef PHG
#define PHG 1
__device__ __forceinline__ void phase_init(const Frame& F_) {
    Frame F = F_; asm volatile("" : "+s"(F.bid), "+s"(F.G), "+s"(F.wave)); F.lane = lane_id_(); asm volatile("" : "+v"(F.lane)); F.tid = F.wave * 64 + F.lane;
    const int gw = F.bid * NWAVES + F.wave, NGW = F.G * NWAVES;
    {
        LAS float* red = (LAS float*)F.lds;
        float* mod = WSP(float, WS_MOD);
        for (int u = F.bid; u < 2 * 96; u += F.G) {
            const int l = u / 96, n0 = (u % 96) * 64;
            const float* aw = KIN(I_ADAW) + (size_t)l * D * 6144;
            float acc[9];
#pragma unroll
            for (int v = 0; v < 9; ++v) acc[v] = 0.f;
            const float* cin = KIN(I_C); const float* ccx = KIN(I_CCTX);
            for (int k0 = F.wave * 128; k0 < F.wave * 128 + 128; k0 += 16) {
                float wv[16];
#pragma unroll
                for (int j = 0; j < 16; ++j) wv[j] = aw[(size_t)(k0 + j) * 6144 + n0 + F.lane];
#pragma unroll
                for (int j = 0; j < 16; ++j)
#pragma unroll
                    for (int v = 0; v < 9; ++v) { const float cv = v < 8 ? cin[v * D + k0 + j] : ccx[k0 + j]; acc[v] += siluf_(cv) * wv[j]; }
            }
#pragma unroll
            for (int v = 0; v < 9; ++v) red[(F.wave * 9 + v) * 64 + F.lane] = acc[v];
            __syncthreads();
            for (int o = F.tid; o < 9 * 64; o += 512) { const int v = o / 64, ln = o % 64; float s = 0.f;
#pragma unroll
                for (int w = 0; w < 8; ++w) s += red[(w * 9 + v) * 64 + ln];
                mod[((size_t)l * 9 + v) * 6144 + n0 + ln] = s + KIN(I_ADAB)[(size_t)l * 6144 + n0 + ln]; }
            __syncthreads();
        }
    }
    {
        float* rc = WSP(float, WS_ROPE); float* rs = rc + 2048;
        for (int i = F.bid * 512 + F.tid; i < 2048; i += F.G * 512) { const int pos = i / 32, f = i % 32;
            const double ang = (double)pos * pow(10000.0, -(double)f / 32.0); rc[i] = (float)cos(ang); rs[i] = (float)sin(ang); }
    }
    {
        __syncthreads();
        LAS float* ctab = (LAS float*)F.lds;
        for (int i = F.tid; i < 4096; i += 512) ctab[i] = cospif((float)i * (1.0f / 2048.0f));
        __syncthreads();
        unsigned char* dft = WSP(unsigned char, WS_DFT);
        for (size_t i = (size_t)F.bid * 512 + F.tid; i < (size_t)4096 * 512; i += (size_t)F.G * 512) {
            const int row = (int)(i / 512), n0 = (int)(i % 512) * 8, reim = row / 2048, np = row % 2048; float v[8];
#pragma unroll
            for (int j = 0; j < 8; ++j) { const int m = ((n0 + j) * np) & 4095; v[j] = (reim ? -ctab[(m - 1024) & 4095] : ctab[m]) * 64.f; }
            u32x2 o; o.x = pg8::pack_fp8x4(v[0], v[1], v[2], v[3]); o.y = pg8::pack_fp8x4(v[4], v[5], v[6], v[7]);
            *(u32x2*)(dft + (size_t)row * 4096 + n0) = o;
        }
        bf16* dftc = WSP(bf16, WS_DFTC); const float scc = 1.0f / 181.01933598375618f;
        for (int i = F.bid * 512 + F.tid; i < 512 * 32; i += F.G * 512) {
            const int row = i / 32, n0 = (i % 32) * 8, reim = row / 256, np = row % 256; float v[8];
#pragma unroll
            for (int j = 0; j < 8; ++j) { const int m = (((n0 + j) * np) & 255) * 16; v[j] = (reim ? -ctab[(m - 1024) & 4095] : ctab[m]) * scc; }
            u32x4 o; o.x = pk2(v[0], v[1]); o.y = pk2(v[2], v[3]); o.z = pk2(v[4], v[5]); o.w = pk2(v[6], v[7]);
            *(u32x4*)(dftc + (size_t)row * 256 + n0) = o;
        }
        __syncthreads();
    }
    {
        LAS float* scr = (LAS float*)(F.lds + 16384 + F.wave * 16384);
        constexpr int I_IN = 16 * 64, I_NA = 8 * 8, I_RET = 16 * 8, I_OUT = 16 * 8, I_RT = 16 * 8, PER = I_IN + I_NA + I_RET + I_OUT + I_RT;
        for (int it = gw; it < 2 * PER; it += NGW) {
            const int l = it / PER; int r = it % PER; unsigned char* wb = ws_opaque(F.ws) + WS_WNE + (size_t)l * WNE_STRIDE;
            const float* W; int K, N; bf16* WT;
            if (r < I_IN) {
                tr_item_fast8(KIN(I_WIN) + (size_t)l * 1024 * 8192, 8192, (r / 64) * 64, (r % 64) * 128, wb + WNE_WIN, WIN_LD, (r % 64) * 128, (LAS unsigned char*)scr, F.lane, WGU_SCALE); continue; }
            else if ((r -= I_IN) < I_NA) {
                tr_item_fast8(KIN(I_WONA) + (size_t)l * 512 * 1024, 1024, (r / 8) * 64, (r % 8) * 128, wb + WNE_ONA, 512, (r % 8) * 128, (LAS unsigned char*)scr, F.lane, WGU_SCALE); continue; }
            else if ((r -= I_NA) < I_RET) {
                tr_item_fast8(KIN(I_WORET) + (size_t)l * 1024 * 1024, 1024, (r / 8) * 64, (r % 8) * 128, wb + WNE_ORET, 1024, (r % 8) * 128, (LAS unsigned char*)scr, F.lane, WGU_SCALE); continue; }
            else if ((r -= I_RET) < I_OUT) {
                tr_item_fast8(KIN(I_WOUT) + (size_t)l * 1024 * 1024, 1024, (r / 8) * 64, (r % 8) * 128, wb + WNE_WOUT, 1024, (r % 8) * 128, (LAS unsigned char*)scr, F.lane, WGU_SCALE); continue; }
            else { r -= I_OUT; W = KIN(I_ROUTW) + (size_t)l * 1024 * 256; K = 1024; N = 256; WT = (bf16*)(wb + WNE_ROUT); }
            const int nblk = N / 32, kb = r / nblk, nb = r % nblk;
            tr_item(W, N, kb * 64, nb * 32, WT, K, nb * 32, scr, F.lane);
        }
        __syncthreads();
        LAS float* ctab2 = (LAS float*)F.lds;
        for (int i = F.tid; i < 4096; i += 512) ctab2[i] = cospif((float)i * (1.0f / 2048.0f));
        __syncthreads();
        for (int it = gw; it < 2 * 1024 * 16; it += NGW) {
            const int l = it / (1024 * 16), r = it % (1024 * 16), kk = r / 16, nb = r % 16, reim = kk / 512, g = (kk % 512) / 128, c = kk % 128, n = nb * 64 + F.lane;
            const float* wf = KIN(I_WFOUR) + (size_t)l * 512 * 1024 + (size_t)g * 128 * 1024 + n; float acc = 0.f;
            for (int cp = 0; cp < 128; ++cp) { const int m = ((c * cp) & 127) * 32; const float gv = reim ? ctab2[(m - 1024) & 4095] : ctab2[m]; acc += gv * wf[(size_t)cp * 1024]; }
            unsigned char* WT = ws_opaque(F.ws) + WS_WNE + (size_t)l * WNE_STRIDE + WNE_WF;
            WT[(size_t)n * 1024 + kk] = (unsigned char)(pg8::pack_fp8x4(acc * WGU_SCALE, 0.f, 0.f, 0.f) & 0xffu);
        }
    }
}

#undef PHG
#define PHG 2
__device__ __forceinline__ void phase_expert_prep(const Frame& F_, int l, int wi, int nw) {
    Frame F = F_; asm volatile("" : "+s"(F.bid), "+s"(F.G), "+s"(F.wave)); F.lane = lane_id_(); asm volatile("" : "+v"(F.lane)); F.tid = F.wave * 64 + F.lane;
    const int gw = wi * NWAVES + F.wave, NGW = nw * NWAVES;
    LAS bf16* tl = (LAS bf16*)(F.lds + F.wave * TRF_BYTES);
    unsigned char* WGU8 = WSP(unsigned char, WS_WGU); unsigned char* WD8 = WSP(unsigned char, WS_WD);
    for (int it = gw; it < 257 * 96; it += NGW) {
        const int e = it / 96, r = it % 96, which = r / 32, q = r % 32;
        if (which < 2) {
            const float* We = which ? KIN(I_EWU) : KIN(I_EWG); const float* Ws = which ? KIN(I_SWU) : KIN(I_SWG);
            const float* W = e < 256 ? We + ((size_t)l * 256 + e) * 1024 * 256 : Ws + (size_t)l * 1024 * 256;
            const int kb = q / 2, nb = q % 2;
            tr_item_fast8(W, 256, kb * 64, nb * 128, WGU8 + (size_t)e * 512 * 1024, 1024, 256 * nb + which * 128, (LAS unsigned char*)tl, F.lane, WGU_SCALE);
        } else {
            const float* W = e < 256 ? KIN(I_EWD) + ((size_t)l * 256 + e) * 256 * 1024 : KIN(I_SWD) + (size_t)l * 256 * 1024;
            const int kb = q / 8, nb = q % 8;
            tr_item_fast8(W, 1024, kb * 64, nb * 128, WD8 + (size_t)e * 1024 * 256, 256, nb * 128, (LAS unsigned char*)tl, F.lane, WGU_SCALE);
        }
    }
}
#undef PHG
#define PHG 3
__device__ __forceinline__ void phase_h0(const Frame& F_) {
    Frame F = F_; asm volatile("" : "+s"(F.bid), "+s"(F.G), "+s"(F.wave)); F.lane = lane_id_(); asm volatile("" : "+v"(F.lane)); F.tid = F.wave * 64 + F.lane;
    const int gw = F.bid * NWAVES + F.wave, NGW = F.G * NWAVES;
    unsigned char* H8 = WSP(unsigned char, WS_H8);
    for (int row = gw; row < T_ALL; row += NGW) {
        const float* src = row < T_LAT ? KIN(I_X) + (size_t)row * D : KIN(I_CTX) + (size_t)(row - T_LAT) * D;
        f32x4 v[4]; row_load(src, F.lane, v); row_ln(v);
        const float* mv = mod_vec(F, 0, row); row_affine(v, mv + 1024, mv, F.lane, true);
#pragma unroll
        for (int j = 0; j < 4; ++j) *(unsigned*)(H8 + (size_t)row * D + 4 * F.lane + 256 * j) = pg8::pack_fp8x4(v[j][0], v[j][1], v[j][2], v[j][3]);
    }
}

#undef PHG
#define PHG 3
__device__ __forceinline__ void phase_gatesum(const Frame& F_, int nrows) {
    Frame F = F_; asm volatile("" : "+s"(F.bid), "+s"(F.G), "+s"(F.wave)); F.lane = lane_id_(); asm volatile("" : "+v"(F.lane)); F.tid = F.wave * 64 + F.lane;
    const int gw = F.bid * NWAVES + F.wave, NGW = F.G * NWAVES, lane = F.lane;
    const unsigned char* G8 = WSP(const unsigned char, WS_G8); unsigned char* Y = WSP(unsigned char, WS_YSUMB);
    const unsigned char* Z0 = WSP(const unsigned char, WS_ZNA); const unsigned char* Z1 = WSP(const unsigned char, WS_ZFF); const unsigned char* Z2 = WSP(const unsigned char, WS_ZRET);
#define GS_LOAD(G_, Z_, row_) do { _Pragma("unroll") for (int j = 0; j < 2; ++j) { const int col = j * 512 + lane * 8; \
        _Pragma("unroll") for (int b = 0; b < 3; ++b) { const unsigned char* Zb = b == 0 ? Z0 : (b == 1 ? Z1 : Z2); \
            G_[j][b] = *(const u32x2*)(G8 + (size_t)(row_) * 3072 + b * 1024 + col); Z_[j][b] = *(const u32x2*)(Zb + (size_t)(row_) * 1024 + col); } } } while (0)
#define GS_COMP(G_, Z_, row_) do { _Pragma("unroll") for (int j = 0; j < 2; ++j) { const int col = j * 512 + lane * 8; float acc[8]; \
        _Pragma("unroll") for (int q = 0; q < 8; ++q) acc[q] = 0.f; \
        _Pragma("unroll") for (int b = 0; b < 3; ++b) { \
            _Pragma("unroll") for (int hw = 0; hw < 2; ++hw) { const int gwd = hw ? (int)G_[j][b].y : (int)G_[j][b].x, zwd = hw ? (int)Z_[j][b].y : (int)Z_[j][b].x; \
                const f32x2 g0 = __builtin_amdgcn_cvt_pk_f32_fp8(gwd, false), g1 = __builtin_amdgcn_cvt_pk_f32_fp8(gwd, true), z0 = __builtin_amdgcn_cvt_pk_f32_fp8(zwd, false), z1 = __builtin_amdgcn_cvt_pk_f32_fp8(zwd, true); \
                acc[4 * hw + 0] += sigmoidf_(g0.x * pg8::YS_INV) * z0.x; acc[4 * hw + 1] += sigmoidf_(g0.y * pg8::YS_INV) * z0.y; \
                acc[4 * hw + 2] += sigmoidf_(g1.x * pg8::YS_INV) * z1.x; acc[4 * hw + 3] += sigmoidf_(g1.y * pg8::YS_INV) * z1.y; } } \
        u32x2 o; o.x = pg8::pack_fp8x4(acc[0], acc[1], acc[2], acc[3]); o.y = pg8::pack_fp8x4(acc[4], acc[5], acc[6], acc[7]);     \
        *(u32x2*)(Y + (size_t)(row_) * 1024 + col) = o; } } while (0)
    u32x2 ga[2][3], za[2][3], gb[2][3], zb[2][3];
    int row = gw;
    if (row < nrows) GS_LOAD(ga, za, row);
    while (row < nrows) {
        const int r1 = row + NGW, r2 = r1 + NGW;
        if (r1 < nrows) GS_LOAD(gb, zb, r1);
        GS_COMP(ga, za, row);
        if (r1 < nrows) { if (r2 < nrows) GS_LOAD(ga, za, r2); GS_COMP(gb, zb, r1); }
        row = r2;
    }
#undef GS_LOAD
#undef GS_COMP
}
#undef PHG
#define PHG 3
__device__ __forceinline__ void phase_ln_mix(const Frame& F_, int l, int nrows) {
    Frame F = F_; asm volatile("" : "+s"(F.bid), "+s"(F.G), "+s"(F.wave)); F.lane = lane_id_(); asm volatile("" : "+v"(F.lane)); F.tid = F.wave * 64 + F.lane;
    const int gw = F.bid * NWAVES + F.wave, NGW = F.G * NWAVES, lane = F.lane;
    const unsigned char* YO = WSP(const unsigned char, WS_YOUT); bf16* X = WSP(bf16, WS_X); bf16* H = WSP(bf16, WS_H); unsigned char* H8 = WSP(unsigned char, WS_H8);
    const float* xin = KIN(I_X); const float* cin = KIN(I_CTX);
    const float* lnw = KIN(I_LNMW) + (size_t)l * D; const float* lnb = KIN(I_LNMB) + (size_t)l * D;
#define LM_LOAD(V_, Y_, row_) do { if (l == 0) row_load((row_) < T_LAT ? xin + (size_t)(row_) * D : cin + (size_t)((row_) - T_LAT) * D, lane, V_); \
        else { _Pragma("unroll") for (int j = 0; j < 4; ++j) { const u32x2 xw = *(const u32x2*)(X + (size_t)(row_) * D + 4 * lane + 256 * j); V_[j][0] = bflo(xw.x); V_[j][1] = bfhi(xw.x); V_[j][2] = bflo(xw.y); V_[j][3] = bfhi(xw.y); } } \
        _Pragma("unroll") for (int j = 0; j < 4; ++j) Y_[j] = *(const unsigned*)(YO + (size_t)(row_) * D + 4 * lane + 256 * j); } while (0)
#define LM_COMP(V_, Y_, row_) do { const float* mv = mod_vec(F, l, (row_)); \
        _Pragma("unroll") for (int j = 0; j < 4; ++j) { const f32x2 y0 = __builtin_amdgcn_cvt_pk_f32_fp8((int)Y_[j], false), y1 = __builtin_amdgcn_cvt_pk_f32_fp8((int)Y_[j], true); const f32x4 g1 = *(const f32x4*)(mv + 2048 + 4 * lane + 256 * j) * pg8::YS_INV; \
            V_[j][0] = DN_ALPHA * V_[j][0] + g1[0] * y0.x; V_[j][1] = DN_ALPHA * V_[j][1] + g1[1] * y0.y; V_[j][2] = DN_ALPHA * V_[j][2] + g1[2] * y1.x; V_[j][3] = DN_ALPHA * V_[j][3] + g1[3] * y1.y; } \
        row_ln(V_); row_affine(V_, lnw, lnb, lane, false); row_store_bf16(X + (size_t)(row_) * D, lane, V_); \
        row_ln(V_); row_affine(V_, mv + 4096, mv + 3072, lane, true); row_store_bf16(H + (size_t)(row_) * D, lane, V_); \
        _Pragma("unroll") for (int j = 0; j < 4; ++j) *(unsigned*)(H8 + (size_t)(row_) * D + 4 * lane + 256 * j) = pg8::pack_fp8x4(V_[j][0], V_[j][1], V_[j][2], V_[j][3]); } while (0)
    f32x4 va[4], vb[4]; unsigned ya[4], yb[4];
    int row = gw;
    if (row < nrows) LM_LOAD(va, ya, row);
    while (row < nrows) {
        const int r1 = row + NGW, r2 = r1 + NGW;
        if (r1 < nrows) LM_LOAD(vb, yb, r1);
        LM_COMP(va, ya, row);
        if (r1 < nrows) { if (r2 < nrows) LM_LOAD(va, ya, r2); LM_COMP(vb, yb, r1); }
        row = r2;
    }
#undef LM_LOAD
#undef LM_COMP
}
typedef __attribute__((ext_vector_type(4))) float facc;
__device__ __forceinline__ facc mma16(bf16x8 a, bf16x8 b, facc c) { return __builtin_amdgcn_mfma_f32_16x16x32_bf16(a, b, c, 0, 0, 0); }
__device__ __forceinline__ bf16x8 lds_gather8(const LAS bf16* p, int stride) {
    bf16x8 r;
#pragma unroll
    for (int j = 0; j < 8; ++j) r[j] = (short)p[j * stride];
    return r;
}
__device__ __forceinline__ bf16x8 pack8(const facc& a, const facc& b) {
    u32x4 w; w.x = pg8::cvt_pk_bf16(a[0], a[1]); w.y = pg8::cvt_pk_bf16(a[2], a[3]); w.z = pg8::cvt_pk_bf16(b[0], b[1]); w.w = pg8::cvt_pk_bf16(b[2], b[3]);
    return __builtin_bit_cast(bf16x8, w);
}
constexpr float LOG2E = 1.4426950408889634f;
typedef short bf16x4s __attribute__((ext_vector_type(4)));
__device__ __forceinline__ unsigned lds_addr_(const LAS void* p) { return (unsigned)(unsigned long long)(const LAS char*)p; }
__device__ __forceinline__ unsigned tr_lane_addr(const LAS bf16* tile  , int pitch, int lane) {
    const int g = lane >> 4, q = (lane & 15) >> 2, p = lane & 3; return lds_addr_(tile + (8 * g + q) * pitch + 4 * p); }
#define TR4(o, a0, a1, a2, a3, off4  ) do { bf16x4s l0_, h0_, l1_, h1_, l2_, h2_, l3_, h3_; \
    const unsigned b0_ = (a0) + (off4), b1_ = (a1) + (off4), b2_ = (a2) + (off4), b3_ = (a3) + (off4); \
    asm volatile("ds_read_b64_tr_b16 %0, %8\n\tds_read_b64_tr_b16 %1, %9\n\tds_read_b64_tr_b16 %2, %10\n\tds_read_b64_tr_b16 %3, %11\n\t" \
                 "ds_read_b64_tr_b16 %4, %12\n\tds_read_b64_tr_b16 %5, %13\n\tds_read_b64_tr_b16 %6, %14\n\tds_read_b64_tr_b16 %7, %15\n\ts_waitcnt lgkmcnt(0)" \
                 : "=&v"(l0_), "=&v"(h0_), "=&v"(l1_), "=&v"(h1_), "=&v"(l2_), "=&v"(h2_), "=&v"(l3_), "=&v"(h3_) \
                 : "v"(a0), "v"(b0_), "v"(a1), "v"(b1_), "v"(a2), "v"(b2_), "v"(a3), "v"(b3_) : "memory"); \
    __builtin_amdgcn_sched_barrier(0); \
    (o)[0] = __builtin_shufflevector(l0_, h0_, 0, 1, 2, 3, 4, 5, 6, 7); (o)[1] = __builtin_shufflevector(l1_, h1_, 0, 1, 2, 3, 4, 5, 6, 7); \
    (o)[2] = __builtin_shufflevector(l2_, h2_, 0, 1, 2, 3, 4, 5, 6, 7); (o)[3] = __builtin_shufflevector(l3_, h3_, 0, 1, 2, 3, 4, 5, 6, 7); } while (0)

constexpr int UT_P = 68;
template <bool OUT8  >
__device__ __forceinline__ void ut_tile(const Frame& F, const bf16* P, int colbase, int rowbase, int n0, int c0, bf16* UT, int ldn, LAS bf16* tl) {
    const int lane = F.lane;
#pragma unroll
    for (int i = 0; i < 8; ++i) { const int r = (lane >> 3) + 8 * i, pc = lane & 7;
        const u32x4 v = *(const u32x4*)(P + (size_t)(rowbase + n0 + r) * INW + colbase + c0 + pc * 8);
        LAS u32x2* d = (LAS u32x2*)(tl + r * UT_P + pc * 8); d[0] = (u32x2){v.x, v.y}; d[1] = (u32x2){v.z, v.w}; }
    LDS_WAIT(); asm volatile("" ::: "memory");
    const unsigned ta = tr_lane_addr(tl, UT_P, lane);
    const int fr = lane & 15, g = lane >> 4;
#pragma unroll
    for (int rb = 0; rb < 2; ++rb) {
        bf16x8 fv[4]; const unsigned a = ta + (unsigned)(32 * rb * UT_P * 2);
        TR4(fv, a, a + 32u, a + 64u, a + 96u, (unsigned)(4 * UT_P * 2));
#pragma unroll
        for (int cb = 0; cb < 4; ++cb) {
            if constexpr (OUT8) { const u32x4 w = __builtin_bit_cast(u32x4, fv[cb]);
                u32x2 o; o.x = pg8::pack_fp8x4(bflo(w.x), bfhi(w.x), bflo(w.y), bfhi(w.y)); o.y = pg8::pack_fp8x4(bflo(w.z), bfhi(w.z), bflo(w.w), bfhi(w.w));
                *(u32x2*)((unsigned char*)UT + (size_t)(c0 + 16 * cb + fr) * ldn + n0 + 32 * rb + 8 * g) = o; }
            else *(bf16x8*)(UT + (size_t)(c0 + 16 * cb + fr) * ldn + n0 + 32 * rb + 8 * g) = fv[cb]; } }
    LDS_WAIT(); asm volatile("" ::: "memory");
}
#undef PHG
#define PHG 4
__device__ __forceinline__ void phase_ut(const Frame& F_, int l) {
    Frame F = F_; asm volatile("" : "+s"(F.bid), "+s"(F.G), "+s"(F.wave)); F.lane = lane_id_(); asm volatile("" : "+v"(F.lane)); F.tid = F.wave * 64 + F.lane;
    const int gw = F.bid * NWAVES + F.wave, NGW = F.G * NWAVES;
    const bf16* P = WSP(const bf16, WS_P); LAS bf16* tl = (LAS bf16*)(F.lds + F.wave * 8704);
    const int ntl = NB * 64 * 8, ntc = (l == 0) ? NB * 4 * 8 : 0;
    for (int it = gw; it < ntl + ntc; it += NGW) {
        if (it < ntl) { const int b = it / 512, r = it % 512; ut_tile<true>(F, P, C_UB, b * NSEQ, (r / 8) * 64, (r % 8) * 64, (bf16*)(WSP(unsigned char, WS_UT) + (size_t)b * 512 * 4096), 4096, tl); }
        else { const int q = it - ntl, b = q / 32, r = q % 32; ut_tile<false>(F, P, C_UB, T_LAT + b * NCTX, (r / 8) * 64, (r % 8) * 64, WSP(bf16, WS_UTC) + (size_t)b * 512 * 256, 256, tl); }
    }
    for (int it = gw; it < ntl + NB * 4 * 8; it += NGW) {
        if (it < ntl) { const int b = it / 512, r = it % 512; ut_tile<false>(F, P, C_VA, b * NSEQ, (r / 8) * 64, (r % 8) * 64, WSP(bf16, WS_VT) + (size_t)b * 512 * 4096, 4096, tl); }
        else { const int q = it - ntl, b = q / 32, r = q % 32; ut_tile<false>(F, P, C_VA, T_LAT + b * NCTX, (r / 8) * 64, (r % 8) * 64, WSP(bf16, WS_VTC) + (size_t)b * 512 * 256, 256, tl); }
    }
}
#undef PHG
#define PHG 4
__device__ __forceinline__ void phase_nyquist(const Frame& F_) {
    Frame F = F_; asm volatile("" : "+s"(F.bid), "+s"(F.G), "+s"(F.wave)); F.lane = lane_id_(); asm volatile("" : "+v"(F.lane)); F.tid = F.wave * 64 + F.lane;
    const int gw = F.bid * NWAVES + F.wave, NGW = F.G * NWAVES, lane = F.lane;
    const unsigned char* UT = WSP(const unsigned char, WS_UT); unsigned char* FF = WSP(unsigned char, WS_FF);
    for (int it0 = gw; it0 < NB * 512; it0 += 2 * NGW) {
        u32x2 w[2][8];
#pragma unroll
        for (int u = 0; u < 2; ++u) { const int it = it0 + u * NGW; const unsigned char* row = UT + (size_t)(it < NB * 512 ? it : it0) * 4096;
#pragma unroll
            for (int k = 0; k < 8; ++k) w[u][k] = *(const u32x2*)(row + k * 512 + lane * 8); }
#pragma unroll
        for (int u = 0; u < 2; ++u) { const int it = it0 + u * NGW; const int b = it >> 9, ch = it & 511; float acc = 0.f;
#pragma unroll
            for (int k = 0; k < 8; ++k) { const f32x2 a0 = __builtin_amdgcn_cvt_pk_f32_fp8((int)w[u][k].x, false), a1 = __builtin_amdgcn_cvt_pk_f32_fp8((int)w[u][k].x, true), a2 = __builtin_amdgcn_cvt_pk_f32_fp8((int)w[u][k].y, false), a3 = __builtin_amdgcn_cvt_pk_f32_fp8((int)w[u][k].y, true);
                acc += (a0.x - a0.y) + (a1.x - a1.y) + (a2.x - a2.y) + (a3.x - a3.y); }
            acc = wave_sum(acc);
            if (lane == 0 && it < NB * 512) { FF[(size_t)(b * NSEQ + NSEQ / 2) * 1024 + ch] = (unsigned char)(pg8::pack_fp8x4(acc * (pg8::YS_SCALE / 724.0773439350247f), 0.f, 0.f, 0.f) & 0xffu); FF[(size_t)(b * NSEQ + NSEQ / 2) * 1024 + 512 + ch] = (unsigned char)0; } }
    }
}

constexpr int NA_RPB_OFF = 0, NA_CK_OFF = 2048, NA_CK_P = 80, NA_CV_OFF = NA_CK_OFF + 256 * NA_CK_P * 2, NA_CV_P = 264;
template <bool WIN, bool CLDS  >
__device__ __forceinline__ void na_chunk(const Frame& F, const char* kb  , const char* vb  , int vpitch  ,
                                         const bf16x8 (&qf)[2], int kc0, int qrow_minus_r0, int qc, float& m, float& lsum, facc (&o)[4]) {
    const int lane = F.lane, fr = lane & 15, g = lane >> 4;
    const LAS float* rpb = (const LAS float*)(F.lds + NA_RPB_OFF);
    int dci[2][4]; unsigned okm = 0u;
    if (WIN) { const int c0 = qc - 8 < 0 ? 0 : (qc - 8 > 48 ? 48 : qc - 8);
#pragma unroll
        for (int tt = 0; tt < 2; ++tt)
#pragma unroll
            for (int r = 0; r < 4; ++r) { const int kc = kc0 + 8 * g + 4 * tt + r; int dc = kc - qc; dc = dc < -15 ? -15 : (dc > 15 ? 15 : dc); dci[tt][r] = dc + 15;
                okm |= (kc >= c0 && kc < c0 + 16) ? (1u << (tt * 4 + r)) : 0u; } }
    const unsigned koff0 = (unsigned)((8 * (fr >> 2) + (fr & 3)) * INW + 8 * g) * 2u, koff1 = koff0 + 4u * INW * 2u;
    const unsigned voff = (unsigned)(fr * vpitch + 8 * g) * 2u;
    facc s[16];
    constexpr int KD = 2;
    bf16x8 kf[KD][4];
    const LAS bf16* ckl = (const LAS bf16*)(F.lds + NA_CK_OFF) + (8 * (fr >> 2) + (fr & 3)) * NA_CK_P + 8 * g;
    const LAS bf16* cvl = (const LAS bf16*)(F.lds + NA_CV_OFF) + fr * NA_CV_P + 8 * g;
#define NA_KLOAD(slot, i) do { if constexpr (CLDS) { const LAS bf16* kl_ = ckl + 32 * (i) * NA_CK_P; \
            kf[slot][0] = *(const LAS bf16x8*)kl_; kf[slot][1] = *(const LAS bf16x8*)(kl_ + 32); kf[slot][2] = *(const LAS bf16x8*)(kl_ + 4 * NA_CK_P); kf[slot][3] = *(const LAS bf16x8*)(kl_ + 4 * NA_CK_P + 32); } \
        else { const char* kp_ = WIN ? kb + (size_t)((i) * 64) * INW * 2 : kb + (size_t)(32 * (i)) * INW * 2; \
        kf[slot][0] = *(const bf16x8*)(kp_ + koff0); kf[slot][1] = *(const bf16x8*)(kp_ + koff0 + 64); kf[slot][2] = *(const bf16x8*)(kp_ + koff1); kf[slot][3] = *(const bf16x8*)(kp_ + koff1 + 64); } } while (0)
#pragma unroll
    for (int i = 0; i < KD; ++i) NA_KLOAD(i, i);
#pragma unroll
    for (int i = 0; i < 8; ++i) {
        facc a = {0.f, 0.f, 0.f, 0.f}, c = {0.f, 0.f, 0.f, 0.f};
        a = mma16(kf[i % KD][0], qf[0], a); a = mma16(kf[i % KD][1], qf[1], a); c = mma16(kf[i % KD][2], qf[0], c); c = mma16(kf[i % KD][3], qf[1], c);
        if (i + KD < 8) NA_KLOAD(i % KD, i + KD);
        if (WIN) {
            const int rb = (i - qrow_minus_r0 + 7) * 31;
#pragma unroll
            for (int r = 0; r < 4; ++r) { const float b0 = rpb[rb + dci[0][r]], b1 = rpb[rb + dci[1][r]];
                a[r] = ((okm >> r) & 1u) ? a[r] * 0.125f + b0 : -1e30f; c[r] = ((okm >> (4 + r)) & 1u) ? c[r] * 0.125f + b1 : -1e30f; }
        } else {
#pragma unroll
            for (int r = 0; r < 4; ++r) { a[r] *= 0.125f; c[r] *= 0.125f; }
        }
        s[2 * i] = a; s[2 * i + 1] = c;
        __builtin_amdgcn_sched_barrier(0);
    }
#undef NA_KLOAD
    constexpr int VD = 2;
    bf16x8 vf[VD][4];
#define NA_VLOAD(slot, i) do { if constexpr (CLDS) { _Pragma("unroll") for (int dt_ = 0; dt_ < 4; ++dt_) vf[slot][dt_] = *(const LAS bf16x8*)(cvl + 16 * dt_ * NA_CV_P + 32 * (i)); } \
        else { const char* vp_ = WIN ? vb + (size_t)((i) * 64) * 2 : vb + (size_t)(32 * (i)) * 2; \
        _Pragma("unroll") for (int dt_ = 0; dt_ < 4; ++dt_) vf[slot][dt_] = *(const bf16x8*)(vp_ + (size_t)(16 * dt_ * vpitch) * 2 + voff); } } while (0)
#pragma unroll
    for (int i = 0; i < VD; ++i) NA_VLOAD(i, i);
    float mx = -1e30f;
#pragma unroll
    for (int t = 0; t < 16; ++t) mx = fmaxf(mx, fmaxf(fmaxf(s[t][0], s[t][1]), fmaxf(s[t][2], s[t][3])));
    mx = fmaxf(mx, __shfl_xor(mx, 16)); mx = fmaxf(mx, __shfl_xor(mx, 32));
    const float mn = fmaxf(m, mx), alpha = __builtin_amdgcn_exp2f((m - mn) * LOG2E);
    m = mn; lsum *= alpha;
#pragma unroll
    for (int dt = 0; dt < 4; ++dt) o[dt] = o[dt] * alpha;
#pragma unroll
    for (int t = 0; t < 16; ++t) {
#pragma unroll
        for (int r = 0; r < 4; ++r) { const float p = __builtin_amdgcn_exp2f((s[t][r] - mn) * LOG2E); s[t][r] = p; lsum += p; }
    }
    __builtin_amdgcn_sched_barrier(0);
#pragma unroll
    for (int i = 0; i < 8; ++i) {
        const bf16x8 pb = pack8(s[2 * i], s[2 * i + 1]);
#pragma unroll
        for (int dt = 0; dt < 4; ++dt) o[dt] = mma16(vf[i % VD][dt], pb, o[dt]);
        if (i + VD < 8) NA_VLOAD(i % VD, i + VD);
        __builtin_amdgcn_sched_barrier(0);
    }
#undef NA_VLOAD
}
template <bool CTX>
__device__ __forceinline__ void na_wave(const Frame& F, const bf16* P, bf16* YNA, int b, int h, int tq  , int r0  , int kc0, int qrow_minus_r0, int qc) {
    const int lane = F.lane, g = lane >> 4;
    bf16x8 qf[2];
#pragma unroll
    for (int ks = 0; ks < 2; ++ks) qf[ks] = *(const bf16x8*)(P + (size_t)tq * INW + C_QA + h * 64 + ks * 32 + 8 * g);
    float m = -1e30f, lsum = 0.f; facc o[4];
#pragma unroll
    for (int dt = 0; dt < 4; ++dt) o[dt] = (facc){0.f, 0.f, 0.f, 0.f};
    const int ctxrow0 = T_LAT + b * NCTX;
    SUBRESET();
    if (!CTX) na_chunk<true, false>(F, (const char*)P + ((size_t)(b * NSEQ + r0 * 64 + kc0) * INW + C_KA + h * 64) * 2,
                             (const char*)(WSP(const bf16, WS_VT) + ((size_t)(b * 8 + h) * 64) * 4096 + r0 * 64 + kc0), 4096, qf, kc0, qrow_minus_r0, qc, m, lsum, o);
    SUBSTAMP(13);
    if (!CTX) na_chunk<false, true>(F, nullptr, nullptr, 256, qf, 0, 0, 0, m, lsum, o);
    else na_chunk<false, false>(F, (const char*)P + ((size_t)ctxrow0 * INW + C_KA + h * 64) * 2, (const char*)(WSP(const bf16, WS_VTC) + ((size_t)(b * 8 + h) * 64) * 256), 256, qf, 0, 0, 0, m, lsum, o);
    lsum += __shfl_xor(lsum, 16); lsum += __shfl_xor(lsum, 32);
    const float inv = pg8::YS_SCALE / lsum;
#pragma unroll
    for (int dt = 0; dt < 4; ++dt)
        *(unsigned*)((unsigned char*)YNA + (size_t)tq * 512 + h * 64 + 16 * dt + 4 * g) = pg8::pack_fp8x4(o[dt][0] * inv, o[dt][1] * inv, o[dt][2] * inv, o[dt][3] * inv);
    SUBSTAMP(14);
}
#undef PHG
#define PHG 5
__device__ __forceinline__ void phase_na(const Frame& F_, int l) {
    const bf16* P = (const bf16*)(ws_opaque(F_.ws) + WS_P); bf16* YNA = (bf16*)(ws_opaque(F_.ws) + WS_YNA);
    const int nlat = NB * 8 * 32, nctx = (l == 0) ? NB * 8 * 2 : 0;
    LAS float* rpb = (LAS float*)(F_.lds + NA_RPB_OFF);
    const int per = (nlat + F_.G - 1) / F_.G, u0 = F_.bid * per, u1 = (u0 + per < nlat) ? u0 + per : nlat;
    int bhcur = -1;
    for (int u = u0; u < u1; ++u) {
        Frame F = F_; asm volatile("" : "+s"(F.bid), "+s"(F.G), "+s"(F.wave)); F.lane = lane_id_(); asm volatile("" : "+v"(F.lane)); F.tid = F.wave * 64 + F.lane;
        const int b = u / 256, h = (u % 256) / 32, rp = u % 32;
        if (b * 8 + h != bhcur) {
            __syncthreads();
            for (int i = F.tid; i < 15 * 31; i += 512) rpb[i] = KIN(I_RPB)[((size_t)l * 8 + h) * 465 + i];
            {   int tq = F.tid; asm volatile("" : "+v"(tq));
                u32x4 kv[4];
#pragma unroll
                for (int k = 0; k < 4; ++k) { const int q = tq + 512 * k; kv[k] = *(const u32x4*)(P + (size_t)(T_LAT + b * NCTX + (q >> 3)) * INW + C_KA + h * 64 + (q & 7) * 8); }
#pragma unroll
                for (int k = 0; k < 4; ++k) { const int q = tq + 512 * k; *(LAS u32x4*)((LAS bf16*)(F.lds + NA_CK_OFF) + (q >> 3) * NA_CK_P + (q & 7) * 8) = kv[k]; } }
            {   int tq = F.tid; asm volatile("" : "+v"(tq));
                u32x4 vv[4];
#pragma unroll
                for (int k = 0; k < 4; ++k) { const int q = tq + 512 * k; vv[k] = *(const u32x4*)(WSP(const bf16, WS_VTC) + ((size_t)(b * 8 + h) * 64 + (q >> 5)) * 256 + (q & 31) * 8); }
#pragma unroll
                for (int k = 0; k < 4; ++k) { const int q = tq + 512 * k; *(LAS u32x4*)((LAS bf16*)(F.lds + NA_CV_OFF) + (q >> 5) * NA_CV_P + (q & 31) * 8) = vv[k]; } }
            __syncthreads(); bhcur = b * 8 + h;
        }
        const int qrow = 2 * rp + (F.wave >> 2), j = F.wave & 3;
        const int r0 = qrow - 4 < 0 ? 0 : (qrow - 4 > 56 ? 56 : qrow - 4);
        const int kc0 = (j == 0) ? 0 : (j == 1 ? 8 : (j == 2 ? 24 : 32));
        const int qc = 16 * j + (F.lane & 15);
        na_wave<false>(F, P, YNA, b, h, b * NSEQ + qrow * 64 + qc, r0, kc0, qrow - r0, qc);
    }
    for (int q = F_.bid; q < nctx; q += F_.G) {
        Frame F = F_; asm volatile("" : "+s"(F.bid), "+s"(F.G), "+s"(F.wave)); F.lane = lane_id_(); asm volatile("" : "+v"(F.lane)); F.tid = F.wave * 64 + F.lane;
        const int b = q / 16, h = (q % 16) / 2, qt = (q % 2) * 8 + F.wave;
        na_wave<true>(F, P, YNA, b, h, T_LAT + b * NCTX + qt * 16 + (F.lane & 15), 0, 0, 0, 0);
    }
    __syncthreads();
}

constexpr int R_KP = 136, R_VP = 264;
constexpr int R_OFF_A = 0, R_OFF_B = 128 * R_KP * 2, R_OFF_V = 2 * 128 * R_KP * 2, R_OFF_RED = R_OFF_V + 128 * R_VP * 2, R_OFF_ST = R_OFF_RED + 8192;
__device__ __forceinline__ float log_sigmoidf_(float x) { return -log1pf(__expf(-x)); }
__device__ __forceinline__ int chunk_row0(int b, int ch) { return ch < 32 ? b * NSEQ + ch * 128 : T_LAT + b * NCTX + (ch - 32) * 128; }
__device__ __forceinline__ void ret_stage_qk(const Frame& F, const bf16* P, int row0, int col0, int ch, LAS bf16* out0, LAS bf16* out1, float lg0, float lg1, int mode  , float scale) {
    const float* rc = WSP(const float, WS_ROPE); const float* rs = rc + 2048;
    u32x4 a[2], bq[2]; f32x4 cs[2][2], sn[2][2];
#pragma unroll
    for (int it = 0; it < 2; ++it) { const int i = F.tid + 512 * it, m = i >> 3, pp = i & 7, d0 = (pp & 3) * 8 + (pp >> 2) * 64;
        a[it] = *(const u32x4*)(P + (size_t)(row0 + m) * INW + col0 + d0); bq[it] = *(const u32x4*)(P + (size_t)(row0 + m) * INW + col0 + d0 + 32);
        if (ch < 32) { const int n = ch * 128 + m, pos = (pp >> 2) ? (n & 63) : (n >> 6), fi = pos * 32 + (pp & 3) * 8;
            cs[it][0] = *(const f32x4*)(rc + fi); cs[it][1] = *(const f32x4*)(rc + fi + 4); sn[it][0] = *(const f32x4*)(rs + fi); sn[it][1] = *(const f32x4*)(rs + fi + 4); } }
#pragma unroll
    for (int it = 0; it < 2; ++it) { const int i = F.tid + 512 * it, m = i >> 3, pp = i & 7, d0 = (pp & 3) * 8 + (pp >> 2) * 64;
        float x1[8], x2[8];
        x1[0] = bflo(a[it].x); x1[1] = bfhi(a[it].x); x1[2] = bflo(a[it].y); x1[3] = bfhi(a[it].y); x1[4] = bflo(a[it].z); x1[5] = bfhi(a[it].z); x1[6] = bflo(a[it].w); x1[7] = bfhi(a[it].w);
        x2[0] = bflo(bq[it].x); x2[1] = bfhi(bq[it].x); x2[2] = bflo(bq[it].y); x2[3] = bfhi(bq[it].y); x2[4] = bflo(bq[it].z); x2[5] = bfhi(bq[it].z); x2[6] = bflo(bq[it].w); x2[7] = bfhi(bq[it].w);
        if (ch < 32) {
#pragma unroll
            for (int e = 0; e < 8; ++e) { const float c = cs[it][e >> 2][e & 3], sv = sn[it][e >> 2][e & 3], y1 = x1[e] * c - x2[e] * sv, y2 = x1[e] * sv + x2[e] * c; x1[e] = y1; x2[e] = y2; }
        }
        float w0 = scale, w1 = scale;
        if (mode == 1) { w0 = __expf(lg0 * (float)(127 - m)); w1 = __expf(lg1 * (float)m); }
        {
            LAS unsigned* p1 = (LAS unsigned*)(out0 + m * R_KP + d0); LAS unsigned* p2 = (LAS unsigned*)(out0 + m * R_KP + d0 + 32);
#pragma unroll
            for (int e = 0; e < 4; ++e) { p1[e] = pk2(x1[2 * e] * w0, x1[2 * e + 1] * w0); p2[e] = pk2(x2[2 * e] * w0, x2[2 * e + 1] * w0); }
        }
        if (out1) {
            LAS unsigned* p1 = (LAS unsigned*)(out1 + m * R_KP + d0); LAS unsigned* p2 = (LAS unsigned*)(out1 + m * R_KP + d0 + 32);
#pragma unroll
            for (int e = 0; e < 4; ++e) { p1[e] = pk2(x1[2 * e] * w1, x1[2 * e + 1] * w1); p2[e] = pk2(x2[2 * e] * w1, x2[2 * e + 1] * w1); }
        }
    }
}
__device__ __forceinline__ void ret_stage_v(const Frame& F, const bf16* P, int row0, int col0) {
    LAS bf16* Vl = (LAS bf16*)(F.lds + R_OFF_V);
    u32x4 v[8];
#pragma unroll
    for (int k = 0; k < 8; ++k) { const int i = F.tid + 512 * k, m = i >> 5, pc = i & 31; v[k] = *(const u32x4*)(P + (size_t)(row0 + m) * INW + col0 + pc * 8); }
#pragma unroll
    for (int k = 0; k < 8; ++k) { const int i = F.tid + 512 * k, m = i >> 5, pc = i & 31;
        LAS unsigned* d = (LAS unsigned*)(Vl + m * R_VP + pc * 8); d[0] = v[k].x; d[1] = v[k].y; d[2] = v[k].z; d[3] = v[k].w; }
}
#undef PHG
#define PHG 6
__device__ __forceinline__ void phase_r1(const Frame& F_, int l) {
    Frame F = F_; asm volatile("" : "+s"(F.bid), "+s"(F.G), "+s"(F.wave)); F.lane = lane_id_(); asm volatile("" : "+v"(F.lane)); F.tid = F.wave * 64 + F.lane;
    const bf16* P = WSP(const bf16, WS_P); bf16* KV = WSP(bf16, WS_KV);
    const int lane = F.lane, fr0 = lane & 15, g0 = lane >> 4;
    for (int u = F.bid; u < NB * 4 * NCH; u += F.G) {
        const int b = u / (4 * NCH), h = (u / NCH) % 4, ch = u % NCH, row0 = chunk_row0(b, ch);
        const float lgf = log_sigmoidf_(KIN(I_DECF)[l * 4 + h]), lgb = log_sigmoidf_(KIN(I_DECB)[l * 4 + h]);
        int fr = fr0, g = g0; asm volatile("" : "+v"(fr), "+v"(g));
        Frame Fu = F; asm volatile("" : "+v"(Fu.tid));
        __syncthreads();
        SUBRESET();
        ret_stage_qk(Fu, P, row0, C_KR + h * 128, ch, (LAS bf16*)(F.lds + R_OFF_A), (LAS bf16*)(F.lds + R_OFF_B), lgf, lgb, 1, 1.f);
        ret_stage_v(Fu, P, row0, C_VR + h * 256);
        __syncthreads();
        SUBSTAMP(5);
        const int dir = F.wave >> 2, eq = F.wave & 3;
        const LAS bf16* Kl = (const LAS bf16*)(F.lds + (dir ? R_OFF_B : R_OFF_A)); const LAS bf16* Vl = (const LAS bf16*)(F.lds + R_OFF_V);
        facc acc[4][8];
#pragma unroll
        for (int et = 0; et < 4; ++et)
#pragma unroll
            for (int dt = 0; dt < 8; ++dt) acc[et][dt] = (facc){0.f, 0.f, 0.f, 0.f};
        const unsigned vta = tr_lane_addr(Vl + 64 * eq, R_VP, lane), kta = tr_lane_addr(Kl, R_KP, lane);
#pragma unroll 1
        for (int ks = 0; ks < 4; ++ks) {
            bf16x8 va[4], kb0[4], kb1[4];
            const unsigned vk = vta + (unsigned)(32 * ks * R_VP * 2), kk = kta + (unsigned)(32 * ks * R_KP * 2);
            TR4(va, vk, vk + 32u, vk + 64u, vk + 96u, (unsigned)(4 * R_VP * 2));
            TR4(kb0, kk, kk + 32u, kk + 64u, kk + 96u, (unsigned)(4 * R_KP * 2));
            TR4(kb1, kk + 128u, kk + 160u, kk + 192u, kk + 224u, (unsigned)(4 * R_KP * 2));
#pragma unroll
            for (int dt = 0; dt < 8; ++dt) {
#pragma unroll
                for (int et = 0; et < 4; ++et) acc[et][dt] = mma16(dt < 4 ? kb0[dt & 3] : kb1[dt & 3], va[et], acc[et][dt]);
            }
        }
        SUBSTAMP(6);
        bf16* out = KV + ((((size_t)(b * 4 + h) * NCH + ch) * 2 + dir) << 15);
#pragma unroll
        for (int et = 0; et < 4; ++et)
#pragma unroll
            for (int dt = 0; dt < 8; ++dt) { u32x2 w; w.x = pk2(acc[et][dt][0], acc[et][dt][1]); w.y = pk2(acc[et][dt][2], acc[et][dt][3]);
                *(u32x2*)(out + (size_t)(64 * eq + 16 * et + fr) * 128 + 16 * dt + 4 * g) = w; }
        SUBSTAMP(7);
    }
    __syncthreads();
}
#undef PHG
#define PHG 7
__device__ __forceinline__ void phase_r2(const Frame& F_, int l) {
    Frame F = F_; asm volatile("" : "+s"(F.bid), "+s"(F.G), "+s"(F.wave)); F.lane = lane_id_(); asm volatile("" : "+v"(F.lane)); F.tid = F.wave * 64 + F.lane;
    const bf16* KV = WSP(const bf16, WS_KV); bf16* SP = WSP(bf16, WS_SPREV);
    for (int id = F.bid * 512 + F.tid; id < 64 * 4096; id += F.G * 512) {
        const int comb = id >> 12, el = (id & 4095) * 8, bh = comb >> 1, dir = comb & 1, h = bh & 3;
        const float lg = log_sigmoidf_(dir ? KIN(I_DECB)[l * 4 + h] : KIN(I_DECF)[l * 4 + h]), gC = __expf(lg * 128.f);
        float S[8];
#pragma unroll
        for (int j = 0; j < 8; ++j) S[j] = 0.f;
#pragma unroll 1
        for (int s0 = 0; s0 < NCH; s0 += 8) {
            u32x4 kv[8];
#pragma unroll
            for (int q = 0; q < 8; ++q) { const int s = s0 + q;
                if (s < NCH) { const int ch = dir == 0 ? (s < 2 ? 32 + s : s - 2) : (s < 2 ? 33 - s : 33 - s);
                    kv[q] = *(const u32x4*)(KV + ((((size_t)bh * NCH + ch) * 2 + dir) << 15) + el); } }
#pragma unroll
            for (int q = 0; q < 8; ++q) { const int s = s0 + q;
                if (s < NCH) { const int ch = dir == 0 ? (s < 2 ? 32 + s : s - 2) : (s < 2 ? 33 - s : 33 - s);
                    u32x4 w; w.x = pk2(S[0], S[1]); w.y = pk2(S[2], S[3]); w.z = pk2(S[4], S[5]); w.w = pk2(S[6], S[7]);
                    *(u32x4*)(SP + ((((size_t)bh * NCH + ch) * 2 + dir) << 15) + el) = w;
                    S[0] = gC * S[0] + bflo(kv[q].x); S[1] = gC * S[1] + bfhi(kv[q].x); S[2] = gC * S[2] + bflo(kv[q].y); S[3] = gC * S[3] + bfhi(kv[q].y);
                    S[4] = gC * S[4] + bflo(kv[q].z); S[5] = gC * S[5] + bfhi(kv[q].z); S[6] = gC * S[6] + bflo(kv[q].w); S[7] = gC * S[7] + bfhi(kv[q].w); } }
        }
    }
}
#undef PHG
#define PHG 8
__device__ __forceinline__ void phase_r3(const Frame& F_, int l) {
    Frame F = F_; asm volatile("" : "+s"(F.bid), "+s"(F.G), "+s"(F.wave)); F.lane = lane_id_(); asm volatile("" : "+v"(F.lane)); F.tid = F.wave * 64 + F.lane;
    const bf16* P = WSP(const bf16, WS_P); const bf16* SP = WSP(const bf16, WS_SPREV); bf16* YR = WSP(bf16, WS_YRET);
    const int lane = F.lane, fr0 = lane & 15, g0 = lane >> 4, w = F.wave;
    const int nch = (l == 0) ? NCH : 32;
    LAS bf16* Ql = (LAS bf16*)(F.lds + R_OFF_A); LAS bf16* Kl = (LAS bf16*)(F.lds + R_OFF_B); const LAS bf16* Vl = (const LAS bf16*)(F.lds + R_OFF_V);
    LAS float* red = (LAS float*)(F.lds + R_OFF_RED); LAS float* stt = (LAS float*)(F.lds + R_OFF_ST);
    for (int u = F.bid; u < NB * 4 * nch; u += F.G) {
        const int b = u / (4 * nch), h = (u / nch) % 4, ch = u % nch, row0 = chunk_row0(b, ch);
        const float lgf = log_sigmoidf_(KIN(I_DECF)[l * 4 + h]), lgb = log_sigmoidf_(KIN(I_DECB)[l * 4 + h]);
        int fr = fr0, g = g0; asm volatile("" : "+v"(fr), "+v"(g));
        Frame Fu = F; asm volatile("" : "+v"(Fu.tid));
        __syncthreads();
        SUBRESET();
        ret_stage_qk(Fu, P, row0, C_QR + h * 128, ch, Ql, nullptr, 0.f, 0.f, 0, 0.08838834764831845f);
        ret_stage_qk(Fu, P, row0, C_KR + h * 128, ch, Kl, nullptr, 0.f, 0.f, 0, 1.f);
        ret_stage_v(Fu, P, row0, C_VR + h * 256);
        __syncthreads();
        SUBSTAMP(0);
        facc st[8];
#pragma unroll
        for (int mt = 0; mt < 8; ++mt) st[mt] = (facc){0.f, 0.f, 0.f, 0.f};
#pragma unroll
        for (int ks = 0; ks < 4; ++ks) {
            const bf16x8 qb = *(const LAS bf16x8*)(Ql + (16 * w + fr) * R_KP + 32 * ks + 8 * g);
#pragma unroll
            for (int mt = 0; mt < 8; ++mt) { const bf16x8 ka = *(const LAS bf16x8*)(Kl + (16 * mt + fr) * R_KP + 32 * ks + 8 * g); st[mt] = mma16(ka, qb, st[mt]); }
        }
        __syncthreads();
        {
            const int c = 16 * w + fr;
#pragma unroll
            for (int mt = 0; mt < 8; ++mt) { float v[4];
#pragma unroll
                for (int r = 0; r < 4; ++r) { const int m = 16 * mt + 4 * g + r; const float dcy = (c >= m) ? __expf(lgf * (float)(c - m)) : __expf(lgb * (float)(m - c)); v[r] = st[mt][r] * dcy; }
                u32x2 pw; pw.x = pk2(v[0], v[1]); pw.y = pk2(v[2], v[3]);
                *(LAS u32x2*)(Kl + c * R_KP + 16 * mt + 4 * g) = pw; }
        }
        __syncthreads();
        SUBSTAMP(1);
        facc acc[2][8];
#pragma unroll
        for (int et = 0; et < 2; ++et)
#pragma unroll
            for (int ct = 0; ct < 8; ++ct) acc[et][ct] = (facc){0.f, 0.f, 0.f, 0.f};
#pragma unroll 1
        for (int ks = 0; ks < 4; ++ks) {
            bf16x8 va[4];
            { const unsigned a = tr_lane_addr(Vl + 32 * w, R_VP, lane) + (unsigned)(32 * ks * R_VP * 2); TR4(va, a, a + 32u, a, a + 32u, (unsigned)(4 * R_VP * 2)); }
#pragma unroll
            for (int ct = 0; ct < 8; ++ct) { const bf16x8 pb = *(const LAS bf16x8*)(Kl + (16 * ct + fr) * R_KP + 32 * ks + 8 * g);
#pragma unroll
                for (int et = 0; et < 2; ++et) acc[et][ct] = mma16(va[et], pb, acc[et][ct]); }
            __builtin_amdgcn_sched_barrier(0);
        }
        SUBSTAMP(2);
        {
            const bf16* sp0 = SP + ((((size_t)(b * 4 + h) * NCH + ch) * 2 + 0) << 15); const bf16* sp1 = sp0 + 32768;
#pragma unroll
            for (int dir = 0; dir < 2; ++dir) {
                const bf16* sp = dir == 0 ? sp0 : sp1; bf16x8 sa[4][2];
#pragma unroll
                for (int ks = 0; ks < 4; ++ks)
#pragma unroll
                    for (int et = 0; et < 2; ++et) sa[ks][et] = *(const bf16x8*)(sp + (size_t)(32 * w + 16 * et + fr) * 128 + 32 * ks + 8 * g);
#pragma unroll
                for (int hf = 0; hf < 2; ++hf) {
                    facc X[2][4];
#pragma unroll
                    for (int et = 0; et < 2; ++et)
#pragma unroll
                        for (int cq = 0; cq < 4; ++cq) X[et][cq] = (facc){0.f, 0.f, 0.f, 0.f};
#pragma unroll
                    for (int ks = 0; ks < 4; ++ks) {
#pragma unroll
                        for (int cq = 0; cq < 4; ++cq) { const int ct = 4 * hf + cq; const bf16x8 qb = *(const LAS bf16x8*)(Ql + (16 * ct + fr) * R_KP + 32 * ks + 8 * g);
#pragma unroll
                            for (int et = 0; et < 2; ++et) X[et][cq] = mma16(sa[ks][et], qb, X[et][cq]); }
                        __builtin_amdgcn_sched_barrier(0);
                    }
#pragma unroll
                    for (int cq = 0; cq < 4; ++cq) { const int ct = 4 * hf + cq, c = 16 * ct + fr; const float dq = dir == 0 ? __expf(lgf * (float)(c + 1)) : __expf(lgb * (float)(128 - c));
#pragma unroll
                        for (int et = 0; et < 2; ++et) acc[et][ct] += X[et][cq] * dq; }
                }
            }
        }
        SUBSTAMP(3);
        unsigned gtv[2][8];
        { const unsigned char* GR8 = WSP(const unsigned char, WS_GR8);
#pragma unroll
        for (int et = 0; et < 2; ++et)
#pragma unroll
            for (int ct = 0; ct < 8; ++ct) gtv[et][ct] = *(const unsigned*)(GR8 + (size_t)(row0 + 16 * ct + fr) * 1024 + h * 256 + 32 * w + 16 * et + 4 * g); }
#pragma unroll
        for (int ct = 0; ct < 8; ++ct) { float s = 0.f, ss = 0.f;
#pragma unroll
            for (int et = 0; et < 2; ++et)
#pragma unroll
                for (int r = 0; r < 4; ++r) { const float v = acc[et][ct][r]; s += v; ss += v * v; }
            s += __shfl_xor(s, 16); s += __shfl_xor(s, 32); ss += __shfl_xor(ss, 16); ss += __shfl_xor(ss, 32);
            if (g == 0) { red[(w * 128 + 16 * ct + fr) * 2] = s; red[(w * 128 + 16 * ct + fr) * 2 + 1] = ss; } }
        __syncthreads();
        if (F.tid < 128) { float s = 0.f, ss = 0.f;
#pragma unroll
            for (int q = 0; q < 8; ++q) { s += red[(q * 128 + F.tid) * 2]; ss += red[(q * 128 + F.tid) * 2 + 1]; }
            const float mean = s * (1.f / 256.f), var = fmaxf(ss * (1.f / 256.f) - mean * mean, 0.f);
            stt[F.tid * 2] = mean; stt[F.tid * 2 + 1] = 1.f / sqrtf(var + GN_EPS); }
        __syncthreads();
        const float* gnw = KIN(I_GNW) + (size_t)l * 1024 + h * 256;
#pragma unroll
        for (int et = 0; et < 2; ++et) { const int e = 32 * w + 16 * et + 4 * g; const f32x4 gw4 = *(const f32x4*)(gnw + e);
#pragma unroll
            for (int ct = 0; ct < 8; ++ct) { const int c = 16 * ct + fr; const float mean = stt[c * 2], rstd = stt[c * 2 + 1];
                const size_t tok = (size_t)(row0 + c);
                const f32x2 ga_ = __builtin_amdgcn_cvt_pk_f32_fp8((int)gtv[et][ct], false), gb_ = __builtin_amdgcn_cvt_pk_f32_fp8((int)gtv[et][ct], true);
                const float g0 = ga_.x * pg8::YS_INV, g1 = ga_.y * pg8::YS_INV, g2 = gb_.x * pg8::YS_INV, g3 = gb_.y * pg8::YS_INV;
                const float y0 = (acc[et][ct][0] - mean) * rstd * gw4[0] * siluf_(g0), y1 = (acc[et][ct][1] - mean) * rstd * gw4[1] * siluf_(g1);
                const float y2 = (acc[et][ct][2] - mean) * rstd * gw4[2] * siluf_(g2), y3 = (acc[et][ct][3] - mean) * rstd * gw4[3] * siluf_(g3);
                *(unsigned*)((unsigned char*)YR + tok * 1024 + h * 256 + e) = pg8::pack_fp8x4(y0 * pg8::YS_SCALE, y1 * pg8::YS_SCALE, y2 * pg8::YS_SCALE, y3 * pg8::YS_SCALE); } }
        SUBSTAMP(4);
    }
    __syncthreads();
}
__device__ __forceinline__ float wave_max_dpp(float v) {
#define DPPF(x, ctrl) __builtin_bit_cast(float, __builtin_amdgcn_update_dpp(0, __builtin_bit_cast(int, (x)), (ctrl), 0xF, 0xF, true))
    v = fmaxf(v, DPPF(v, 0xB1)); v = fmaxf(v, DPPF(v, 0x4E)); v = fmaxf(v, DPPF(v, 0x141)); v = fmaxf(v, DPPF(v, 0x140));
#undef DPPF
    const int x = __builtin_bit_cast(int, v);
    const float r0 = __builtin_bit_cast(float, __builtin_amdgcn_readlane(x, 0)), r1 = __builtin_bit_cast(float, __builtin_amdgcn_readlane(x, 16));
    const float r2 = __builtin_bit_cast(float, __builtin_amdgcn_readlane(x, 32)), r3 = __builtin_bit_cast(float, __builtin_amdgcn_readlane(x, 48));
    return fmaxf(fmaxf(r0, r1), fmaxf(r2, r3));
}
#undef PHG
#define PHG 9
__device__ __forceinline__ void phase_topk(const Frame& F_, int l, int Tm) {
    Frame F = F_; asm volatile("" : "+s"(F.bid), "+s"(F.G), "+s"(F.wave)); F.lane = lane_id_(); asm volatile("" : "+v"(F.lane)); F.tid = F.wave * 64 + F.lane;
    const int lane = F.lane;
    const float* LG = WSP(const float, WS_LOGIT); int* TE = WSP(int, WS_TOPE); float* TW = WSP(float, WS_TOPW); int* TP = WSP(int, WS_TPOS);
    unsigned* cnt = WSP(unsigned, WS_CTL) + CW_CNT + l * 256;
    LAS unsigned* hist = (LAS unsigned*)F.lds;
    if (F.tid < 512) hist[F.tid] = 0u;
    __syncthreads();
    const int per = (Tm + F.G - 1) / F.G, t0 = F.bid * per, t1 = (t0 + per < Tm) ? t0 + per : Tm;
    const f32x4 bias = *(const f32x4*)(KIN(I_ROUTB) + (size_t)l * 256 + 4 * lane);
    const float NEG = -__builtin_inff();
    for (int tb = t0 + F.wave; tb < t1; tb += 2 * NWAVES) {
        int tt[2]; bool ok[2]; f32x4 lg[2];
#pragma unroll
        for (int u = 0; u < 2; ++u) { tt[u] = tb + u * NWAVES; ok[u] = tt[u] < t1; lg[u] = *(const f32x4*)(LG + (size_t)(ok[u] ? tt[u] : tb) * 256 + 4 * lane); }
        float sc[2][4], v[2][4]; int my_e[2]; float my_w[2], wsum[2];
#pragma unroll
        for (int u = 0; u < 2; ++u) {
#pragma unroll
            for (int i = 0; i < 4; ++i) { sc[u][i] = sigmoidf_(lg[u][i]); v[u][i] = sc[u][i] + bias[i]; }
            float m1 = fmaxf(fmaxf(v[u][0], v[u][1]), fmaxf(v[u][2], v[u][3]));
            float m2;
            { const float a = fmaxf(v[u][0], v[u][1]), b = fminf(v[u][0], v[u][1]), c = fmaxf(v[u][2], v[u][3]), d = fminf(v[u][2], v[u][3]); m2 = fmaxf(fminf(a, c), fmaxf(b, d)); }
#pragma unroll
            for (int o = 1; o < 8; o <<= 1) { const float b1 = __shfl_xor(m1, o), b2 = __shfl_xor(m2, o); const float n1 = fmaxf(m1, b1), n2 = fmaxf(fminf(m1, b1), fmaxf(m2, b2)); m1 = n1; m2 = n2; }
            const float gs = m1 + m2; const int grp = lane >> 3; int rank = 0;
#pragma unroll
            for (int j = 0; j < 8; ++j) { const float o = __shfl(gs, j * 8); rank += (o > gs || (o == gs && j < grp)) ? 1 : 0; }
            if (rank >= 4) { v[u][0] = NEG; v[u][1] = NEG; v[u][2] = NEG; v[u][3] = NEG; }
            my_e[u] = 0; my_w[u] = 0.f; wsum[u] = 0.f;
        }
#pragma unroll 1
        for (int k = 0; k < 8; ++k) {
#pragma unroll
            for (int u = 0; u < 2; ++u) {
                float bv = v[u][0]; int bl = 0;
#pragma unroll
                for (int i = 1; i < 4; ++i) if (v[u][i] > bv) { bv = v[u][i]; bl = i; }
                const float wm = wave_max_dpp(bv);
                const unsigned long long hit = __ballot(bv == wm);
                const int own = (int)__builtin_ctzll(hit);
                const int sub = __builtin_amdgcn_readlane(bl, own), bi = own * 4 + sub;
                const float mysc = sub == 0 ? sc[u][0] : (sub == 1 ? sc[u][1] : (sub == 2 ? sc[u][2] : sc[u][3]));
                const float wv = __builtin_bit_cast(float, __builtin_amdgcn_readlane(__builtin_bit_cast(int, mysc), own));
#pragma unroll
                for (int i = 0; i < 4; ++i) v[u][i] = (lane == own && sub == i) ? NEG : v[u][i];
                wsum[u] += wv; if (lane == k) { my_e[u] = bi; my_w[u] = wv; }
            }
        }
#pragma unroll
        for (int u = 0; u < 2; ++u)
            if (ok[u] && lane < 8) {
                TE[(size_t)tt[u] * 8 + lane] = my_e[u]; TW[(size_t)tt[u] * 8 + lane] = my_w[u] / wsum[u] * 2.5f;
                TP[(size_t)tt[u] * 8 + lane] = (int)__hip_atomic_fetch_add(&hist[my_e[u]], 1u, __ATOMIC_RELAXED, __HIP_MEMORY_SCOPE_WORKGROUP);
            }
    }
    __syncthreads();
    if (F.tid < 256) { const unsigned c = hist[F.tid]; hist[256 + F.tid] = c ? __hip_atomic_fetch_add(&cnt[F.tid], c, __ATOMIC_RELAXED, __HIP_MEMORY_SCOPE_AGENT) : 0u; }
    asm volatile("s_waitcnt vmcnt(0)" ::: "memory");
    __syncthreads();
    for (int q = t0 * 8 + F.tid; q < t1 * 8; q += 512) TP[q] += (int)hist[256 + TE[q]];
    __syncthreads();
}
#undef PHG
#define PHG 9
__device__ __forceinline__ void phase_slots(const Frame& F_, int l, int Tm) {
    Frame F = F_; asm volatile("" : "+s"(F.bid), "+s"(F.G), "+s"(F.wave)); F.lane = lane_id_(); asm volatile("" : "+v"(F.lane)); F.tid = F.wave * 64 + F.lane;
    const int gw = F.bid * NWAVES + F.wave, NGW = F.G * NWAVES, lane = F.lane;
    LAS int* tst = (LAS int*)F.lds; LAS int* cn = tst + 260;
    const unsigned* cnt = WSP(const unsigned, WS_CTL) + CW_CNT + l * 256;
    if (F.tid < 256) cn[F.tid] = (int)__hip_atomic_load(&cnt[F.tid], __ATOMIC_RELAXED, __HIP_MEMORY_SCOPE_AGENT);
    __syncthreads();
    if (F.tid == 0) { int s = 0; for (int e = 0; e < 256; ++e) { tst[e] = s; s += (cn[e] + 255) >> 8; } tst[256] = s; }
    __syncthreads();
    const int NT = tst[256];
    int* meta = WSP(int, WS_META); int* tile_e = meta + 64;
    int* ST = WSP(int, WS_STOK); float* SW = WSP(float, WS_SW);
    const int* TE = WSP(const int, WS_TOPE); const float* TW = WSP(const float, WS_TOPW); const int* TP = WSP(const int, WS_TPOS); int* TS = WSP(int, WS_TSLOT);
    if (F.bid == 0) {
        if (F.tid == 0) { meta[0] = NT; meta[1] = NT + Tm / 256; }
        if (F.tid < 256) { const int e = F.tid, n = (cn[e] + 255) >> 8; for (int j = 0; j < n; ++j) tile_e[tst[e] + j] = e; }
        for (int i = F.tid; i < Tm / 256; i += 512) tile_e[NT + i] = 256;
    }
    for (int t = gw; t < Tm; t += NGW) {
        if (lane < 8) { const int e = TE[(size_t)t * 8 + lane], slot = tst[e] * 256 + TP[(size_t)t * 8 + lane];
            ST[slot] = t; SW[slot] = TW[(size_t)t * 8 + lane]; TS[(size_t)t * 8 + lane] = slot; }
    }
#pragma unroll 1
    for (int e = gw; e < 256; e += NGW) { const int c = cn[e], n = (c + 255) >> 8;
#pragma unroll 1
        for (int s = c + lane; s < n * 256; s += 64) { ST[tst[e] * 256 + s] = 0; SW[tst[e] * 256 + s] = 0.f; } }
    int gstep = F.G * 512; asm volatile("" : "+s"(gstep));
#pragma unroll 1
    for (int t = F.bid * 512 + F.tid; t < Tm; t += gstep) { ST[NT * 256 + t] = t; SW[NT * 256 + t] = 1.f; }
    __syncthreads();
}
#undef PHG
#define PHG 9
__device__ __forceinline__ void moe_units_setup(const Frame& F_, int npn, const int* rowsrc  ) {
    Frame F = F_; asm volatile("" : "+s"(F.bid), "+s"(F.G), "+s"(F.wave)); F.lane = lane_id_(); asm volatile("" : "+v"(F.lane)); F.tid = F.wave * 64 + F.lane;
    int G_ = F.G; asm volatile("" : "+s"(G_)); F.G = G_;
    const int* meta = WSP(const int, WS_META); const int* tile_e = meta + 64;
    LAS int* ut = (LAS int*)(F.lds + pg8::XT_UT); LAS int* xi = (LAS int*)(F.lds + pg8::XT_XI);
    const int nun = meta[1] * npn;
    __syncthreads();
    const int cperm = (F.G % 8 == 0) ? (F.bid & 7) * (F.G >> 3) + (F.bid >> 3) : F.bid;
#ifdef DOWN_WGMAJOR
#define MOE_L(i) ((npn == 4) ? (((i) >> 2) * F.G + cperm) * 4 + ((i) & 3) : (i) * F.G + cperm)
#else
#define MOE_L(i) ((i) * F.G + cperm)
#endif
    if (F.tid < pg8::XT_MAXU) { const int L = MOE_L(F.tid), ok = L < nun, tile = ok ? L / npn : 0;
        ut[F.tid * 4] = tile; ut[F.tid * 4 + 1] = ok ? L % npn : 0; ut[F.tid * 4 + 2] = ok ? tile_e[tile] : 0; ut[F.tid * 4 + 3] = ok; }
    for (int q = F.tid; q < pg8::XT_MAXU * 256; q += 512) { const int i = q >> 8, r = q & 255, L = MOE_L(i);
        if (L < nun) xi[q] = rowsrc[(L / npn) * 256 + r]; }
    __syncthreads();
}
#undef PHG
#define PHG 10
__device__ __forceinline__ void combine_token(const Frame& F, int l, int t, const u32x2 (&R_)[2][9], const u32x4 (&XW_)[2], const float* lw, const float* lb, bf16* X, bf16* H) {
    const int lane = F.lane;
    const float* mv = mod_vec(F, l, t);
    float v[16]; float s = 0.f;
#pragma unroll
    for (int j = 0; j < 2; ++j) { const int col = j * 512 + lane * 8; float f[8];
#pragma unroll
        for (int q = 0; q < 8; ++q) f[q] = 0.f;
#pragma unroll
        for (int k = 0; k < 9; ++k) { const u32x2 w = R_[j][k];
            const f32x2 a = __builtin_amdgcn_cvt_pk_f32_fp8((int)w.x, false), b = __builtin_amdgcn_cvt_pk_f32_fp8((int)w.x, true), c = __builtin_amdgcn_cvt_pk_f32_fp8((int)w.y, false), d = __builtin_amdgcn_cvt_pk_f32_fp8((int)w.y, true);
            f[0] += a.x; f[1] += a.y; f[2] += b.x; f[3] += b.y; f[4] += c.x; f[5] += c.y; f[6] += d.x; f[7] += d.y; }
#pragma unroll
        for (int q = 0; q < 8; ++q) f[q] *= pg8::YS_INV;
        const u32x4 xw = XW_[j];
        const f32x4 xa = {bflo(xw.x), bfhi(xw.x), bflo(xw.y), bfhi(xw.y)}, xb = {bflo(xw.z), bfhi(xw.z), bflo(xw.w), bfhi(xw.w)};
        const f32x4 ga = *(const f32x4*)(mv + 5120 + col), gb = *(const f32x4*)(mv + 5120 + col + 4);
#pragma unroll
        for (int q = 0; q < 4; ++q) { v[j * 8 + q] = DN_ALPHA * xa[q] + ga[q] * f[q]; v[j * 8 + 4 + q] = DN_ALPHA * xb[q] + gb[q] * f[4 + q]; }
#pragma unroll
        for (int q = 0; q < 8; ++q) s += v[j * 8 + q]; }
    float mean = wave_sum(s) * (1.f / D), s2 = 0.f;
#pragma unroll
    for (int q = 0; q < 16; ++q) { v[q] -= mean; s2 += v[q] * v[q]; }
    float rstd = 1.f / sqrtf(wave_sum(s2) * (1.f / D) + LN_EPS);
    s = 0.f;
#pragma unroll
    for (int j = 0; j < 2; ++j) { const int col = j * 512 + lane * 8;
        const f32x4 wa = *(const f32x4*)(lw + col), wb = *(const f32x4*)(lw + col + 4), ba = *(const f32x4*)(lb + col), bb = *(const f32x4*)(lb + col + 4);
#pragma unroll
        for (int q = 0; q < 4; ++q) { v[j * 8 + q] = v[j * 8 + q] * rstd * wa[q] + ba[q]; v[j * 8 + 4 + q] = v[j * 8 + 4 + q] * rstd * wb[q] + bb[q]; }
        if (l == 1) { float* dst = (float*)karg(27) + (size_t)t * D + col;
            *(f32x4*)dst = (f32x4){v[j * 8], v[j * 8 + 1], v[j * 8 + 2], v[j * 8 + 3]}; *(f32x4*)(dst + 4) = (f32x4){v[j * 8 + 4], v[j * 8 + 5], v[j * 8 + 6], v[j * 8 + 7]}; }
        else { u32x4 w; w.x = pk2(v[j * 8], v[j * 8 + 1]); w.y = pk2(v[j * 8 + 2], v[j * 8 + 3]); w.z = pk2(v[j * 8 + 4], v[j * 8 + 5]); w.w = pk2(v[j * 8 + 6], v[j * 8 + 7]); *(u32x4*)(X + (size_t)t * D + col) = w; }
#pragma unroll
        for (int q = 0; q < 8; ++q) s += v[j * 8 + q]; }
    if (l == 0) {
        mean = wave_sum(s) * (1.f / D); s2 = 0.f;
#pragma unroll
        for (int q = 0; q < 16; ++q) { v[q] -= mean; s2 += v[q] * v[q]; }
        rstd = 1.f / sqrtf(wave_sum(s2) * (1.f / D) + LN_EPS);
        const float* m1 = mod_vec(F, 1, t);
#pragma unroll
        for (int j = 0; j < 2; ++j) { const int col = j * 512 + lane * 8;
            const f32x4 sa = *(const f32x4*)(m1 + 1024 + col), sb = *(const f32x4*)(m1 + 1024 + col + 4), ha = *(const f32x4*)(m1 + col), hb = *(const f32x4*)(m1 + col + 4);
            float o[8];
#pragma unroll
            for (int q = 0; q < 4; ++q) { o[q] = v[j * 8 + q] * rstd * (1.f + sa[q]) + ha[q]; o[4 + q] = v[j * 8 + 4 + q] * rstd * (1.f + sb[q]) + hb[q]; }
            u32x2 w; w.x = pg8::pack_fp8x4(o[0], o[1], o[2], o[3]); w.y = pg8::pack_fp8x4(o[4], o[5], o[6], o[7]);
            *(u32x2*)((unsigned char*)H + (size_t)t * D + col) = w; }
    }
}
#undef PHG
#define PHG 10
__device__ __forceinline__ void phase_combine(const Frame& F_, int l, int Tm) {
    Frame F = F_; asm volatile("" : "+s"(F.bid), "+s"(F.G), "+s"(F.wave)); F.lane = lane_id_(); asm volatile("" : "+v"(F.lane)); F.tid = F.wave * 64 + F.lane;
    const int gw = F.bid * NWAVES + F.wave, NGW = F.G * NWAVES, lane = F.lane;
    const int* meta = WSP(const int, WS_META); const int NT = meta[0];
    const int* TS = WSP(const int, WS_TSLOT); const unsigned char* YS = WSP(const unsigned char, WS_YSLOT); bf16* X = WSP(bf16, WS_X); bf16* H = (bf16*)WSP(unsigned char, WS_H8);
    const float* lw = KIN(I_LNFW) + (size_t)l * D; const float* lb = KIN(I_LNFB) + (size_t)l * D;
#define CB_SLOT(t_) ((lane < 8 && (t_) < Tm) ? TS[(size_t)(t_) * 8 + lane] : 0)
#define CB_LOAD(R_, XW_, sl_, t_) do { int slots_[9]; _Pragma("unroll") for (int k = 0; k < 8; ++k) slots_[k] = __shfl(sl_, k); slots_[8] = NT * 256 + (t_); \
        _Pragma("unroll") for (int j = 0; j < 2; ++j) { const int col = j * 512 + lane * 8; \
            _Pragma("unroll") for (int k = 0; k < 9; ++k) R_[j][k] = *(const u32x2*)(YS + (size_t)slots_[k] * 1024 + col); \
            XW_[j] = *(const u32x4*)(X + (size_t)(t_) * D + col); } } while (0)
    u32x2 ra[2][9]; u32x4 xa_[2];
    int sl = CB_SLOT(gw);
#pragma unroll 1
    for (int t = gw; t < Tm; t += NGW) {
        const int sln = CB_SLOT(t + NGW);
        CB_LOAD(ra, xa_, sl, t);
        combine_token(F, l, t, ra, xa_, lw, lb, X, H);
        sl = sln;
    }
#undef CB_SLOT
#undef CB_LOAD
}
#ifndef MK_PER_PHASE
#define MK_PER_PHASE 0
#endif
#ifndef TSAMP
#define TSAMP 8ull
#endif
#ifndef NPREP
#define NPREP 0
#endif
#ifndef ALIGN_BIG
#define ALIGN_BIG true
#endif
#ifndef SKEW_BIG
#define SKEW_BIG 0
#endif
#ifndef SKEW_DOWN
#define SKEW_DOWN 0
#endif
constexpr int NPL = 15, NPHASE = 1 + 2 * NPL;
#undef PHG
#define PHG 0
struct Args { const float* in[27]; float* out; unsigned char* ws; int ph_lo, ph_hi; };
static_assert(sizeof(Args) == 29 * 8 + 8, "Args has no padding");

__global__ void __launch_bounds__(NWAVES * 64, 2) mk_fwd(Args args) {
    extern __shared__ __attribute__((aligned(16))) unsigned char lds_raw[];
    Frame F;
    F.lds = (LAS unsigned char*)lds_raw;
    F.wave = __builtin_amdgcn_readfirstlane((int)threadIdx.x >> 6); F.lane = lane_id_(); F.tid = F.wave * 64 + F.lane; F.G = gridDim.x; F.bid = blockIdx.x;
    F.ws = args.ws;
    volatile LAS unsigned* MISC = (volatile LAS unsigned*)(F.lds + MISC_OFF);
    { const int t_ = F.wave * 64 + lane_id_(); if (t_ < 128) MISC[t_] = 0u; }
    __syncthreads();
    unsigned* ctl = (unsigned*)(F.ws + WS_CTL);
    if (!MK_PER_PHASE) (void)xcd_barrier_post(ctl + CW_BAR, MISC, F.wave);
#ifndef PHMASK
#define PHMASK 0xFFFFFFFFu
#endif
#define PHON(k) ((PHMASK >> ((k) == 0 ? 0 : (((k) - 1) % NPL) + 1)) & 1u)
#define IN(k) (PHON(k) && karg_int(29 * 8) <= (k) && (k) < karg_int(29 * 8 + 4))
#ifndef DUPMASK
#define DUPMASK 0u
#endif
#define REPS(k) (((DUPMASK >> ((k) == 0 ? 0 : (((k) - 1) % NPL) + 1)) & 1u) ? 2 : 1)
#ifdef TSMASK
#define STAMP(i) do { if (F.bid == 0 && F.wave == 0 && lane_id_() == 0) ((volatile LAS unsigned long long*)(F.lds + MISC_OFF + 16))[i] = wall_clock64(); } while (0)
#else
#define STAMP(i) do { } while (0)
#endif
#define SEAM(k) do { if (IN(k) && IN((k) + 1)) { XcdBarrier b_; unsigned long long bp_ = (unsigned long long)(F.ws + WS_CTL) + CW_BAR * 4; asm volatile("" : "+s"(bp_));   \
        b_.bar = ((GMASK >> 11) & 1u) ? (unsigned*)(__attribute__((address_space(1))) unsigned*)bp_ : (unsigned*)bp_; b_.x = xb_xcc_id(); b_.st = (volatile LAS unsigned*)(F.lds + MISC_OFF); xcd_barrier(b_, F.wave); } STAMP((k) + 1); } while (0)
    LAS unsigned char* ring = F.lds;
    STAMP(0);

    if (IN(0)) _Pragma("unroll") for (int rep_ = 0; rep_ < REPS(0); ++rep_) { phase_init(F); } SEAM(0);

#pragma unroll 1
    for (int l = 0; l < 2; ++l) {
        const int pb = 1 + l * NPL;
        const int Mrows = (l == 0) ? T_ALL : T_LAT;
        unsigned char* wne = ws_opaque(F.ws) + WS_WNE + (size_t)l * WNE_STRIDE;
        if (IN(pb + 0)) { if (l == 0) phase_h0(F); } if (l == 0) SEAM(pb + 0); else STAMP(pb + 1);
        if (IN(pb + 1)) _Pragma("unroll") for (int rep_ = 0; rep_ < REPS(pb + 1); ++rep_) {
            const int ng = (NPREP > 0 && F.G > 4 * NPREP) ? F.G - NPREP : F.G;
            if (F.bid < ng) {
                pg8::ProbDense S{nullptr, 512  , WSP(const bf16, WS_H8), (const bf16*)(wne + WNE_WIN), T_ALL / 256, INW / 256, ng, F.bid, 0, WIN_LD / 2};
                pg8::EpiInproj E{WSP(bf16, WS_P), WSP(unsigned char, WS_G8), WSP(unsigned char, WS_GR8), 1.f / WGU_SCALE};
                pg8::gemm_phase<pg8::ProbDense, pg8::EpiInproj, ALIGN_BIG, SKEW_BIG, 8, true>(ring, S, E, F.wave);
            }
            if (ng == F.G) phase_expert_prep(F, l, F.bid, F.G); else if (F.bid >= ng) phase_expert_prep(F, l, F.bid - ng, F.G - ng);
#ifdef DUP_PREP
            phase_expert_prep(F, l, F.bid, F.G);
#endif
            if (REPS(pb + 1) > 1) __syncthreads();
        } SEAM(pb + 1);
        if (IN(pb + 2)) _Pragma("unroll") for (int rep_ = 0; rep_ < REPS(pb + 2); ++rep_) {
#ifndef NO_R1
            phase_r1(F, l);
#ifdef DUP_R1
            phase_r1(F, l);
#endif
#endif
#ifndef NO_UT
            phase_ut(F, l); __syncthreads();
#ifdef DUP_UT
            phase_ut(F, l); __syncthreads();
#endif
#endif

        } SEAM(pb + 2);
        if (IN(pb + 3)) _Pragma("unroll") for (int rep_ = 0; rep_ < REPS(pb + 3); ++rep_) {
            phase_nyquist(F);
            phase_na(F, l);
#ifdef DUP_NA
            phase_na(F, l);
#endif
            phase_r2(F, l);
#ifdef DUP_R2
            phase_r2(F, l);
#endif
#ifdef DUP_NYQ
            phase_nyquist(F);
#endif
            { pg8::ProbBatched S{nullptr, 2048  , WSP(const bf16, WS_DFT), WSP(const bf16, WS_UT), (size_t)512 * 2048  , 16, 2, NB, F.G, F.bid};
              pg8::EpiFourier E{WSP(unsigned char, WS_FF), 0, NSEQ, 8, 1, 16.f / (64.f * 724.0773439350247f)};
              pg8::gemm_phase<pg8::ProbBatched, pg8::EpiFourier, true, 0, -1, true>(ring, S, E, F.wave); }
            if (l == 0) {
              pg8::ProbBatched S{nullptr, 256, WSP(const bf16, WS_DFTC), WSP(const bf16, WS_UTC), (size_t)512 * 256, 2, 2, NB, F.G, F.bid};
              pg8::EpiFourier E{WSP(unsigned char, WS_FF), T_LAT, NCTX, 1, 0, 16.f};
              pg8::gemm_phase<pg8::ProbBatched, pg8::EpiFourier>(ring, S, E, F.wave); }
        } SEAM(pb + 3);
        if (IN(pb + 4)) _Pragma("unroll") for (int rep_ = 0; rep_ < REPS(pb + 4); ++rep_) { phase_r3(F, l); } SEAM(pb + 4);
        if (IN(pb + 5)) _Pragma("unroll") for (int rep_ = 0; rep_ < REPS(pb + 5); ++rep_) {
            { pg8::ProbDense S{nullptr, 256  , WSP(const bf16, WS_YNA), (const bf16*)(wne + WNE_ONA), Mrows / 256, 4, F.G, F.bid};
              pg8::EpiFp8Plain E{WSP(unsigned char, WS_ZNA), 1024, 1.f / WGU_SCALE};
              pg8::gemm_phase<pg8::ProbDense, pg8::EpiFp8Plain, true, 0, -1, true>(ring, S, E, F.wave); }
            { pg8::ProbDense S{nullptr, 512, WSP(const bf16, WS_FF), (const bf16*)(wne + WNE_WF), Mrows / 256, 4, F.G, (F.bid + 88) % F.G};
              pg8::EpiFp8Plain E{WSP(unsigned char, WS_ZFF), 1024, 1.f / WGU_SCALE};
              pg8::gemm_phase<pg8::ProbDense, pg8::EpiFp8Plain, true, 0, -1, true>(ring, S, E, F.wave); }
            { pg8::ProbDense S{nullptr, 512, WSP(const bf16, WS_YRET), (const bf16*)(wne + WNE_ORET), Mrows / 256, 4, F.G, (F.bid + 176) % F.G};
              pg8::EpiFp8Plain E{WSP(unsigned char, WS_ZRET), 1024, 1.f / WGU_SCALE};
              pg8::gemm_phase<pg8::ProbDense, pg8::EpiFp8Plain, true, 0, -1, true>(ring, S, E, F.wave); }
        } SEAM(pb + 5);
        if (IN(pb + 6)) _Pragma("unroll") for (int rep_ = 0; rep_ < REPS(pb + 6); ++rep_) { phase_gatesum(F, Mrows); } SEAM(pb + 6);
        if (IN(pb + 7)) _Pragma("unroll") for (int rep_ = 0; rep_ < REPS(pb + 7); ++rep_) {
            pg8::ProbDense S{nullptr, 512, WSP(const bf16, WS_YSUMB), (const bf16*)(wne + WNE_WOUT), Mrows / 256, 4, F.G, F.bid};
            pg8::EpiFp8Plain E{WSP(unsigned char, WS_YOUT), 1024, 1.f / WGU_SCALE};
            pg8::gemm_phase<pg8::ProbDense, pg8::EpiFp8Plain, true, 0, -1, true>(ring, S, E, F.wave);
        } SEAM(pb + 7);
        if (IN(pb + 8)) _Pragma("unroll") for (int rep_ = 0; rep_ < REPS(pb + 8); ++rep_) { phase_ln_mix(F, l, Mrows); } SEAM(pb + 8);
        if (IN(pb + 9)) _Pragma("unroll") for (int rep_ = 0; rep_ < REPS(pb + 9); ++rep_) {
            pg8::ProbDense S{nullptr, 1024, WSP(const bf16, WS_H), (const bf16*)(wne + WNE_ROUT), Mrows / 256, 1, F.G, F.bid};
            pg8::EpiF32 E{WSP(float, WS_LOGIT), 256};
            pg8::gemm_phase<pg8::ProbDense, pg8::EpiF32>(ring, S, E, F.wave);
        } SEAM(pb + 9);
        if (IN(pb + 10)) _Pragma("unroll") for (int rep_ = 0; rep_ < REPS(pb + 10); ++rep_) { phase_topk(F, l, Mrows); } SEAM(pb + 10);
        if (IN(pb + 11)) _Pragma("unroll") for (int rep_ = 0; rep_ < REPS(pb + 11); ++rep_) { phase_slots(F, l, Mrows); } SEAM(pb + 11);
        if (IN(pb + 12)) _Pragma("unroll") for (int rep_ = 0; rep_ < REPS(pb + 12); ++rep_) {
            moe_units_setup(F, 2, WSP(const int, WS_STOK));
            pg8::ProbGU S{(const LAS int*)(F.lds + pg8::XT_XI), 512  , WSP(const bf16, WS_H8), WSP(const bf16, WS_WGU), (const LAS int*)(F.lds + pg8::XT_UT)};
            pg8::EpiSwiglu E{WSP(unsigned char, WS_ACT), 1.f / WGU_SCALE};
            pg8::gemm_phase<pg8::ProbGU, pg8::EpiSwiglu, ALIGN_BIG, SKEW_BIG, -1, true>(ring, S, E, F.wave);
        } SEAM(pb + 12);
        if (IN(pb + 13)) _Pragma("unroll") for (int rep_ = 0; rep_ < REPS(pb + 13); ++rep_) {
            moe_units_setup(F, 4, WSP(const int, WS_SW));
            pg8::ProbDown S{nullptr, 128  , WSP(const bf16, WS_ACT), WSP(const bf16, WS_WD), (const LAS int*)(F.lds + pg8::XT_UT)};
            pg8::EpiDown E{WSP(unsigned char, WS_YSLOT), (const LAS float*)(F.lds + pg8::XT_XI), 16.f / (16.f * WGU_SCALE)};
            pg8::gemm_phase<pg8::ProbDown, pg8::EpiDown, ALIGN_BIG, SKEW_DOWN, 10, true>(ring, S, E, F.wave);
        } SEAM(pb + 13);
        if (IN(pb + 14)) _Pragma("unroll") for (int rep_ = 0; rep_ < REPS(pb + 14); ++rep_) { phase_combine(F, l, Mrows); } SEAM(pb + 14);
    }
#ifdef SUBSEL
    if (F.bid == 0 && F.wave == 0 && lane_id_() == 0) {
        volatile LAS unsigned* sb = (volatile LAS unsigned*)(F.lds + MISC_OFF + 288);
        float tot = 0.f; for (int k = SUBLO; k <= SUBHI; ++k) tot += (float)sb[k];
        unsigned code = 0, mul = 1;
        for (int k = 0; k < 3; ++k) { int d = tot > 0.f ? (int)((float)sb[SUBSEL + k] * 15.f / tot + 0.5f) : 0; d = d > 15 ? 15 : d; code += (unsigned)d * mul; mul *= 16u; }
        const unsigned long long t0 = wall_clock64(), dt = (unsigned long long)code * 4000ull;
        while (wall_clock64() - t0 < dt) __builtin_amdgcn_s_sleep(32);
    }
#endif
#ifdef TSMASK
    if (F.bid == 0 && F.wave == 0 && lane_id_() == 0) {
        volatile LAS unsigned long long* ts = (volatile LAS unsigned long long*)(F.lds + MISC_OFF + 16);
        unsigned long long sel = 0;
        for (int k = 0; k < NPHASE; ++k) { const int slot = k == 0 ? 0 : ((k - 1) % NPL) + 1; if ((TSMASK >> slot) & 1u) sel += ts[k + 1] - ts[k]; }
        const unsigned long long t0 = wall_clock64(), dt = sel * TSAMP;
        while (wall_clock64() - t0 < dt) __builtin_amdgcn_s_sleep(32);
    }
#endif
#undef IN
#undef SEAM
}

extern "C" void kernel_launch(void* const* d_in, const int* in_sizes, int n_in, void* d_out, int out_size, void* d_ws, size_t ws_size, hipStream_t stream) {
    static int grid = 0;
    if (grid == 0) {
        if (n_in != 27 || out_size != T_LAT * D || ws_size < WS_END) { fprintf(stderr, "kernel_launch: unexpected problem (n_in %d out %d ws %zu)\n", n_in, out_size, ws_size); grid = -1; return; }
        int dev = 0, cus = 0;
        if (hipGetDevice(&dev) != hipSuccess || hipDeviceGetAttribute(&cus, hipDeviceAttributeMultiprocessorCount, dev) != hipSuccess) { grid = -1; return; }
        if (hipFuncSetAttribute((const void*)mk_fwd, hipFuncAttributeMaxDynamicSharedMemorySize, LDS_BYTES) != hipSuccess) { fprintf(stderr, "kernel_launch: hipFuncSetAttribute failed\n"); grid = -1; return; }
        int per_cu = 0;
        if (hipOccupancyMaxActiveBlocksPerMultiprocessor(&per_cu, (const void*)mk_fwd, NWAVES * 64, LDS_BYTES) != hipSuccess || per_cu < 1) fprintf(stderr, "kernel_launch: occupancy query reports %d\n", per_cu);
        (void)hipGetLastError();
        grid = cus;
    }
    if (grid < 0) return;
    if (hipMemsetAsync((char*)d_ws + WS_CTL, 0, CTL_BYTES, stream) != hipSuccess) return;
    Args a{};
    for (int i = 0; i < 27; ++i) a.in[i] = (const float*)d_in[i];
    a.out = (float*)d_out; a.ws = (unsigned char*)d_ws;
#if MK_PER_PHASE
    for (int p = 0; p < NPHASE; ++p) { a.ph_lo = p; a.ph_hi = p + 1; hipLaunchKernelGGL(mk_fwd, dim3(grid), dim3(NWAVES * 64), LDS_BYTES, stream, a); }
#else
    a.ph_lo = 0; a.ph_hi = NPHASE;
    hipLaunchKernelGGL(mk_fwd, dim3(grid), dim3(NWAVES * 64), LDS_BYTES, stream, a);
#endif
}
```

```cpp
#include <hip/hip_runtime.h>
#include <cstdio>
#include <cstdint>

#define LAS __attribute__((address_space(3)))
#define GAS __attribute__((address_space(1)))
typedef unsigned short bf16;
typedef short bf16x8 __attribute__((ext_vector_type(8)));
typedef short bf16x4 __attribute__((ext_vector_type(4)));
typedef float f32x4 __attribute__((ext_vector_type(4)));
typedef float f32x2 __attribute__((ext_vector_type(2)));
typedef unsigned u32x4 __attribute__((ext_vector_type(4)));
typedef unsigned u32x2 __attribute__((ext_vector_type(2)));

constexpr int D = 1024, NB = 8, NSEQ = 4096, NCTX = 256, GW = 64;
constexpr int T_LAT = NB * NSEQ, T_CTX = NB * NCTX, T_ALL = T_LAT + T_CTX;
constexpr int INW = 8192;
constexpr int C_QA = 0, C_KA = 512, C_VA = 1024, C_UB = 1536, C_QR = 2048, C_KR = 2560, C_VR = 3072, C_GR = 4096, C_GL = 5120;
constexpr int NE = 256, TOPK = 8, EDIM = 256;
constexpr int NCH = 34;
constexpr float DN_ALPHA = 1.41421356237309515f;
constexpr float LN_EPS = 1e-6f, GN_EPS = 1e-5f;
constexpr int MAX_TILES = 1343 + 136;

constexpr size_t MiB = 1u << 20;
constexpr size_t WS_CTL = 0, CTL_BYTES = 1 * MiB;
constexpr size_t WS_MOD = 1 * MiB;
constexpr size_t WS_ROPE = 2 * MiB;
constexpr size_t WS_META = 3 * MiB;
constexpr size_t WS_WNE = 8 * MiB, WNE_STRIDE = 24 * MiB;
constexpr size_t WNE_WIN = 0, WNE_ONA = 16 * MiB, WNE_WF = 17 * MiB, WNE_ORET = 19 * MiB, WNE_WOUT = 21 * MiB, WNE_ROUT = 23 * MiB;
#ifndef WIN_LD
#define WIN_LD 1152
#endif
constexpr size_t WS_DFT = 56 * MiB;
constexpr size_t WS_DFTC = 120 * MiB;
constexpr size_t WS_WGU = 128 * MiB;
constexpr size_t WS_WD = 386 * MiB;
constexpr size_t WS_X = 520 * MiB;
constexpr size_t WS_H = 656 * MiB;
constexpr size_t WS_R = 724 * MiB;
constexpr size_t WS_P = WS_R;
constexpr size_t WS_YNA = WS_R + 544 * MiB;
constexpr size_t WS_FF = WS_R + 578 * MiB;
constexpr size_t WS_YRET = WS_R + 646 * MiB;
constexpr size_t WS_UT = WS_R + 714 * MiB;
constexpr size_t WS_UTC = WS_UT + 32 * MiB;
constexpr size_t WS_KV = WS_R + 748 * MiB;
constexpr size_t WS_SPREV = WS_R + 1020 * MiB;
constexpr size_t WS_ZNA = WS_KV, WS_ZFF = WS_KV + 68 * MiB, WS_ZRET = WS_KV + 136 * MiB;
constexpr size_t WS_YSUMB = WS_KV + 204 * MiB;
constexpr size_t WS_YOUT = WS_KV;
constexpr size_t WS_TMIX = WS_R;
constexpr size_t WS_LOGIT = WS_R + 136 * MiB;
constexpr size_t WS_TOPE = WS_R + 170 * MiB;
constexpr size_t WS_TOPW = WS_R + 172 * MiB;
constexpr size_t WS_TPOS = WS_R + 174 * MiB;
constexpr size_t WS_TSLOT = WS_R + 176 * MiB;
constexpr size_t WS_STOK = WS_R + 178 * MiB;
constexpr size_t WS_SW = WS_R + 180 * MiB;
constexpr size_t WS_ACT = WS_R + 182 * MiB;
constexpr size_t WS_YSLOT = WS_R + 368 * MiB;
constexpr size_t WS_VT = WS_R + 1156 * MiB;
constexpr size_t WS_VTC = WS_VT + 32 * MiB;
constexpr size_t WS_H8 = WS_SPREV;
constexpr size_t WS_GR8 = WS_KV + 136 * MiB;
constexpr size_t WS_G8 = WS_R + 1190 * MiB;
constexpr size_t WS_END = 2016 * MiB;
constexpr int CW_BAR = 4096;
constexpr int CW_CNT = 16384;
constexpr int CW_CHK = 20000;

constexpr int LDS_BYTES = 159744;
constexpr int MISC_OFF = 159232;

__device__ __forceinline__ int lane_id_() { return (int)__builtin_amdgcn_mbcnt_hi(~0u, __builtin_amdgcn_mbcnt_lo(~0u, 0u)); }
#define LDS_WAIT() asm volatile("s_waitcnt lgkmcnt(0)" ::: "memory")
#define VM_WAIT() asm volatile("s_waitcnt vmcnt(0)" ::: "memory")
__device__ __forceinline__ unsigned f2bf(float f) { unsigned u = __builtin_bit_cast(unsigned, f); return (u + 0x7fffu + ((u >> 16) & 1u)) >> 16; }
__device__ __forceinline__ float bf2f(unsigned b) { return __builtin_bit_cast(float, (b & 0xffffu) << 16); }
__device__ __forceinline__ unsigned pk2(float lo, float hi) { unsigned r; asm volatile("v_cvt_pk_bf16_f32 %0, %1, %2" : "=v"(r) : "v"(lo), "v"(hi)); return r; }
__device__ __forceinline__ float bflo(unsigned w) { return __builtin_bit_cast(float, w << 16); }
__device__ __forceinline__ float bfhi(unsigned w) { return __builtin_bit_cast(float, w & 0xffff0000u); }
__device__ __forceinline__ float wave_sum(float v) {
#pragma unroll
    for (int o = 1; o < 64; o <<= 1) v += __shfl_xor(v, o);
    return v;
}
__device__ __forceinline__ float sigmoidf_(float x) { return __builtin_amdgcn_rcpf(1.f + __expf(-x)); }
__device__ __forceinline__ float siluf_(float x) { return x * __builtin_amdgcn_rcpf(1.f + __expf(-x)); }

#define XB_TMO      128
#define XB_XCNT(j)  (256  + 64 * (j))
#define XB_XSUB(j)  (1280 + 64 * (j))
#define XB_XGEN(j)  (2304 + 64 * (j))
#define XB_TOP      3328
#define XB_TOPGEN   3392
#define XCD_BAR_WORDS 3456
#define XB_SPIN_CAP (1u << 18)
__device__ __forceinline__ unsigned xb_ld(unsigned* p)              { return __hip_atomic_load(p, __ATOMIC_RELAXED, __HIP_MEMORY_SCOPE_AGENT); }
__device__ __forceinline__ unsigned xb_add(unsigned* p, unsigned v) { return __hip_atomic_fetch_add(p, v, __ATOMIC_RELAXED, __HIP_MEMORY_SCOPE_AGENT); }
__device__ __forceinline__ unsigned xb_xcc_id() { return (unsigned)__builtin_amdgcn_s_getreg((3 << 11) | 20) & 0xFu; }
#define XB_SPIN(cond, bar) do { unsigned _sp = 0; while (cond) { __builtin_amdgcn_s_sleep(1); \
    if ((++_sp & 255u) == 0u) { if (xb_ld(&(bar)[XB_TMO])) break; if (_sp > XB_SPIN_CAP) { atomicAdd(&(bar)[XB_TMO], 1u); break; } } } } while (0)
struct XcdBarrier { unsigned* bar; unsigned x; volatile LAS unsigned* st; };
__device__ __forceinline__ XcdBarrier xcd_barrier_post(unsigned* bar, volatile LAS unsigned* st, int wave_id) {
    XcdBarrier b; b.bar = bar; b.x = xb_xcc_id(); b.st = st;
    if (wave_id == 0 && lane_id_() == 0) (void)xb_add(&bar[XB_XCNT(b.x)], 1u);
    return b;
}
__device__ __forceinline__ void xcd_barrier_complete(unsigned* bar, unsigned x, unsigned& nloc, unsigned& nx) {
    const unsigned G = gridDim.x * gridDim.y * gridDim.z;
    unsigned sum, cnt, mine, sp = 0u;
    for (;;) {
        sum = 0u; cnt = 0u; mine = 0u;
#pragma unroll
        for (unsigned j = 0; j < 16; ++j) { const unsigned c = xb_ld(&bar[XB_XCNT(j)]); sum += c; cnt += (c > 0u) ? 1u : 0u; mine = (j == x) ? c : mine; }
        if (sum == G) break;
        __builtin_amdgcn_s_sleep(1);
        if ((++sp & 255u) == 0u) { if (xb_ld(&bar[XB_TMO])) break; if (sp > XB_SPIN_CAP) { atomicAdd(&bar[XB_TMO], 1u); break; } }
    }
    nloc = mine > 0u ? mine : 1u; nx = cnt > 0u ? cnt : 1u;
}
__device__ __forceinline__ void xcd_barrier(const XcdBarrier& b, int wave_id) {
    asm volatile("s_waitcnt vmcnt(0)" ::: "memory");
    __syncthreads();
    if (wave_id == 0 && lane_id_() == 0) {
        unsigned* bar = b.bar;
        __builtin_amdgcn_s_waitcnt(0);
        unsigned nloc = b.st[0], nx = b.st[1];
        if (nloc == 0u) { xcd_barrier_complete(bar, b.x, nloc, nx); b.st[0] = nloc; b.st[1] = nx; }
        const unsigned old = xb_add(&bar[XB_XSUB(b.x)], 1u);
        const unsigned gen = old / nloc;
        if (old + 1u == (gen + 1u) * nloc) {
            __builtin_amdgcn_fence(__ATOMIC_RELEASE, "agent");
            asm volatile("s_waitcnt vmcnt(0)" ::: "memory");
            const unsigned og = xb_add(&bar[XB_TOP], 1u);
            const unsigned tg = og / nx;
            if (og + 1u == (tg + 1u) * nx) xb_add(&bar[XB_TOPGEN], 1u);
            else XB_SPIN(xb_ld(&bar[XB_TOPGEN]) == tg, bar);
            __builtin_amdgcn_fence(__ATOMIC_ACQUIRE, "agent");
            xb_add(&bar[XB_XGEN(b.x)], 1u);
            asm volatile("s_waitcnt vmcnt(0)" ::: "memory");
        } else {
            XB_SPIN(xb_ld(&bar[XB_XGEN(b.x)]) == gen, bar);
            __builtin_amdgcn_fence(__ATOMIC_ACQUIRE, "agent");
            asm volatile("s_waitcnt vmcnt(0)" ::: "memory");
        }
    }
    __syncthreads();
}
namespace pg8 {
#ifndef SKEW_TICKS
#define SKEW_TICKS 27u
#endif
constexpr int BM = 256, BK = 64, HALF = 128, HTB = HALF * BK * 2, STAGE_BYTES = 8 * HTB, NXCD = 8, WGM = 8;
__host__ __device__ __forceinline__ int lds_byte(int r, int c) { const int st = (r >> 4) * 2 + (c >> 5), rr = r & 15, cc = c & 31, ob = rr * 64 + cc * 2; return st * 1024 + (ob ^ (((ob >> 9) & 1) << 5)); }
__host__ __device__ __forceinline__ void stage_rc(int b, int& R, int& C) { const int st = b / 1024, sb = b % 1024, swz = sb ^ (((sb >> 9) & 1) << 5); R = (st >> 1) * 16 + swz / 64; C = (st & 1) * 32 + (swz % 64) / 2; }
__host__ __device__ __forceinline__ int perm32(int rho) { const int n = rho >> 4, i = rho & 15; return 8 * (i >> 2) + 4 * n + (i & 3); }
__host__ __device__ __forceinline__ int perm64(int R) { return (R >> 5) * 64 + ((R >> 2) & 3) * 16 + ((R >> 4) & 1) * 4 + (R & 3); }

struct Unit { int pm, pn, e, aux; };
typedef int i8v_ __attribute__((ext_vector_type(8)));
__device__ __forceinline__ unsigned cvt_pk_bf16(float lo, float hi) { unsigned r; asm volatile("v_cvt_pk_bf16_f32 %0, %1, %2" : "=v"(r) : "v"(lo), "v"(hi)); return r; }

__device__ __forceinline__ bool static_tile(int nM, int nN, int G, int c, int i, int& pm, int& pn) {
    const int nwg = nM * nN; const long L = (long)i * G + c; if (L >= nwg) return false;
    int wgid = (int)L; { const int q = nwg / NXCD, r = nwg % NXCD, xcd = wgid % NXCD, off = wgid / NXCD; wgid = (xcd < r ? xcd * (q + 1) : r * (q + 1) + (xcd - r) * q) + off; }
    const int nig = WGM * nN, gid = wgid / nig, fm = gid * WGM, gsz = (nM - fm) < WGM ? (nM - fm) : WGM;
    pm = fm + ((wgid % nig) % gsz); pn = (wgid % nig) / gsz; return true;
}

template <class Prob, class Epi, bool ALIGN_EPI = true, int SKEW = 0  , int STAMP = -1  ,
          bool F8 = false  >
__device__ __forceinline__ void gemm_phase(LAS unsigned char* lds, const Prob& S, const Epi& E, int wave_id) {
    int lane_ = lane_id_(); asm volatile("" : "+v"(lane_));
    const int wid = wave_id, lane = lane_, tid = wid * 64 + lane, wr = wid >> 2, wc = wid & 3, fr = lane & 15, fq = lane >> 4;
    int K_ = S.K, la_ = S.lda(), lb_ = S.ldb(); asm volatile("" : "+s"(K_), "+s"(la_), "+s"(lb_));
    const int K = K_, nt = K / BK, lda = la_, ldb = lb_;
    unsigned voffA[2], voffB[2]; int RA[2], CA[2];
#pragma unroll
    for (int i = 0; i < 2; ++i) { int R, C; stage_rc(tid * 16 + i * 8192, R, C); const int Rb = (int)Epi::PERM == 2 ? perm64(R) : (Epi::PERM ? ((R & ~31) + perm32(R & 31)) : R);
        RA[i] = R; CA[i] = C; voffA[i] = (unsigned)(R * lda + C) * 2u; voffB[i] = (unsigned)(Rb * ldb + C) * 2u; }
    const size_t kstep = (size_t)(BK * 2);
    const size_t hstepA = (size_t)HALF * lda * 2, hstepB = (size_t)((int)Epi::PERM == 2 ? 8 : HALF) * ldb * 2;
    const unsigned ldsw = (unsigned)wid * 1024u;
    const int aoff = lds_byte(wr * 64 + fr, fq * 8), boff = lds_byte(wc * 32 + fr, fq * 8);
#define PG8_SA(b, h) (((b) * 2 + (h)) * HTB)
#define PG8_SB(b, h) ((4 + (b) * 2 + (h)) * HTB)
#define PG8_STAGE(bufoff, gbase, voff) do { _Pragma("unroll") for (int _i = 0; _i < 2; ++_i) \
        __builtin_amdgcn_global_load_lds((const unsigned*)((const char*)(gbase) + (voff)[_i]), (LAS unsigned*)(lds + (bufoff) + ldsw + _i * 8192), 16, 0, 0); } while (0)
#define PG8_STAGE_A(bufoff, kp, h, g0, g1) do { if constexpr (Prob::GATHER) { if ((h) == 0) PG8_STAGE(bufoff, kp, g0); else PG8_STAGE(bufoff, kp, g1); } \
        else PG8_STAGE(bufoff, (kp) + (h) * hstepA, voffA); } while (0)
#define PG8_LDA(dst, b, h) do { _Pragma("unroll") for (int m = 0; m < 4; ++m) _Pragma("unroll") for (int k = 0; k < 2; ++k) dst[m][k] = *(const LAS bf16x8*)(lds + PG8_SA(b, h) + aoff + m * 2048 + k * 1024); } while (0)
#define PG8_LDB(dst, b, h) do { _Pragma("unroll") for (int n = 0; n < 2; ++n) _Pragma("unroll") for (int k = 0; k < 2; ++k) dst[n][k] = *(const LAS bf16x8*)(lds + PG8_SB(b, h) + boff + n * 2048 + k * 1024); } while (0)
#define PG8_MMA(ai, bj, At, Bt) do { __builtin_amdgcn_s_setprio(1); _Pragma("unroll") for (int m = 0; m < 4; ++m) _Pragma("unroll") for (int n = 0; n < 2; ++n) { \
        if constexpr (F8) { typedef int i4_ __attribute__((ext_vector_type(4))); \
            const i8v_ b_ = __builtin_shufflevector(__builtin_bit_cast(i4_, Bt[n][0]), __builtin_bit_cast(i4_, Bt[n][1]), 0, 1, 2, 3, 4, 5, 6, 7), a_ = __builtin_shufflevector(__builtin_bit_cast(i4_, At[m][0]), __builtin_bit_cast(i4_, At[m][1]), 0, 1, 2, 3, 4, 5, 6, 7); \
            asm volatile("v_mfma_f32_16x16x128_f8f6f4 %0, %1, %2, %0" : "+v"(acc[ai][bj][m][n]) : "v"(b_), "v"(a_));   } \
        else { _Pragma("unroll") for (int k = 0; k < 2; ++k) acc[ai][bj][m][n] = __builtin_amdgcn_mfma_f32_16x16x32_bf16(Bt[n][k], At[m][k], acc[ai][bj][m][n], 0, 0, 0); } } __builtin_amdgcn_s_setprio(0); } while (0)
#define PG8_WAIT_V(n) asm volatile("s_waitcnt vmcnt(" #n ")" ::: "memory")
#define PG8_WAIT_L(n) asm volatile("s_waitcnt lgkmcnt(" #n ")" ::: "memory")
#define PG8_BAR __builtin_amdgcn_s_barrier()
#define PG8_SCHED __builtin_amdgcn_sched_barrier(0)
#ifdef SUBSEL
#define PG8_TS(k, add) do { if (STAMP >= 0 && blockIdx.x == 0 && wid == 0) { volatile LAS unsigned* sb_ = (volatile LAS unsigned*)(lds + MISC_OFF + 288); const unsigned n_ = (unsigned)__builtin_amdgcn_s_memrealtime(); if (add) sb_[STAMP + (k)] += n_ - sb_[15]; sb_[15] = n_; } } while (0)
#else
#define PG8_TS(k, add) do { } while (0)
#endif
    Unit cur, nxt; int ui = 0;
    if (!S.next(0, cur)) return;
    if constexpr (SKEW > 0) {
        const unsigned grp = (blockIdx.x >> 3) & 3u;
        if (grp) { const unsigned long long t0 = wall_clock64(), dt = (unsigned long long)(grp * (unsigned)SKEW);
            while (wall_clock64() - t0 < dt) __builtin_amdgcn_s_sleep(8); } }
    f32x4 acc[2][2][4][2];
#pragma unroll
    for (int a = 0; a < 2; ++a)
#pragma unroll
        for (int b = 0; b < 2; ++b)
#pragma unroll
            for (int m = 0; m < 4; ++m)
#pragma unroll
                for (int n = 0; n < 2; ++n) acc[a][b][m][n] = (f32x4){0.f, 0.f, 0.f, 0.f};
    bf16x8 At[4][2], B0[2][2], B1[2][2];
    const char* cA = S.a_tile(cur); const char* cB = S.b_tile(cur);
    unsigned gc0[2] = {0u, 0u}, gc1[2] = {0u, 0u}, gn0[2] = {0u, 0u}, gn1[2] = {0u, 0u};
    if constexpr (Prob::GATHER) {
#pragma unroll
        for (int i = 0; i < 2; ++i) { const int r0 = S.gidx[cur.aux * 256 + RA[i]], r1 = S.gidx[cur.aux * 256 + 128 + RA[i]];
            gc0[i] = (unsigned)(r0 * lda + CA[i]) * 2u; gc1[i] = (unsigned)(r1 * lda + CA[i]) * 2u; }
    }
    PG8_STAGE(PG8_SB(0, 0), cB, voffB); PG8_STAGE(PG8_SB(0, 1), cB + hstepB, voffB); PG8_STAGE_A(PG8_SA(0, 0), cA, 0, gc0, gc1); PG8_STAGE_A(PG8_SA(0, 1), cA, 1, gc0, gc1);
    if (wr == 1) PG8_BAR;
    PG8_WAIT_V(2); PG8_BAR;
    PG8_STAGE(PG8_SB(1, 0), cB + kstep, voffB); PG8_STAGE_A(PG8_SA(1, 0), cA + kstep, 0, gc0, gc1); PG8_STAGE(PG8_SB(1, 1), cB + hstepB + kstep, voffB);
    PG8_WAIT_V(6); PG8_BAR;
    for (;;) {
        const bool has_next = S.next(ui + 1, nxt);
        const char* nA = has_next ? S.a_tile(nxt) : cA; const char* nB = has_next ? S.b_tile(nxt) : cB;
        if constexpr (Prob::GATHER) {
            if (has_next) {
#pragma unroll
                for (int i = 0; i < 2; ++i) { const int r0 = S.gidx[nxt.aux * 256 + RA[i]], r1 = S.gidx[nxt.aux * 256 + 128 + RA[i]];
                    gn0[i] = (unsigned)(r0 * lda + CA[i]) * 2u; gn1[i] = (unsigned)(r1 * lda + CA[i]) * 2u; }
            } else { gn0[0] = gc0[0]; gn0[1] = gc0[1]; gn1[0] = gc1[0]; gn1[1] = gc1[1]; }
        }
        PG8_TS(1, ui > 0);
#ifdef EXP_KDUP
        constexpr bool kdup = (STAMP == EXP_KDUP);
#else
        constexpr bool kdup = false;
#endif
        const int ntx = kdup ? 2 * nt : nt;
        for (int t = 0; t < ntx; t += 2) {
            const bool last = (t == ntx - 2);
            const int tw = kdup ? (t & (nt - 1)) : t, t2 = kdup ? ((t + 2) & (nt - 1)) : t + 2;
            const char* a1 = cA + (size_t)(tw + 1) * kstep;
            const char* a2 = last ? nA : cA + (size_t)t2 * kstep; const char* b2 = last ? nB : cB + (size_t)t2 * kstep;
            const char* a3 = a2 + kstep; const char* b3 = b2 + kstep;
            unsigned g20[2], g21[2];
            g20[0] = last ? gn0[0] : gc0[0]; g20[1] = last ? gn0[1] : gc0[1]; g21[0] = last ? gn1[0] : gc1[0]; g21[1] = last ? gn1[1] : gc1[1];
            PG8_LDB(B0, 0, 0); PG8_LDB(B1, 0, 1); PG8_SCHED; PG8_LDA(At, 0, 0); PG8_STAGE_A(PG8_SA(1, 1), a1, 1, gc0, gc1);
            PG8_WAIT_V(8); PG8_WAIT_L(0); PG8_BAR; PG8_MMA(0, 0, At, B0); PG8_MMA(0, 1, At, B1); PG8_BAR; PG8_SCHED;
            PG8_LDA(At, 0, 1); PG8_STAGE(PG8_SB(0, 0), b2, voffB); PG8_STAGE(PG8_SB(0, 1), b2 + hstepB, voffB); PG8_STAGE_A(PG8_SA(0, 0), a2, 0, g20, g21);
            PG8_WAIT_V(8); PG8_WAIT_L(0); PG8_BAR; PG8_MMA(1, 0, At, B0); PG8_MMA(1, 1, At, B1); PG8_BAR; PG8_SCHED;
            PG8_LDB(B0, 1, 0); PG8_LDB(B1, 1, 1); PG8_SCHED; PG8_LDA(At, 1, 0); PG8_STAGE_A(PG8_SA(0, 1), a2, 1, g20, g21);
            PG8_WAIT_V(8); PG8_WAIT_L(0); PG8_BAR; PG8_MMA(0, 0, At, B0); PG8_MMA(0, 1, At, B1); PG8_BAR; PG8_SCHED;
            PG8_LDA(At, 1, 1); PG8_STAGE(PG8_SB(1, 0), b3, voffB); PG8_STAGE(PG8_SB(1, 1), b3 + hstepB, voffB); PG8_STAGE_A(PG8_SA(1, 0), a3, 0, g20, g21);
            PG8_WAIT_V(8); PG8_WAIT_L(0); PG8_BAR; PG8_MMA(1, 0, At, B0); PG8_MMA(1, 1, At, B1); PG8_BAR; PG8_SCHED;
        }
        PG8_TS(0, true);
        if constexpr (F8) asm volatile("s_nop 15\n\ts_nop 15" ::: "memory");
        if constexpr (kdup) {
#pragma unroll
            for (int a = 0; a < 2; ++a)
#pragma unroll
                for (int b = 0; b < 2; ++b)
#pragma unroll
                    for (int m = 0; m < 4; ++m)
#pragma unroll
                        for (int n = 0; n < 2; ++n) acc[a][b][m][n] *= 0.5f; }
        if constexpr (ALIGN_EPI) { if (wr == 0) PG8_BAR; }
        E(acc, cur, wr, wc, fr, fq);
#ifdef EXP_EPI2
        if constexpr (STAMP == EXP_EPI2) { asm volatile("" ::: "memory"); E(acc, cur, wr, wc, fr, fq); }
#endif
#ifdef EXP_WAIT0
        PG8_WAIT_V(0);
#endif
        if (!has_next) break;
#pragma unroll
        for (int a = 0; a < 2; ++a)
#pragma unroll
            for (int b = 0; b < 2; ++b)
#pragma unroll
                for (int m = 0; m < 4; ++m)
#pragma unroll
                    for (int n = 0; n < 2; ++n) acc[a][b][m][n] = (f32x4){0.f, 0.f, 0.f, 0.f};
        cur = nxt; cA = nA; cB = nB; ++ui;
        if constexpr (Prob::GATHER) { gc0[0] = gn0[0]; gc0[1] = gn0[1]; gc1[0] = gn1[0]; gc1[1] = gn1[1]; }
        if constexpr (ALIGN_EPI) { if (wr == 1) PG8_BAR; }
    }
    PG8_WAIT_V(0);
    if constexpr (!ALIGN_EPI) { if (wr == 0) PG8_BAR; }
    PG8_BAR;
#undef PG8_TS
#undef PG8_SA
#undef PG8_SB
#undef PG8_STAGE
#undef PG8_STAGE_A
#undef PG8_LDA
#undef PG8_LDB
#undef PG8_MMA
#undef PG8_WAIT_V
#undef PG8_WAIT_L
#undef PG8_BAR
#undef PG8_SCHED
}
}
namespace pg8 {
struct ProbDense {
    static constexpr bool GATHER = false; const LAS int* gidx;
    int K; const bf16* A; const bf16* Bt; int nM, nN, G, c;
    int ldA = 0, ldB = 0;
    __device__ __forceinline__ int lda() const { return ldA ? ldA : K; }
    __device__ __forceinline__ int ldb() const { return ldB ? ldB : K; }
    __device__ __forceinline__ bool next(int i, Unit& u) const { u.e = 0; u.aux = 0; return static_tile(nM, nN, G, c, i, u.pm, u.pn); }
    __device__ __forceinline__ const char* a_tile(const Unit& u) const { return (const char*)A + (size_t)u.pm * 256 * lda() * 2; }
    __device__ __forceinline__ const char* b_tile(const Unit& u) const { return (const char*)Bt + (size_t)u.pn * 256 * ldb() * 2; }
};
struct ProbBatched {
    static constexpr bool GATHER = false; const LAS int* gidx;
    int K; const bf16* A; const bf16* Bt; size_t bstride  ; int nPm, nPn, nb, G, c;
    __device__ __forceinline__ int lda() const { return K; } __device__ __forceinline__ int ldb() const { return K; }
    __device__ __forceinline__ bool next(int i, Unit& u) const {
        const int per = nPm * nPn; int b, r;
        if (G == 256 && nb == 8) { b = c & 7; r = i * 32 + (c >> 3); if (r >= per) return false; }
        else { const int L = i * G + c; if (L >= nb * per) return false; b = L / per; r = L % per; }
        u.e = b; u.pm = r / nPn; u.pn = r % nPn; u.aux = 0; return true; }
    __device__ __forceinline__ const char* a_tile(const Unit& u) const { return (const char*)A + (size_t)u.pm * 256 * K * 2; }
    __device__ __forceinline__ const char* b_tile(const Unit& u) const { return (const char*)(Bt + (size_t)u.e * bstride) + (size_t)u.pn * 256 * K * 2; }
};
constexpr int XT_OFF = 131072, XT_MAXU = 24, XT_UT = XT_OFF, XT_XI = XT_OFF + XT_MAXU * 16;
struct ProbGU {
    static constexpr bool GATHER = true; const LAS int* gidx  ;
    int K; const bf16* A; const bf16* W; const LAS int* ut;
    __device__ __forceinline__ int lda() const { return K; } __device__ __forceinline__ int ldb() const { return K; }
    __device__ __forceinline__ bool next(int i, Unit& u) const {
        if (i >= XT_MAXU) return false; if (__builtin_amdgcn_readfirstlane(ut[i * 4 + 3]) == 0) return false;
        u.pm = __builtin_amdgcn_readfirstlane(ut[i * 4]); u.pn = __builtin_amdgcn_readfirstlane(ut[i * 4 + 1]); u.e = __builtin_amdgcn_readfirstlane(ut[i * 4 + 2]); u.aux = i; return true; }
    __device__ __forceinline__ const char* a_tile(const Unit&) const { return (const char*)A; }
    __device__ __forceinline__ const char* b_tile(const Unit& u) const { return (const char*)W + ((size_t)u.e * 512 + (size_t)u.pn * 256) * K * 2; }
};
struct ProbDown {
    static constexpr bool GATHER = false; const LAS int* gidx;
    int K; const bf16* A; const bf16* W; const LAS int* ut;
    __device__ __forceinline__ int lda() const { return K; } __device__ __forceinline__ int ldb() const { return K; }
    __device__ __forceinline__ bool next(int i, Unit& u) const {
        if (i >= XT_MAXU) return false; if (__builtin_amdgcn_readfirstlane(ut[i * 4 + 3]) == 0) return false;
        u.pm = __builtin_amdgcn_readfirstlane(ut[i * 4]); u.pn = __builtin_amdgcn_readfirstlane(ut[i * 4 + 1]); u.e = __builtin_amdgcn_readfirstlane(ut[i * 4 + 2]); u.aux = i; return true; }
    __device__ __forceinline__ const char* a_tile(const Unit& u) const { return (const char*)A + (size_t)u.pm * 256 * K * 2; }
    __device__ __forceinline__ const char* b_tile(const Unit& u) const { return (const char*)W + ((size_t)u.e * 1024 + (size_t)u.pn * 256) * K * 2; }
};

typedef f32x4 Acc[2][2][4][2];
template <class T> __device__ __forceinline__ T* at(T* base, unsigned byte_off) { return (T*)((char*)base + byte_off); }
template <class T> __device__ __forceinline__ const T* at(const T* base, unsigned byte_off) { return (const T*)((const char*)base + byte_off); }
#ifndef USE_NT
template <class V> __device__ __forceinline__ void st_stream(V* p, const V& v) { *p = v; }
#else
template <class V> __device__ __forceinline__ void st_stream(V* p, const V& v) { __builtin_nontemporal_store(v, p); }
#endif
__device__ __forceinline__ u32x4 pack_bf16x8(const f32x4& v0, const f32x4& v1) { u32x4 w; w.x = cvt_pk_bf16(v0[0], v0[1]); w.y = cvt_pk_bf16(v0[2], v0[3]); w.z = cvt_pk_bf16(v1[0], v1[1]); w.w = cvt_pk_bf16(v1[2], v1[3]); return w; }
constexpr float YS_SCALE = 16.f, YS_INV = 1.f / 16.f;
__device__ __forceinline__ unsigned pack_fp8x4(float a, float b, float c, float d) {
    a = fminf(fmaxf(a, -448.f), 448.f); b = fminf(fmaxf(b, -448.f), 448.f); c = fminf(fmaxf(c, -448.f), 448.f); d = fminf(fmaxf(d, -448.f), 448.f);
    int w = 0; w = __builtin_amdgcn_cvt_pk_fp8_f32(a, b, w, false); w = __builtin_amdgcn_cvt_pk_fp8_f32(c, d, w, true); return (unsigned)w; }
__device__ __forceinline__ u32x2 pack_fp8x8(const f32x4& v0, const f32x4& v1, float sc) { u32x2 w; w.x = pack_fp8x4(v0[0] * sc, v0[1] * sc, v0[2] * sc, v0[3] * sc); w.y = pack_fp8x4(v1[0] * sc, v1[1] * sc, v1[2] * sc, v1[3] * sc); return w; }
struct EpiInproj {
    static constexpr int PERM = 2; bf16* O; unsigned char* G8; unsigned char* GR8; float inv  ;
    __device__ __forceinline__ void operator()(const Acc& acc0, const Unit& u, int wr, int wc, int fr, int fq) const {
        Acc acc;
#pragma unroll
        for (int a_ = 0; a_ < 2; ++a_)
#pragma unroll
            for (int b_ = 0; b_ < 2; ++b_)
#pragma unroll
                for (int m_ = 0; m_ < 4; ++m_)
#pragma unroll
                    for (int n_ = 0; n_ < 2; ++n_) acc[a_][b_][m_][n_] = acc0[a_][b_][m_][n_] * inv;
        const int row = u.pm * 256 + wr * 64 + fr, col = u.pn * 256 + wc * 64 + 16 * fq;
        if (u.pn >= C_GR / 256 && u.pn < C_GL / 256) {
            const unsigned o0 = (unsigned)(row * 1024 + col - C_GR);
#pragma unroll
            for (int ai = 0; ai < 2; ++ai)
#pragma unroll
                for (int m = 0; m < 4; ++m) { const u32x2 lo = pack_fp8x8(acc[ai][0][m][0], acc[ai][0][m][1], YS_SCALE), hi = pack_fp8x8(acc[ai][1][m][0], acc[ai][1][m][1], YS_SCALE);
                    u32x4 w; w.x = lo.x; w.y = lo.y; w.z = hi.x; w.w = hi.y; *(u32x4*)at(GR8, o0 + (unsigned)(ai * HALF + m * 16) * 1024u) = w; }
        } else if (u.pn < C_GL / 256) {
            const unsigned o0 = (unsigned)(row * INW + col) * 2u;
#pragma unroll
            for (int ai = 0; ai < 2; ++ai)
#pragma unroll
                for (int m = 0; m < 4; ++m)
#pragma unroll
                    for (int bj = 0; bj < 2; ++bj) *(u32x4*)at(O, o0 + (unsigned)(ai * HALF + m * 16) * (INW * 2u) + bj * 16) = pack_bf16x8(acc[ai][bj][m][0], acc[ai][bj][m][1]);
        } else {
            const unsigned o0 = (unsigned)(row * 3072 + col - C_GL);
#pragma unroll
            for (int ai = 0; ai < 2; ++ai)
#pragma unroll
                for (int m = 0; m < 4; ++m) { const u32x2 lo = pack_fp8x8(acc[ai][0][m][0], acc[ai][0][m][1], YS_SCALE), hi = pack_fp8x8(acc[ai][1][m][0], acc[ai][1][m][1], YS_SCALE);
                    u32x4 w; w.x = lo.x; w.y = lo.y; w.z = hi.x; w.w = hi.y; *(u32x4*)at(G8, o0 + (unsigned)(ai * HALF + m * 16) * 3072u) = w; }
        }
    }
};
struct EpiFp8Plain {
    static constexpr int PERM = 2; unsigned char* O; int ldc; float sc;
    __device__ __forceinline__ void operator()(const Acc& acc, const Unit& u, int wr, int wc, int fr, int fq) const {
        const unsigned o0 = (unsigned)((u.pm * 256 + wr * 64 + fr) * ldc + u.pn * 256 + wc * 64 + 16 * fq), rs = (unsigned)ldc;
#pragma unroll
        for (int ai = 0; ai < 2; ++ai)
#pragma unroll
            for (int m = 0; m < 4; ++m) { const u32x2 lo = pack_fp8x8(acc[ai][0][m][0], acc[ai][0][m][1], sc), hi = pack_fp8x8(acc[ai][1][m][0], acc[ai][1][m][1], sc);
                u32x4 w; w.x = lo.x; w.y = lo.y; w.z = hi.x; w.w = hi.y; *(u32x4*)at(O, o0 + (unsigned)(ai * HALF + m * 16) * rs) = w; }
    }
};
struct EpiBf16Plain {
    static constexpr int PERM = 1; bf16* O; int ldc;
    __device__ __forceinline__ void operator()(const Acc& acc, const Unit& u, int wr, int wc, int fr, int fq) const {
        const unsigned o0 = (unsigned)((u.pm * 256 + wr * 64 + fr) * ldc + u.pn * 256 + wc * 32 + 8 * fq) * 2u, rs = (unsigned)ldc * 2u;
#pragma unroll
        for (int ai = 0; ai < 2; ++ai)
#pragma unroll
            for (int m = 0; m < 4; ++m)
#pragma unroll
                for (int bj = 0; bj < 2; ++bj) { const u32x4 w = pack_bf16x8(acc[ai][bj][m][0], acc[ai][bj][m][1]); u32x4* p = (u32x4*)at(O, o0 + (unsigned)(ai * HALF + m * 16) * rs + bj * HALF * 2);
                    *p = w;
#ifdef EXP_DOUBLE_STORE
                    if (ldc == INW) { asm volatile("" ::: "memory"); *p = w; asm volatile("" ::: "memory"); }
#endif
                }
    }
};
struct EpiFourier {
    static constexpr int PERM = 1; unsigned char* FF  ; int rowbase, rows_b, hp, mirror; float osc  ;
    __device__ __forceinline__ void operator()(const Acc& acc, const Unit& u, int wr, int wc, int fr, int fq) const {
        const int reim = u.pm / hp, pr = u.pm % hp;
        const int n0 = pr * 256 + wr * 64 + fr, rb = rowbase + u.e * rows_b;
        const unsigned c0 = (unsigned)(reim * 512 + u.pn * 256 + wc * 32 + 8 * fq);
        const float sg = (mirror && reim) ? -osc : osc;
#pragma unroll
        for (int ai = 0; ai < 2; ++ai)
#pragma unroll
            for (int m = 0; m < 4; ++m) { const int np = n0 + ai * HALF + m * 16;
#pragma unroll
                for (int bj = 0; bj < 2; ++bj) {
                    *(u32x2*)at(FF, (unsigned)(rb + np) * 1024u + c0 + bj * HALF) = pack_fp8x8(acc[ai][bj][m][0], acc[ai][bj][m][1], osc);
                    if (mirror && np != 0) *(u32x2*)at(FF, (unsigned)(rb + rows_b - np) * 1024u + c0 + bj * HALF) = pack_fp8x8(acc[ai][bj][m][0], acc[ai][bj][m][1], sg); } }
    }
};
struct EpiF32 {
    static constexpr int PERM = 0; float* C; int ldc;
    __device__ __forceinline__ void operator()(const Acc& acc, const Unit& u, int wr, int wc, int fr, int fq) const {
        const unsigned o0 = (unsigned)((u.pm * 256 + wr * 64 + fr) * ldc + u.pn * 256 + wc * 32 + 4 * fq) * 4u, rs = (unsigned)ldc * 4u;
#pragma unroll
        for (int ai = 0; ai < 2; ++ai)
#pragma unroll
            for (int m = 0; m < 4; ++m)
#pragma unroll
                for (int bj = 0; bj < 2; ++bj)
#pragma unroll
                    for (int n = 0; n < 2; ++n) *(f32x4*)at(C, o0 + (unsigned)(ai * HALF + m * 16) * rs + (bj * HALF + n * 16) * 4) = acc[ai][bj][m][n];
    }
};
template <int MODE  > struct EpiGate {
    static constexpr int PERM = 0; float* Y; bf16* YB; const bf16* P; int br;
    __device__ __forceinline__ void operator()(const Acc& acc, const Unit& u, int wr, int wc, int fr, int fq) const {
        const int row0 = u.pm * 256 + wr * 64 + fr, col0 = u.pn * 256 + wc * 32 + 4 * fq;
        const unsigned e0 = (unsigned)(row0 * 1024 + col0), p0 = (unsigned)(row0 * INW + C_GL + br * 1024 + col0) * 2u;
#pragma unroll
        for (int ai = 0; ai < 2; ++ai)
#pragma unroll
            for (int m = 0; m < 4; ++m)
#pragma unroll
                for (int bj = 0; bj < 2; ++bj)
#pragma unroll
                    for (int n = 0; n < 2; ++n) { const unsigned rr = (unsigned)(ai * HALF + m * 16), cc = (unsigned)(bj * HALF + n * 16), e = e0 + rr * 1024u + cc;
                        const u32x2 gw = *(const u32x2*)at(P, p0 + rr * (INW * 2u) + cc * 2u);
                        f32x4 g; g[0] = sigmoidf_(bflo(gw.x)); g[1] = sigmoidf_(bfhi(gw.x)); g[2] = sigmoidf_(bflo(gw.y)); g[3] = sigmoidf_(bfhi(gw.y));
                        f32x4 v = acc[ai][bj][m][n] * g;
                        if (MODE >= 1) v += *(const f32x4*)at(Y, e * 4u);
                        if (MODE <= 1) *(f32x4*)at(Y, e * 4u) = v;
                        else { u32x2 w; w.x = cvt_pk_bf16(v[0], v[1]); w.y = cvt_pk_bf16(v[2], v[3]); *(u32x2*)at(YB, e * 2u) = w; } }
    }
};
struct EpiWout {
    static constexpr int PERM = 0; float* tmix; const float* xlat; const float* xctx; const float* modl  ; int goff  ;
    __device__ __forceinline__ void operator()(const Acc& acc, const Unit& u, int wr, int wc, int fr, int fq) const {
        const int rowt = u.pm * 256; const bool isctx = rowt >= T_LAT;
        const int v = isctx ? 8 : rowt / NSEQ;
        const float* xs = isctx ? xctx + (size_t)(rowt - T_LAT) * 1024 : xlat + (size_t)rowt * 1024;
        float* tm = tmix + (size_t)rowt * 1024;
        const float* gv = modl + v * 6144 + goff;
        const unsigned col0 = (unsigned)(u.pn * 256 + wc * 32 + 4 * fq), e0 = (unsigned)((wr * 64 + fr) * 1024) + col0;
        f32x4 gg[2][2];
#pragma unroll
        for (int bj = 0; bj < 2; ++bj)
#pragma unroll
            for (int n = 0; n < 2; ++n) gg[bj][n] = *(const f32x4*)at(gv, (col0 + bj * HALF + n * 16) * 4u);
#pragma unroll
        for (int ai = 0; ai < 2; ++ai)
#pragma unroll
            for (int m = 0; m < 4; ++m)
#pragma unroll
                for (int bj = 0; bj < 2; ++bj)
#pragma unroll
                    for (int n = 0; n < 2; ++n) { const unsigned e = (e0 + (unsigned)(ai * HALF + m * 16) * 1024u + (unsigned)(bj * HALF + n * 16)) * 4u;
                        const f32x4 xv = *(const f32x4*)at(xs, e);
                        *(f32x4*)at(tm, e) = xv * DN_ALPHA + gg[bj][n] * acc[ai][bj][m][n]; }
    }
};
struct EpiSwiglu {
    static constexpr int PERM = 1; unsigned char* ACT; float inv;
    __device__ __forceinline__ void operator()(const Acc& acc, const Unit& u, int wr, int wc, int fr, int fq) const {
        const unsigned o0 = (unsigned)((u.pm * 256 + wr * 64 + fr) * 256 + u.pn * 128 + wc * 32 + 8 * fq);
#pragma unroll
        for (int ai = 0; ai < 2; ++ai)
#pragma unroll
            for (int m = 0; m < 4; ++m) {
                const f32x4 g0 = acc[ai][0][m][0] * inv, g1 = acc[ai][0][m][1] * inv, u0 = acc[ai][1][m][0] * inv, u1 = acc[ai][1][m][1] * inv;
                f32x4 a, b;
#pragma unroll
                for (int j = 0; j < 4; ++j) { a[j] = siluf_(g0[j]) * u0[j]; b[j] = siluf_(g1[j]) * u1[j]; }
                *(u32x2*)at(ACT, o0 + (unsigned)(ai * HALF + m * 16) * 256u) = pack_fp8x8(a, b, YS_SCALE); }
    }
};
struct EpiDown {
    static constexpr int PERM = 2; unsigned char* Y; const LAS float* sw  ; float osc  ;
    __device__ __forceinline__ void operator()(const Acc& acc, const Unit& u, int wr, int wc, int fr, int fq) const {
        const int r0 = u.pm * 256 + wr * 64 + fr; const LAS float* swu = sw + u.aux * 256 + wr * 64 + fr;
        const unsigned o0 = (unsigned)(r0 * 1024 + u.pn * 256 + wc * 64 + 16 * fq);
#pragma unroll
        for (int ai = 0; ai < 2; ++ai)
#pragma unroll
            for (int m = 0; m < 4; ++m) { const float w8 = swu[ai * HALF + m * 16] * osc;
                if (w8 != 0.f) {
                    u32x4 w;
                    { const f32x4 v0 = acc[ai][0][m][0] * w8, v1 = acc[ai][0][m][1] * w8; w.x = pack_fp8x4(v0[0], v0[1], v0[2], v0[3]); w.y = pack_fp8x4(v1[0], v1[1], v1[2], v1[3]); }
                    { const f32x4 v0 = acc[ai][1][m][0] * w8, v1 = acc[ai][1][m][1] * w8; w.z = pack_fp8x4(v0[0], v0[1], v0[2], v0[3]); w.w = pack_fp8x4(v1[0], v1[1], v1[2], v1[3]); }
                    *(u32x4*)at(Y, o0 + (unsigned)(ai * HALF + m * 16) * 1024u) = w; } }
    }
};
}
struct Frame {
    LAS unsigned char* lds; int tid, lane, wave, G, bid;
    unsigned char* ws;
};
#ifndef GMASK
#define GMASK 0x1u
#endif
#define PHG_ON (((GMASK >> PHG) & 1u) != 0)
template <bool G> __device__ __forceinline__ const float* karg_t(int i) {
    unsigned long long p = (unsigned long long)__builtin_amdgcn_kernarg_segment_ptr();
    asm volatile("" : "+s"(p));
    if (!G) return ((const float* const __attribute__((address_space(4)))*)p)[i];
    return (const float*)(((const float __attribute__((address_space(1)))* const __attribute__((address_space(4)))*)p)[i]);
}
#define KIN(i) karg_t<PHG_ON>(i)
#define karg(i) KIN(i)
__device__ __forceinline__ int karg_int(int byte_off) {
    unsigned long long p = (unsigned long long)__builtin_amdgcn_kernarg_segment_ptr();
    asm volatile("" : "+s"(p));
    return *(const int __attribute__((address_space(4)))*)(p + byte_off);
}
#ifdef SUBSEL
__device__ __forceinline__ void substamp_(LAS unsigned char* lds, int k, bool add) {
    volatile LAS unsigned* sb = (volatile LAS unsigned*)(lds + MISC_OFF + 288);
    const unsigned n = (unsigned)__builtin_amdgcn_s_memrealtime();
    if (add) sb[k] += n - sb[15];
    sb[15] = n;
}
#define SUBSTAMP(k) do { if (F.bid == 0 && F.wave == 0) substamp_(F.lds, (k), true); } while (0)
#define SUBRESET() do { if (F.bid == 0 && F.wave == 0) substamp_(F.lds, 0, false); } while (0)
#else
#define SUBSTAMP(k) do { } while (0)
#define SUBRESET() do { } while (0)
#endif
enum { I_X = 0, I_C, I_CTX, I_CCTX, I_ADAW, I_ADAB, I_WIN, I_RPB, I_WONA, I_WFOUR, I_DECF, I_DECB, I_GNW, I_WORET, I_WOUT, I_LNMW, I_LNMB,
       I_ROUTW, I_ROUTB, I_EWG, I_EWU, I_EWD, I_SWG, I_SWU, I_SWD, I_LNFW, I_LNFB };
template <bool G> __device__ __forceinline__ unsigned char* ws_opaque_t(unsigned char* p) { unsigned long long v = (unsigned long long)p; asm volatile("" : "+s"(v));
    if (G) return (unsigned char*)(__attribute__((address_space(1))) unsigned char*)v;
    return (unsigned char*)v; }
#define ws_opaque(p) ws_opaque_t<PHG_ON>(p)
#define WSP(T, off) ((T*)(ws_opaque(F.ws) + (off)))
constexpr int NWAVES = 8;
#define PHG 1

__device__ __forceinline__ void tr_item(const float* W, int N, int k0, int n0, bf16* WT, int ldt, int drow0, LAS float* scr, int lane) {
#pragma unroll
    for (int hb = 0; hb < 2; ++hb) { float wv[16];
#pragma unroll
        for (int i = 0; i < 16; ++i) { const int kk = 2 * (16 * hb + i) + (lane >> 5); wv[i] = W[(size_t)(k0 + kk) * N + n0 + (lane & 31)]; }
#pragma unroll
        for (int i = 0; i < 16; ++i) { const int kk = 2 * (16 * hb + i) + (lane >> 5); scr[kk * 33 + (lane & 31)] = wv[i]; } }
    LDS_WAIT(); asm volatile("" ::: "memory");
    const int c = lane & 7;
#pragma unroll
    for (int j = 0; j < 4; ++j) { const int n = (lane >> 3) + 8 * j; const LAS float* s = scr + (8 * c) * 33 + n;
        u32x4 o; o.x = pk2(s[0 * 33], s[1 * 33]); o.y = pk2(s[2 * 33], s[3 * 33]); o.z = pk2(s[4 * 33], s[5 * 33]); o.w = pk2(s[6 * 33], s[7 * 33]);
        *(u32x4*)(WT + (size_t)(drow0 + n) * ldt + k0 + 8 * c) = o; }
    LDS_WAIT(); asm volatile("" ::: "memory");
}

__device__ __forceinline__ void row_load(const float* p, int lane, f32x4 (&v)[4]) {
#pragma unroll
    for (int j = 0; j < 4; ++j) v[j] = *(const f32x4*)(p + 4 * lane + 256 * j);
}
__device__ __forceinline__ void row_ln(f32x4 (&v)[4]) {
    float s = 0.f;
#pragma unroll
    for (int j = 0; j < 4; ++j) s += (v[j][0] + v[j][1]) + (v[j][2] + v[j][3]);
    const float mean = wave_sum(s) * (1.f / D); float s2 = 0.f;
#pragma unroll
    for (int j = 0; j < 4; ++j) { v[j] = v[j] - mean; s2 += (v[j][0] * v[j][0] + v[j][1] * v[j][1]) + (v[j][2] * v[j][2] + v[j][3] * v[j][3]); }
    const float rstd = 1.f / sqrtf(wave_sum(s2) * (1.f / D) + LN_EPS);
#pragma unroll
    for (int j = 0; j < 4; ++j) v[j] = v[j] * rstd;
}
__device__ __forceinline__ void row_affine(f32x4 (&v)[4], const float* w, const float* b, int lane, bool one_plus) {
#pragma unroll
    for (int j = 0; j < 4; ++j) { f32x4 ww = *(const f32x4*)(w + 4 * lane + 256 * j); const f32x4 bb = *(const f32x4*)(b + 4 * lane + 256 * j);
        if (one_plus) ww = ww + 1.f; v[j] = v[j] * ww + bb; }
}
__device__ __forceinline__ void row_store_bf16(bf16* p, int lane, const f32x4 (&v)[4]) {
#pragma unroll
    for (int j = 0; j < 4; ++j) { u32x2 w; w.x = pk2(v[j][0], v[j][1]); w.y = pk2(v[j][2], v[j][3]); *(u32x2*)(p + 4 * lane + 256 * j) = w; }
}
__device__ __forceinline__ void row_store_f32(float* p, int lane, const f32x4 (&v)[4]) {
#pragma unroll
    for (int j = 0; j < 4; ++j) *(f32x4*)(p + 4 * lane + 256 * j) = v[j];
}
__device__ __forceinline__ const float* mod_vec(const Frame& F, int l, int row) {
    const int v = row >= T_LAT ? 8 : row / NSEQ; return WSP(const float, WS_MOD) + ((size_t)l * 9 + v) * 6144;
}

constexpr int TRF_P = 72, TRF_BYTES = 128 * TRF_P * 2;
__device__ __forceinline__ void tr_item_fast(const float* W, int N, int k0, int n0, bf16* WT, int ldt, int drow0, LAS bf16* tl, int lane) {
    const int hf = lane >> 5, c = lane & 31;
    f32x4 v[16][2];
#pragma unroll
    for (int i = 0; i < 16; ++i)
#pragma unroll
        for (int q = 0; q < 2; ++q) v[i][q] = *(const f32x4*)(W + (size_t)(k0 + 4 * i + 2 * hf + q) * N + n0 + 4 * c);
#pragma unroll
    for (int i = 0; i < 16; ++i)
#pragma unroll
        for (int j = 0; j < 4; ++j) *(LAS unsigned*)(tl + (4 * c + j) * TRF_P + 4 * i + 2 * hf) = pk2(v[i][0][j], v[i][1][j]);
    LDS_WAIT(); asm volatile("" ::: "memory");
#pragma unroll
    for (int it = 0; it < 16; ++it) { const int p = it * 64 + lane, n = p >> 3, kc = p & 7;
        *(u32x4*)(WT + (size_t)(drow0 + n) * ldt + k0 + 8 * kc) = *(const LAS u32x4*)(tl + n * TRF_P + 8 * kc); }
    LDS_WAIT(); asm volatile("" ::: "memory");
}
__device__ __forceinline__ void tr_item_fast8(const float* W, int N, int k0, int n0, unsigned char* WT8, int ldt, int drow0, LAS unsigned char* tl, int lane, float wscale) {
    const int hf = lane >> 5, c = lane & 31;
    f32x4 v[8][4];
#pragma unroll
    for (int i = 0; i < 8; ++i)
#pragma unroll
        for (int q = 0; q < 4; ++q) v[i][q] = *(const f32x4*)(W + (size_t)(k0 + 8 * i + 4 * hf + q) * N + n0 + 4 * c);
#pragma unroll
    for (int i = 0; i < 8; ++i)
#pragma unroll
        for (int j = 0; j < 4; ++j) *(LAS unsigned*)(tl + (4 * c + j) * 80 + 8 * i + 4 * hf) = pg8::pack_fp8x4(v[i][0][j] * wscale, v[i][1][j] * wscale, v[i][2][j] * wscale, v[i][3][j] * wscale);
    LDS_WAIT(); asm volatile("" ::: "memory");
#pragma unroll
    for (int it = 0; it < 8; ++it) { const int p = it * 64 + lane, n = p >> 2, kc = p & 3;
        *(u32x4*)(WT8 + (size_t)(drow0 + n) * ldt + k0 + 16 * kc) = *(const LAS u32x4*)(tl + n * 80 + 16 * kc); }
    LDS_WAIT(); asm volatile("" ::: "memory");
}
constexpr float WGU_SCALE = 32.f;
#undef PHG
#define PHG 1
__device__ __forceinline__ void phase_init(const Frame& F_) {
    Frame F = F_; asm volatile("" : "+s"(F.bid), "+s"(F.G), "+s"(F.wave)); F.lane = lane_id_(); asm volatile("" : "+v"(F.lane)); F.tid = F.wave * 64 + F.lane;
    const int gw = F.bid * NWAVES + F.wave, NGW = F.G * NWAVES;
    {
        LAS float* red = (LAS float*)F.lds;
        float* mod = WSP(float, WS_MOD);
        for (int u = F.bid; u < 2 * 96; u += F.G) {
            const int l = u / 96, n0 = (u % 96) * 64;
            const float* aw = KIN(I_ADAW) + (size_t)l * D * 6144;
            float acc[9];
#pragma unroll
            for (int v = 0; v < 9; ++v) acc[v] = 0.f;
            const float* cin = KIN(I_C); const float* ccx = KIN(I_CCTX);
            for (int k0 = F.wave * 128; k0 < F.wave * 128 + 128; k0 += 16) {
                float wv[16];
#pragma unroll
                for (int j = 0; j < 16; ++j) wv[j] = aw[(size_t)(k0 + j) * 6144 + n0 + F.lane];
#pragma unroll
                for (int j = 0; j < 16; ++j)
#pragma unroll
                    for (int v = 0; v < 9; ++v) { const float cv = v < 8 ? cin[v * D + k0 + j] : ccx[k0 + j]; acc[v] += siluf_(cv) * wv[j]; }
            }
#pragma unroll
            for (int v = 0; v < 9; ++v) red[(F.wave * 9 + v) * 64 + F.lane] = acc[v];
            __syncthreads();
            for (int o = F.tid; o < 9 * 64; o += 512) { const int v = o / 64, ln = o % 64; float s = 0.f;
#pragma unroll
                for (int w = 0; w < 8; ++w) s += red[(w * 9 + v) * 64 + ln];
                mod[((size_t)l * 9 + v) * 6144 + n0 + ln] = s + KIN(I_ADAB)[(size_t)l * 6144 + n0 + ln]; }
            __syncthreads();
        }
    }
    {
        float* rc = WSP(float, WS_ROPE); float* rs = rc + 2048;
        for (int i = F.bid * 512 + F.tid; i < 2048; i += F.G * 512) { const int pos = i / 32, f = i % 32;
            const double ang = (double)pos * pow(10000.0, -(double)f / 32.0); rc[i] = (float)cos(ang); rs[i] = (float)sin(ang); }
    }
    {
        __syncthreads();
        LAS float* ctab = (LAS float*)F.lds;
        for (int i = F.tid; i < 4096; i += 512) ctab[i] = cospif((float)i * (1.0f / 2048.0f));
        __syncthreads();
        unsigned char* dft = WSP(unsigned char, WS_DFT);
        for (size_t i = (size_t)F.bid * 512 + F.tid; i < (size_t)4096 * 512; i += (size_t)F.G * 512) {
            const int row = (int)(i / 512), n0 = (int)(i % 512) * 8, reim = row / 2048, np = row % 2048; float v[8];
#pragma unroll
            for (int j = 0; j < 8; ++j) { const int m = ((n0 + j) * np) & 4095; v[j] = (reim ? -ctab[(m - 1024) & 4095] : ctab[m]) * 64.f; }
            u32x2 o; o.x = pg8::pack_fp8x4(v[0], v[1], v[2], v[3]); o.y = pg8::pack_fp8x4(v[4], v[5], v[6], v[7]);
            *(u32x2*)(dft + (size_t)row * 4096 + n0) = o;
        }
        bf16* dftc = WSP(bf16, WS_DFTC); const float scc = 1.0f / 181.01933598375618f;
        for (int i = F.bid * 512 + F.tid; i < 512 * 32; i += F.G * 512) {
            const int row = i / 32, n0 = (i % 32) * 8, reim = row / 256, np = row % 256; float v[8];
#pragma unroll
            for (int j = 0; j < 8; ++j) { const int m = (((n0 + j) * np) & 255) * 16; v[j] = (reim ? -ctab[(m - 1024) & 4095] : ctab[m]) * scc; }
            u32x4 o; o.x = pk2(v[0], v[1]); o.y = pk2(v[2], v[3]); o.z = pk2(v[4], v[5]); o.w = pk2(v[6], v[7]);
            *(u32x4*)(dftc + (size_t)row * 256 + n0) = o;
        }
        __syncthreads();
    }
    {
        LAS float* scr = (LAS float*)(F.lds + 16384 + F.wave * 16384);
        constexpr int I_IN = 16 * 64, I_NA = 8 * 8, I_RET = 16 * 8, I_OUT = 16 * 8, I_RT = 16 * 8, PER = I_IN + I_NA + I_RET + I_OUT + I_RT;
        for (int it = gw; it < 2 * PER; it += NGW) {
            const int l = it / PER; int r = it % PER; unsigned char* wb = ws_opaque(F.ws) + WS_WNE + (size_t)l * WNE_STRIDE;
            const float* W; int K, N; bf16* WT;
            if (r < I_IN) {
                tr_item_fast8(KIN(I_WIN) + (size_t)l * 1024 * 8192, 8192, (r / 64) * 64, (r % 64) * 128, wb + WNE_WIN, WIN_LD, (r % 64) * 128, (LAS unsigned char*)scr, F.lane, WGU_SCALE); continue; }
            else if ((r -= I_IN) < I_NA) {
                tr_item_fast8(KIN(I_WONA) + (size_t)l * 512 * 1024, 1024, (r / 8) * 64, (r % 8) * 128, wb + WNE_ONA, 512, (r % 8) * 128, (LAS unsigned char*)scr, F.lane, WGU_SCALE); continue; }
            else if ((r -= I_NA) < I_RET) {
                tr_item_fast8(KIN(I_WORET) + (size_t)l * 1024 * 1024, 1024, (r / 8) * 64, (r % 8) * 128, wb + WNE_ORET, 1024, (r % 8) * 128, (LAS unsigned char*)scr, F.lane, WGU_SCALE); continue; }
            else if ((r -= I_RET) < I_OUT) {
                tr_item_fast8(KIN(I_WOUT) + (size_t)l * 1024 * 1024, 1024, (r / 8) * 64, (r % 8) * 128, wb + WNE_WOUT, 1024, (r % 8) * 128, (LAS unsigned char*)scr, F.lane, WGU_SCALE); continue; }
            else { r -= I_OUT; W = KIN(I_ROUTW) + (size_t)l * 1024 * 256; K = 1024; N = 256; WT = (bf16*)(wb + WNE_ROUT); }
            const int nblk = N / 32, kb = r / nblk, nb = r % nblk;
            tr_item(W, N, kb * 64, nb * 32, WT, K, nb * 32, scr, F.lane);
        }
        __syncthreads();
        LAS float* ctab2 = (LAS float*)F.lds;
        for (int i = F.tid; i < 4096; i += 512) ctab2[i] = cospif((float)i * (1.0f / 2048.0f));
        __syncthreads();
        for (int it = gw; it < 2 * 1024 * 16; it += NGW) {
            const int l = it / (1024 * 16), r = it % (1024 * 16), kk = r / 16, nb = r % 16, reim = kk / 512, g = (kk % 512) / 128, c = kk % 128, n = nb * 64 + F.lane;
            const float* wf = KIN(I_WFOUR) + (size_t)l * 512 * 1024 + (size_t)g * 128 * 1024 + n; float acc = 0.f;
            for (int cp = 0; cp < 128; ++cp) { const int m = ((c * cp) & 127) * 32; const float gv = reim ? ctab2[(m - 1024) & 4095] : ctab2[m]; acc += gv * wf[(size_t)cp * 1024]; }
            unsigned char* WT = ws_opaque(F.ws) + WS_WNE + (size_t)l * WNE_STRIDE + WNE_WF;
            WT[(size_t)n * 1024 + kk] = (unsigned char)(pg8::pack_fp8x4(acc * WGU_SCALE, 0.f, 0.f, 0.f) & 0xffu);
        }
    }
}

#undef PHG
#define PHG 2
__device__ __forceinline__ void phase_expert_prep(const Frame& F_, int l, int wi, int nw) {
    Frame F = F_; asm volatile("" : "+s"(F.bid), "+s"(F.G), "+s"(F.wave)); F.lane = lane_id_(); asm volatile("" : "+v"(F.lane)); F.tid = F.wave * 64 + F.lane;
    const int gw = wi * NWAVES + F.wave, NGW = nw * NWAVES;
    LAS bf16* tl = (LAS bf16*)(F.lds + F.wave * TRF_BYTES);
    unsigned char* WGU8 = WSP(unsigned char, WS_WGU); unsigned char* WD8 = WSP(unsigned char, WS_WD);
    for (int it = gw; it < 257 * 96; it += NGW) {
        const int e = it / 96, r = it % 96, which = r / 32, q = r % 32;
        if (which < 2) {
            const float* We = which ? KIN(I_EWU) : KIN(I_EWG); const float* Ws = which ? KIN(I_SWU) : KIN(I_SWG);
            const float* W = e < 256 ? We + ((size_t)l * 256 + e) * 1024 * 256 : Ws + (size_t)l * 1024 * 256;
            const int kb = q / 2, nb = q % 2;
            tr_item_fast8(W, 256, kb * 64, nb * 128, WGU8 + (size_t)e * 512 * 1024, 1024, 256 * nb + which * 128, (LAS unsigned char*)tl, F.lane, WGU_SCALE);
        } else {
            const float* W = e < 256 ? KIN(I_EWD) + ((size_t)l * 256 + e) * 256 * 1024 : KIN(I_SWD) + (size_t)l * 256 * 1024;
            const int kb = q / 8, nb = q % 8;
            tr_item_fast8(W, 1024, kb * 64, nb * 128, WD8 + (size_t)e * 1024 * 256, 256, nb * 128, (LAS unsigned char*)tl, F.lane, WGU_SCALE);
        }
    }
}
#undef PHG
#define PHG 3
__device__ __forceinline__ void phase_h0(const Frame& F_) {
    Frame F = F_; asm volatile("" : "+s"(F.bid), "+s"(F.G), "+s"(F.wave)); F.lane = lane_id_(); asm volatile("" : "+v"(F.lane)); F.tid = F.wave * 64 + F.lane;
    const int gw = F.bid * NWAVES + F.wave, NGW = F.G * NWAVES;
    unsigned char* H8 = WSP(unsigned char, WS_H8);
    for (int row = gw; row < T_ALL; row += NGW) {
        const float* src = row < T_LAT ? KIN(I_X) + (size_t)row * D : KIN(I_CTX) + (size_t)(row - T_LAT) * D;
        f32x4 v[4]; row_load(src, F.lane, v); row_ln(v);
        const float* mv = mod_vec(F, 0, row); row_affine(v, mv + 1024, mv, F.lane, true);
#pragma unroll
        for (int j = 0; j < 4; ++j) *(unsigned*)(H8 + (size_t)row * D + 4 * F.lane + 256 * j) = pg8::pack_fp8x4(v[j][0], v[j][1], v[j][2], v[j][3]);
    }
}

#undef PHG
#define PHG 3
__device__ __forceinline__ void phase_gatesum(const Frame& F_, int nrows) {
    Frame F = F_; asm volatile("" : "+s"(F.bid), "+s"(F.G), "+s"(F.wave)); F.lane = lane_id_(); asm volatile("" : "+v"(F.lane)); F.tid = F.wave * 64 + F.lane;
    const int gw = F.bid * NWAVES + F.wave, NGW = F.G * NWAVES, lane = F.lane;
    const unsigned char* G8 = WSP(const unsigned char, WS_G8); unsigned char* Y = WSP(unsigned char, WS_YSUMB);
    const unsigned char* Z0 = WSP(const unsigned char, WS_ZNA); const unsigned char* Z1 = WSP(const unsigned char, WS_ZFF); const unsigned char* Z2 = WSP(const unsigned char, WS_ZRET);
#define GS_LOAD(G_, Z_, row_) do { _Pragma("unroll") for (int j = 0; j < 2; ++j) { const int col = j * 512 + lane * 8; \
        _Pragma("unroll") for (int b = 0; b < 3; ++b) { const unsigned char* Zb = b == 0 ? Z0 : (b == 1 ? Z1 : Z2); \
            G_[j][b] = *(const u32x2*)(G8 + (size_t)(row_) * 3072 + b * 1024 + col); Z_[j][b] = *(const u32x2*)(Zb + (size_t)(row_) * 1024 + col); } } } while (0)
#define GS_COMP(G_, Z_, row_) do { _Pragma("unroll") for (int j = 0; j < 2; ++j) { const int col = j * 512 + lane * 8; float acc[8]; \
        _Pragma("unroll") for (int q = 0; q < 8; ++q) acc[q] = 0.f; \
        _Pragma("unroll") for (int b = 0; b < 3; ++b) { \
            _Pragma("unroll") for (int hw = 0; hw < 2; ++hw) { const int gwd = hw ? (int)G_[j][b].y : (int)G_[j][b].x, zwd = hw ? (int)Z_[j][b].y : (int)Z_[j][b].x; \
                const f32x2 g0 = __builtin_amdgcn_cvt_pk_f32_fp8(gwd, false), g1 = __builtin_amdgcn_cvt_pk_f32_fp8(gwd, true), z0 = __builtin_amdgcn_cvt_pk_f32_fp8(zwd, false), z1 = __builtin_amdgcn_cvt_pk_f32_fp8(zwd, true); \
                acc[4 * hw + 0] += sigmoidf_(g0.x * pg8::YS_INV) * z0.x; acc[4 * hw + 1] += sigmoidf_(g0.y * pg8::YS_INV) * z0.y; \
                acc[4 * hw + 2] += sigmoidf_(g1.x * pg8::YS_INV) * z1.x; acc[4 * hw + 3] += sigmoidf_(g1.y * pg8::YS_INV) * z1.y; } } \
        u32x2 o; o.x = pg8::pack_fp8x4(acc[0], acc[1], acc[2], acc[3]); o.y = pg8::pack_fp8x4(acc[4], acc[5], acc[6], acc[7]);     \
        *(u32x2*)(Y + (size_t)(row_) * 1024 + col) = o; } } while (0)
    u32x2 ga[2][3], za[2][3], gb[2][3], zb[2][3];
    int row = gw;
    if (row < nrows) GS_LOAD(ga, za, row);
    while (row < nrows) {
        const int r1 = row + NGW, r2 = r1 + NGW;
        if (r1 < nrows) GS_LOAD(gb, zb, r1);
        GS_COMP(ga, za, row);
        if (r1 < nrows) { if (r2 < nrows) GS_LOAD(ga, za, r2); GS_COMP(gb, zb, r1); }
        row = r2;
    }
#undef GS_LOAD
#undef GS_COMP
}
#undef PHG
#define PHG 3
__device__ __forceinline__ void phase_ln_mix(const Frame& F_, int l, int nrows) {
    Frame F = F_; asm volatile("" : "+s"(F.bid), "+s"(F.G), "+s"(F.wave)); F.lane = lane_id_(); asm volatile("" : "+v"(F.lane)); F.tid = F.wave * 64 + F.lane;
    const int gw = F.bid * NWAVES + F.wave, NGW = F.G * NWAVES, lane = F.lane;
    const unsigned char* YO = WSP(const unsigned char, WS_YOUT); bf16* X = WSP(bf16, WS_X); bf16* H = WSP(bf16, WS_H); unsigned char* H8 = WSP(unsigned char, WS_H8);
    const float* xin = KIN(I_X); const float* cin = KIN(I_CTX);
    const float* lnw = KIN(I_LNMW) + (size_t)l * D; const float* lnb = KIN(I_LNMB) + (size_t)l * D;
#define LM_LOAD(V_, Y_, row_) do { if (l == 0) row_load((row_) < T_LAT ? xin + (size_t)(row_) * D : cin + (size_t)((row_) - T_LAT) * D, lane, V_); \
        else { _Pragma("unroll") for (int j = 0; j < 4; ++j) { const u32x2 xw = *(const u32x2*)(X + (size_t)(row_) * D + 4 * lane + 256 * j); V_[j][0] = bflo(xw.x); V_[j][1] = bfhi(xw.x); V_[j][2] = bflo(xw.y); V_[j][3] = bfhi(xw.y); } } \
        _Pragma("unroll") for (int j = 0; j < 4; ++j) Y_[j] = *(const unsigned*)(YO + (size_t)(row_) * D + 4 * lane + 256 * j); } while (0)
#define LM_COMP(V_, Y_, row_) do { const float* mv = mod_vec(F, l, (row_)); \
        _Pragma("unroll") for (int j = 0; j < 4; ++j) { const f32x2 y0 = __builtin_amdgcn_cvt_pk_f32_fp8((int)Y_[j], false), y1 = __builtin_amdgcn_cvt_pk_f32_fp8((int)Y_[j], true); const f32x4 g1 = *(const f32x4*)(mv + 2048 + 4 * lane + 256 * j) * pg8::YS_INV; \
            V_[j][0] = DN_ALPHA * V_[j][0] + g1[0] * y0.x; V_[j][1] = DN_ALPHA * V_[j][1] + g1[1] * y0.y; V_[j][2] = DN_ALPHA * V_[j][2] + g1[2] * y1.x; V_[j][3] = DN_ALPHA * V_[j][3] + g1[3] * y1.y; } \
        row_ln(V_); row_affine(V_, lnw, lnb, lane, false); row_store_bf16(X + (size_t)(row_) * D, lane, V_); \
        row_ln(V_); row_affine(V_, mv + 4096, mv + 3072, lane, true); row_store_bf16(H + (size_t)(row_) * D, lane, V_); \
        _Pragma("unroll") for (int j = 0; j < 4; ++j) *(unsigned*)(H8 + (size_t)(row_) * D + 4 * lane + 256 * j) = pg8::pack_fp8x4(V_[j][0], V_[j][1], V_[j][2], V_[j][3]); } while (0)
    f32x4 va[4], vb[4]; unsigned ya[4], yb[4];
    int row = gw;
    if (row < nrows) LM_LOAD(va, ya, row);
    while (row < nrows) {
        const int r1 = row + NGW, r2 = r1 + NGW;
        if (r1 < nrows) LM_LOAD(vb, yb, r1);
        LM_COMP(va, ya, row);
        if (r1 < nrows) { if (r2 < nrows) LM_LOAD(va, ya, r2); LM_COMP(vb, yb, r1); }
        row = r2;
    }
#undef LM_LOAD
#undef LM_COMP
}
typedef __attribute__((ext_vector_type(4))) float facc;
__device__ __forceinline__ facc mma16(bf16x8 a, bf16x8 b, facc c) { return __builtin_amdgcn_mfma_f32_16x16x32_bf16(a, b, c, 0, 0, 0); }
__device__ __forceinline__ bf16x8 lds_gather8(const LAS bf16* p, int stride) {
    bf16x8 r;
#pragma unroll
    for (int j = 0; j < 8; ++j) r[j] = (short)p[j * stride];
    return r;
}
__device__ __forceinline__ bf16x8 pack8(const facc& a, const facc& b) {
    u32x4 w; w.x = pg8::cvt_pk_bf16(a[0], a[1]); w.y = pg8::cvt_pk_bf16(a[2], a[3]); w.z = pg8::cvt_pk_bf16(b[0], b[1]); w.w = pg8::cvt_pk_bf16(b[2], b[3]);
    return __builtin_bit_cast(bf16x8, w);
}
constexpr float LOG2E = 1.4426950408889634f;
typedef short bf16x4s __attribute__((ext_vector_type(4)));
__device__ __forceinline__ unsigned lds_addr_(const LAS void* p) { return (unsigned)(unsigned long long)(const LAS char*)p; }
__device__ __forceinline__ unsigned tr_lane_addr(const LAS bf16* tile  , int pitch, int lane) {
    const int g = lane >> 4, q = (lane & 15) >> 2, p = lane & 3; return lds_addr_(tile + (8 * g + q) * pitch + 4 * p); }
#define TR4(o, a0, a1, a2, a3, off4  ) do { bf16x4s l0_, h0_, l1_, h1_, l2_, h2_, l3_, h3_; \
    const unsigned b0_ = (a0) + (off4), b1_ = (a1) + (off4), b2_ = (a2) + (off4), b3_ = (a3) + (off4); \
    asm volatile("ds_read_b64_tr_b16 %0, %8\n\tds_read_b64_tr_b16 %1, %9\n\tds_read_b64_tr_b16 %2, %10\n\tds_read_b64_tr_b16 %3, %11\n\t" \
                 "ds_read_b64_tr_b16 %4, %12\n\tds_read_b64_tr_b16 %5, %13\n\tds_read_b64_tr_b16 %6, %14\n\tds_read_b64_tr_b16 %7, %15\n\ts_waitcnt lgkmcnt(0)" \
                 : "=&v"(l0_), "=&v"(h0_), "=&v"(l1_), "=&v"(h1_), "=&v"(l2_), "=&v"(h2_), "=&v"(l3_), "=&v"(h3_) \
                 : "v"(a0), "v"(b0_), "v"(a1), "v"(b1_), "v"(a2), "v"(b2_), "v"(a3), "v"(b3_) : "memory"); \
    __builtin_amdgcn_sched_barrier(0); \
    (o)[0] = __builtin_shufflevector(l0_, h0_, 0, 1, 2, 3, 4, 5, 6, 7); (o)[1] = __builtin_shufflevector(l1_, h1_, 0, 1, 2, 3, 4, 5, 6, 7); \
    (o)[2] = __builtin_shufflevector(l2_, h2_, 0, 1, 2, 3, 4, 5, 6, 7); (o)[3] = __builtin_shufflevector(l3_, h3_, 0, 1, 2, 3, 4, 5, 6, 7); } while (0)

constexpr int UT_P = 68;
template <bool OUT8  >
__device__ __forceinline__ void ut_tile(const Frame& F, const bf16* P, int colbase, int rowbase, int n0, int c0, bf16* UT, int ldn, LAS bf16* tl) {
    const int lane = F.lane;
#pragma unroll
    for (int i = 0; i < 8; ++i) { const int r = (lane >> 3) + 8 * i, pc = lane & 7;
        const u32x4 v = *(const u32x4*)(P + (size_t)(rowbase + n0 + r) * INW + colbase + c0 + pc * 8);
        LAS u32x2* d = (LAS u32x2*)(tl + r * UT_P + pc * 8); d[0] = (u32x2){v.x, v.y}; d[1] = (u32x2){v.z, v.w}; }
    LDS_WAIT(); asm volatile("" ::: "memory");
    const unsigned ta = tr_lane_addr(tl, UT_P, lane);
    const int fr = lane & 15, g = lane >> 4;
#pragma unroll
    for (int rb = 0; rb < 2; ++rb) {
        bf16x8 fv[4]; const unsigned a = ta + (unsigned)(32 * rb * UT_P * 2);
        TR4(fv, a, a + 32u, a + 64u, a + 96u, (unsigned)(4 * UT_P * 2));
#pragma unroll
        for (int cb = 0; cb < 4; ++cb) {
            if constexpr (OUT8) { const u32x4 w = __builtin_bit_cast(u32x4, fv[cb]);
                u32x2 o; o.x = pg8::pack_fp8x4(bflo(w.x), bfhi(w.x), bflo(w.y), bfhi(w.y)); o.y = pg8::pack_fp8x4(bflo(w.z), bfhi(w.z), bflo(w.w), bfhi(w.w));
                *(u32x2*)((unsigned char*)UT + (size_t)(c0 + 16 * cb + fr) * ldn + n0 + 32 * rb + 8 * g) = o; }
            else *(bf16x8*)(UT + (size_t)(c0 + 16 * cb + fr) * ldn + n0 + 32 * rb + 8 * g) = fv[cb]; } }
    LDS_WAIT(); asm volatile("" ::: "memory");
}
#undef PHG
#define PHG 4
__device__ __forceinline__ void phase_ut(const Frame& F_, int l) {
    Frame F = F_; asm volatile("" : "+s"(F.bid), "+s"(F.G), "+s"(F.wave)); F.lane = lane_id_(); asm volatile("" : "+v"(F.lane)); F.tid = F.wave * 64 + F.lane;
    const int gw = F.bid * NWAVES + F.wave, NGW = F.G * NWAVES;
    const bf16* P = WSP(const bf16, WS_P); LAS bf16* tl = (LAS bf16*)(F.lds + F.wave * 8704);
    const int ntl = NB * 64 * 8, ntc = (l == 0) ? NB * 4 * 8 : 0;
    for (int it = gw; it < ntl; it += NGW) { const int b = it / 512, r = it % 512; ut_tile<true>(F, P, C_UB, b * NSEQ, (r / 8) * 64, (r % 8) * 64, (bf16*)(WSP(unsigned char, WS_UT) + (size_t)b * 512 * 4096), 4096, tl); }
    for (int q = NGW - 1 - gw; q < ntc; q += NGW) { const int b = q / 32, r = q % 32; ut_tile<false>(F, P, C_UB, T_LAT + b * NCTX, (r / 8) * 64, (r % 8) * 64, WSP(bf16, WS_UTC) + (size_t)b * 512 * 256, 256, tl); }
    for (int it = gw; it < ntl; it += NGW) { const int b = it / 512, r = it % 512; ut_tile<false>(F, P, C_VA, b * NSEQ, (r / 8) * 64, (r % 8) * 64, WSP(bf16, WS_VT) + (size_t)b * 512 * 4096, 4096, tl); }
    for (int q = NGW - 1 - gw; q < NB * 4 * 8; q += NGW) { const int b = q / 32, r = q % 32; ut_tile<false>(F, P, C_VA, T_LAT + b * NCTX, (r / 8) * 64, (r % 8) * 64, WSP(bf16, WS_VTC) + (size_t)b * 512 * 256, 256, tl); }
}
#undef PHG
#define PHG 4
__device__ __forceinline__ void phase_nyquist(const Frame& F_) {
    Frame F = F_; asm volatile("" : "+s"(F.bid), "+s"(F.G), "+s"(F.wave)); F.lane = lane_id_(); asm volatile("" : "+v"(F.lane)); F.tid = F.wave * 64 + F.lane;
    const int gw = F.bid * NWAVES + F.wave, NGW = F.G * NWAVES, lane = F.lane;
    const unsigned char* UT = WSP(const unsigned char, WS_UT); unsigned char* FF = WSP(unsigned char, WS_FF);
    for (int it0 = gw; it0 < NB * 512; it0 += 2 * NGW) {
        u32x2 w[2][8];
#pragma unroll
        for (int u = 0; u < 2; ++u) { const int it = it0 + u * NGW; const unsigned char* row = UT + (size_t)(it < NB * 512 ? it : it0) * 4096;
#pragma unroll
            for (int k = 0; k < 8; ++k) w[u][k] = *(const u32x2*)(row + k * 512 + lane * 8); }
#pragma unroll
        for (int u = 0; u < 2; ++u) { const int it = it0 + u * NGW; const int b = it >> 9, ch = it & 511; float acc = 0.f;
#pragma unroll
            for (int k = 0; k < 8; ++k) { const f32x2 a0 = __builtin_amdgcn_cvt_pk_f32_fp8((int)w[u][k].x, false), a1 = __builtin_amdgcn_cvt_pk_f32_fp8((int)w[u][k].x, true), a2 = __builtin_amdgcn_cvt_pk_f32_fp8((int)w[u][k].y, false), a3 = __builtin_amdgcn_cvt_pk_f32_fp8((int)w[u][k].y, true);
                acc += (a0.x - a0.y) + (a1.x - a1.y) + (a2.x - a2.y) + (a3.x - a3.y); }
            acc = wave_sum(acc);
            if (lane == 0 && it < NB * 512) { FF[(size_t)(b * NSEQ + NSEQ / 2) * 1024 + ch] = (unsigned char)(pg8::pack_fp8x4(acc * (pg8::YS_SCALE / 724.0773439350247f), 0.f, 0.f, 0.f) & 0xffu); FF[(size_t)(b * NSEQ + NSEQ / 2) * 1024 + 512 + ch] = (unsigned char)0; } }
    }
}

constexpr int NA_RPB_OFF = 0, NA_CK_OFF = 2048, NA_CK_P = 80, NA_CV_OFF = NA_CK_OFF + 256 * NA_CK_P * 2, NA_CV_P = 264;
template <bool WIN, bool CLDS  >
__device__ __forceinline__ void na_chunk(const Frame& F, const char* kb  , const char* vb  , int vpitch  ,
                                         const bf16x8 (&qf)[2], int kc0, int qrow_minus_r0, int qc, float& m, float& lsum, facc (&o)[4]) {
    const int lane = F.lane, fr = lane & 15, g = lane >> 4;
    const LAS float* rpb = (const LAS float*)(F.lds + NA_RPB_OFF);
    int dci[2][4]; unsigned okm = 0u;
    if (WIN) { const int c0 = qc - 8 < 0 ? 0 : (qc - 8 > 48 ? 48 : qc - 8);
#pragma unroll
        for (int tt = 0; tt < 2; ++tt)
#pragma unroll
            for (int r = 0; r < 4; ++r) { const int kc = kc0 + 8 * g + 4 * tt + r; int dc = kc - qc; dc = dc < -15 ? -15 : (dc > 15 ? 15 : dc); dci[tt][r] = dc + 15;
                okm |= (kc >= c0 && kc < c0 + 16) ? (1u << (tt * 4 + r)) : 0u; } }
    const unsigned koff0 = (unsigned)((8 * (fr >> 2) + (fr & 3)) * INW + 8 * g) * 2u, koff1 = koff0 + 4u * INW * 2u;
    const unsigned voff = (unsigned)(fr * vpitch + 8 * g) * 2u;
    facc s[16];
    constexpr int KD = 2;
    bf16x8 kf[KD][4];
    const LAS bf16* ckl = (const LAS bf16*)(F.lds + NA_CK_OFF) + (8 * (fr >> 2) + (fr & 3)) * NA_CK_P + 8 * g;
    const LAS bf16* cvl = (const LAS bf16*)(F.lds + NA_CV_OFF) + fr * NA_CV_P + 8 * g;
#define NA_KLOAD(slot, i) do { if constexpr (CLDS) { const LAS bf16* kl_ = ckl + 32 * (i) * NA_CK_P; \
            kf[slot][0] = *(const LAS bf16x8*)kl_; kf[slot][1] = *(const LAS bf16x8*)(kl_ + 32); kf[slot][2] = *(const LAS bf16x8*)(kl_ + 4 * NA_CK_P); kf[slot][3] = *(const LAS bf16x8*)(kl_ + 4 * NA_CK_P + 32); } \
        else { const char* kp_ = WIN ? kb + (size_t)((i) * 64) * INW * 2 : kb + (size_t)(32 * (i)) * INW * 2; \
        kf[slot][0] = *(const bf16x8*)(kp_ + koff0); kf[slot][1] = *(const bf16x8*)(kp_ + koff0 + 64); kf[slot][2] = *(const bf16x8*)(kp_ + koff1); kf[slot][3] = *(const bf16x8*)(kp_ + koff1 + 64); } } while (0)
#pragma unroll
    for (int i = 0; i < KD; ++i) NA_KLOAD(i, i);
#pragma unroll
    for (int i = 0; i < 8; ++i) {
        facc a = {0.f, 0.f, 0.f, 0.f}, c = {0.f, 0.f, 0.f, 0.f};
        a = mma16(kf[i % KD][0], qf[0], a); a = mma16(kf[i % KD][1], qf[1], a); c = mma16(kf[i % KD][2], qf[0], c); c = mma16(kf[i % KD][3], qf[1], c);
        if (i + KD < 8) NA_KLOAD(i % KD, i + KD);
        if (WIN) {
            const int rb = (i - qrow_minus_r0 + 7) * 31;
#pragma unroll
            for (int r = 0; r < 4; ++r) { const float b0 = rpb[rb + dci[0][r]], b1 = rpb[rb + dci[1][r]];
                a[r] = ((okm >> r) & 1u) ? a[r] * 0.125f + b0 : -1e30f; c[r] = ((okm >> (4 + r)) & 1u) ? c[r] * 0.125f + b1 : -1e30f; }
        } else {
#pragma unroll
            for (int r = 0; r < 4; ++r) { a[r] *= 0.125f; c[r] *= 0.125f; }
        }
        s[2 * i] = a; s[2 * i + 1] = c;
        __builtin_amdgcn_sched_barrier(0);
    }
#undef NA_KLOAD
    constexpr int VD = 2;
    bf16x8 vf[VD][4];
#define NA_VLOAD(slot, i) do { if constexpr (CLDS) { _Pragma("unroll") for (int dt_ = 0; dt_ < 4; ++dt_) vf[slot][dt_] = *(const LAS bf16x8*)(cvl + 16 * dt_ * NA_CV_P + 32 * (i)); } \
        else { const char* vp_ = WIN ? vb + (size_t)((i) * 64) * 2 : vb + (size_t)(32 * (i)) * 2; \
        _Pragma("unroll") for (int dt_ = 0; dt_ < 4; ++dt_) vf[slot][dt_] = *(const bf16x8*)(vp_ + (size_t)(16 * dt_ * vpitch) * 2 + voff); } } while (0)
#pragma unroll
    for (int i = 0; i < VD; ++i) NA_VLOAD(i, i);
    float mx = -1e30f;
#pragma unroll
    for (int t = 0; t < 16; ++t) mx = fmaxf(mx, fmaxf(fmaxf(s[t][0], s[t][1]), fmaxf(s[t][2], s[t][3])));
    mx = fmaxf(mx, __shfl_xor(mx, 16)); mx = fmaxf(mx, __shfl_xor(mx, 32));
    const float mn = fmaxf(m, mx), alpha = __builtin_amdgcn_exp2f((m - mn) * LOG2E);
    m = mn; lsum *= alpha;
#pragma unroll
    for (int dt = 0; dt < 4; ++dt) o[dt] = o[dt] * alpha;
#pragma unroll
    for (int t = 0; t < 16; ++t) {
#pragma unroll
        for (int r = 0; r < 4; ++r) { const float p = __builtin_amdgcn_exp2f((s[t][r] - mn) * LOG2E); s[t][r] = p; lsum += p; }
    }
    __builtin_amdgcn_sched_barrier(0);
#pragma unroll
    for (int i = 0; i < 8; ++i) {
        const bf16x8 pb = pack8(s[2 * i], s[2 * i + 1]);
#pragma unroll
        for (int dt = 0; dt < 4; ++dt) o[dt] = mma16(vf[i % VD][dt], pb, o[dt]);
        if (i + VD < 8) NA_VLOAD(i % VD, i + VD);
        __builtin_amdgcn_sched_barrier(0);
    }
#undef NA_VLOAD
}
template <bool CTX>
__device__ __forceinline__ void na_wave(const Frame& F, const bf16* P, bf16* YNA, int b, int h, int tq  , int r0  , int kc0, int qrow_minus_r0, int qc) {
    const int lane = F.lane, g = lane >> 4;
    bf16x8 qf[2];
#pragma unroll
    for (int ks = 0; ks < 2; ++ks) qf[ks] = *(const bf16x8*)(P + (size_t)tq * INW + C_QA + h * 64 + ks * 32 + 8 * g);
    float m = -1e30f, lsum = 0.f; facc o[4];
#pragma unroll
    for (int dt = 0; dt < 4; ++dt) o[dt] = (facc){0.f, 0.f, 0.f, 0.f};
    const int ctxrow0 = T_LAT + b * NCTX;
    SUBRESET();
    if (!CTX) na_chunk<true, false>(F, (const char*)P + ((size_t)(b * NSEQ + r0 * 64 + kc0) * INW + C_KA + h * 64) * 2,
                             (const char*)(WSP(const bf16, WS_VT) + ((size_t)(b * 8 + h) * 64) * 4096 + r0 * 64 + kc0), 4096, qf, kc0, qrow_minus_r0, qc, m, lsum, o);
    SUBSTAMP(13);
    if (!CTX) na_chunk<false, true>(F, nullptr, nullptr, 256, qf, 0, 0, 0, m, lsum, o);
    else na_chunk<false, false>(F, (const char*)P + ((size_t)ctxrow0 * INW + C_KA + h * 64) * 2, (const char*)(WSP(const bf16, WS_VTC) + ((size_t)(b * 8 + h) * 64) * 256), 256, qf, 0, 0, 0, m, lsum, o);
    lsum += __shfl_xor(lsum, 16); lsum += __shfl_xor(lsum, 32);
    const float inv = pg8::YS_SCALE / lsum;
#pragma unroll
    for (int dt = 0; dt < 4; ++dt)
        *(unsigned*)((unsigned char*)YNA + (size_t)tq * 512 + h * 64 + 16 * dt + 4 * g) = pg8::pack_fp8x4(o[dt][0] * inv, o[dt][1] * inv, o[dt][2] * inv, o[dt][3] * inv);
    SUBSTAMP(14);
}
#undef PHG
#define PHG 5
__device__ __forceinline__ void phase_na(const Frame& F_, int l) {
    const bf16* P = (const bf16*)(ws_opaque(F_.ws) + WS_P); bf16* YNA = (bf16*)(ws_opaque(F_.ws) + WS_YNA);
    const int nlat = NB * 8 * 32, nctx = (l == 0) ? NB * 8 * 2 : 0;
    LAS float* rpb = (LAS float*)(F_.lds + NA_RPB_OFF);
    const int per = (nlat + F_.G - 1) / F_.G, u0 = F_.bid * per, u1 = (u0 + per < nlat) ? u0 + per : nlat;
    int bhcur = -1;
    for (int u = u0; u < u1; ++u) {
        Frame F = F_; asm volatile("" : "+s"(F.bid), "+s"(F.G), "+s"(F.wave)); F.lane = lane_id_(); asm volatile("" : "+v"(F.lane)); F.tid = F.wave * 64 + F.lane;
        const int b = u / 256, h = (u % 256) / 32, rp = u % 32;
        if (b * 8 + h != bhcur) {
            __syncthreads();
            for (int i = F.tid; i < 15 * 31; i += 512) rpb[i] = KIN(I_RPB)[((size_t)l * 8 + h) * 465 + i];
            {   int tq = F.tid; asm volatile("" : "+v"(tq));
                u32x4 kv[4];
#pragma unroll
                for (int k = 0; k < 4; ++k) { const int q = tq + 512 * k; kv[k] = *(const u32x4*)(P + (size_t)(T_LAT + b * NCTX + (q >> 3)) * INW + C_KA + h * 64 + (q & 7) * 8); }
#pragma unroll
                for (int k = 0; k < 4; ++k) { const int q = tq + 512 * k; *(LAS u32x4*)((LAS bf16*)(F.lds + NA_CK_OFF) + (q >> 3) * NA_CK_P + (q & 7) * 8) = kv[k]; } }
            {   int tq = F.tid; asm volatile("" : "+v"(tq));
                u32x4 vv[4];
#pragma unroll
                for (int k = 0; k < 4; ++k) { const int q = tq + 512 * k; vv[k] = *(const u32x4*)(WSP(const bf16, WS_VTC) + ((size_t)(b * 8 + h) * 64 + (q >> 5)) * 256 + (q & 31) * 8); }
#pragma unroll
                for (int k = 0; k < 4; ++k) { const int q = tq + 512 * k; *(LAS u32x4*)((LAS bf16*)(F.lds + NA_CV_OFF) + (q >> 5) * NA_CV_P + (q & 31) * 8) = vv[k]; } }
            __syncthreads(); bhcur = b * 8 + h;
        }
        const int qrow = 2 * rp + (F.wave >> 2), j = F.wave & 3;
        const int r0 = qrow - 4 < 0 ? 0 : (qrow - 4 > 56 ? 56 : qrow - 4);
        const int kc0 = (j == 0) ? 0 : (j == 1 ? 8 : (j == 2 ? 24 : 32));
        const int qc = 16 * j + (F.lane & 15);
        na_wave<false>(F, P, YNA, b, h, b * NSEQ + qrow * 64 + qc, r0, kc0, qrow - r0, qc);
    }
    for (int q = F_.bid; q < nctx; q += F_.G) {
        Frame F = F_; asm volatile("" : "+s"(F.bid), "+s"(F.G), "+s"(F.wave)); F.lane = lane_id_(); asm volatile("" : "+v"(F.lane)); F.tid = F.wave * 64 + F.lane;
        const int b = q / 16, h = (q % 16) / 2, qt = (q % 2) * 8 + F.wave;
        na_wave<true>(F, P, YNA, b, h, T_LAT + b * NCTX + qt * 16 + (F.lane & 15), 0, 0, 0, 0);
    }
    __syncthreads();
}

constexpr int R_KP = 136, R_VP = 264;
constexpr int R_OFF_A = 0, R_OFF_B = 128 * R_KP * 2, R_OFF_V = 2 * 128 * R_KP * 2, R_OFF_RED = R_OFF_V + 128 * R_VP * 2, R_OFF_ST = R_OFF_RED + 8192;
__device__ __forceinline__ float log_sigmoidf_(float x) { return -log1pf(__expf(-x)); }
__device__ __forceinline__ int chunk_row0(int b, int ch) { return ch < 32 ? b * NSEQ + ch * 128 : T_LAT + b * NCTX + (ch - 32) * 128; }
__device__ __forceinline__ void ret_stage_qk(const Frame& F, const bf16* P, int row0, int col0, int ch, LAS bf16* out0, LAS bf16* out1, float lg0, float lg1, int mode  , float scale) {
    const float* rc = WSP(const float, WS_ROPE); const float* rs = rc + 2048;
    u32x4 a[2], bq[2]; f32x4 cs[2][2], sn[2][2];
#pragma unroll
    for (int it = 0; it < 2; ++it) { const int i = F.tid + 512 * it, m = i >> 3, pp = i & 7, d0 = (pp & 3) * 8 + (pp >> 2) * 64;
        a[it] = *(const u32x4*)(P + (size_t)(row0 + m) * INW + col0 + d0); bq[it] = *(const u32x4*)(P + (size_t)(row0 + m) * INW + col0 + d0 + 32);
        if (ch < 32) { const int n = ch * 128 + m, pos = (pp >> 2) ? (n & 63) : (n >> 6), fi = pos * 32 + (pp & 3) * 8;
            cs[it][0] = *(const f32x4*)(rc + fi); cs[it][1] = *(const f32x4*)(rc + fi + 4); sn[it][0] = *(const f32x4*)(rs + fi); sn[it][1] = *(const f32x4*)(rs + fi + 4); } }
#pragma unroll
    for (int it = 0; it < 2; ++it) { const int i = F.tid + 512 * it, m = i >> 3, pp = i & 7, d0 = (pp & 3) * 8 + (pp >> 2) * 64;
        float x1[8], x2[8];
        x1[0] = bflo(a[it].x); x1[1] = bfhi(a[it].x); x1[2] = bflo(a[it].y); x1[3] = bfhi(a[it].y); x1[4] = bflo(a[it].z); x1[5] = bfhi(a[it].z); x1[6] = bflo(a[it].w); x1[7] = bfhi(a[it].w);
        x2[0] = bflo(bq[it].x); x2[1] = bfhi(bq[it].x); x2[2] = bflo(bq[it].y); x2[3] = bfhi(bq[it].y); x2[4] = bflo(bq[it].z); x2[5] = bfhi(bq[it].z); x2[6] = bflo(bq[it].w); x2[7] = bfhi(bq[it].w);
        if (ch < 32) {
#pragma unroll
            for (int e = 0; e < 8; ++e) { const float c = cs[it][e >> 2][e & 3], sv = sn[it][e >> 2][e & 3], y1 = x1[e] * c - x2[e] * sv, y2 = x1[e] * sv + x2[e] * c; x1[e] = y1; x2[e] = y2; }
        }
        float w0 = scale, w1 = scale;
        if (mode == 1) { w0 = __expf(lg0 * (float)(127 - m)); w1 = __expf(lg1 * (float)m); }
        {
            LAS unsigned* p1 = (LAS unsigned*)(out0 + m * R_KP + d0); LAS unsigned* p2 = (LAS unsigned*)(out0 + m * R_KP + d0 + 32);
#pragma unroll
            for (int e = 0; e < 4; ++e) { p1[e] = pk2(x1[2 * e] * w0, x1[2 * e + 1] * w0); p2[e] = pk2(x2[2 * e] * w0, x2[2 * e + 1] * w0); }
        }
        if (out1) {
            LAS unsigned* p1 = (LAS unsigned*)(out1 + m * R_KP + d0); LAS unsigned* p2 = (LAS unsigned*)(out1 + m * R_KP + d0 + 32);
#pragma unroll
            for (int e = 0; e < 4; ++e) { p1[e] = pk2(x1[2 * e] * w1, x1[2 * e + 1] * w1); p2[e] = pk2(x2[2 * e] * w1, x2[2 * e + 1] * w1); }
        }
    }
}
__device__ __forceinline__ void ret_stage_v(const Frame& F, const bf16* P, int row0, int col0) {
    LAS bf16* Vl = (LAS bf16*)(F.lds + R_OFF_V);
    u32x4 v[8];
#pragma unroll
    for (int k = 0; k < 8; ++k) { const int i = F.tid + 512 * k, m = i >> 5, pc = i & 31; v[k] = *(const u32x4*)(P + (size_t)(row0 + m) * INW + col0 + pc * 8); }
#pragma unroll
    for (int k = 0; k < 8; ++k) { const int i = F.tid + 512 * k, m = i >> 5, pc = i & 31;
        LAS unsigned* d = (LAS unsigned*)(Vl + m * R_VP + pc * 8); d[0] = v[k].x; d[1] = v[k].y; d[2] = v[k].z; d[3] = v[k].w; }
}
#undef PHG
#define PHG 6
__device__ __forceinline__ void phase_r1(const Frame& F_, int l) {
    Frame F = F_; asm volatile("" : "+s"(F.bid), "+s"(F.G), "+s"(F.wave)); F.lane = lane_id_(); asm volatile("" : "+v"(F.lane)); F.tid = F.wave * 64 + F.lane;
    const bf16* P = WSP(const bf16, WS_P); bf16* KV = WSP(bf16, WS_KV);
    const int lane = F.lane, fr0 = lane & 15, g0 = lane >> 4;
    for (int u = F.bid; u < NB * 4 * NCH; u += F.G) {
        const int b = u / (4 * NCH), h = (u / NCH) % 4, ch = u % NCH, row0 = chunk_row0(b, ch);
        const float lgf = log_sigmoidf_(KIN(I_DECF)[l * 4 + h]), lgb = log_sigmoidf_(KIN(I_DECB)[l * 4 + h]);
        int fr = fr0, g = g0; asm volatile("" : "+v"(fr), "+v"(g));
        Frame Fu = F; asm volatile("" : "+v"(Fu.tid));
        __syncthreads();
        SUBRESET();
        ret_stage_qk(Fu, P, row0, C_KR + h * 128, ch, (LAS bf16*)(F.lds + R_OFF_A), (LAS bf16*)(F.lds + R_OFF_B), lgf, lgb, 1, 1.f);
        ret_stage_v(Fu, P, row0, C_VR + h * 256);
        __syncthreads();
        SUBSTAMP(5);
        const int dir = F.wave >> 2, eq = F.wave & 3;
        const LAS bf16* Kl = (const LAS bf16*)(F.lds + (dir ? R_OFF_B : R_OFF_A)); const LAS bf16* Vl = (const LAS bf16*)(F.lds + R_OFF_V);
        facc acc[4][8];
#pragma unroll
        for (int et = 0; et < 4; ++et)
#pragma unroll
            for (int dt = 0; dt < 8; ++dt) acc[et][dt] = (facc){0.f, 0.f, 0.f, 0.f};
        const unsigned vta = tr_lane_addr(Vl + 64 * eq, R_VP, lane), kta = tr_lane_addr(Kl, R_KP, lane);
#pragma unroll 1
        for (int ks = 0; ks < 4; ++ks) {
            bf16x8 va[4], kb0[4], kb1[4];
            const unsigned vk = vta + (unsigned)(32 * ks * R_VP * 2), kk = kta + (unsigned)(32 * ks * R_KP * 2);
            TR4(va, vk, vk + 32u, vk + 64u, vk + 96u, (unsigned)(4 * R_VP * 2));
            TR4(kb0, kk, kk + 32u, kk + 64u, kk + 96u, (unsigned)(4 * R_KP * 2));
            TR4(kb1, kk + 128u, kk + 160u, kk + 192u, kk + 224u, (unsigned)(4 * R_KP * 2));
#pragma unroll
            for (int dt = 0; dt < 8; ++dt) {
#pragma unroll
                for (int et = 0; et < 4; ++et) acc[et][dt] = mma16(dt < 4 ? kb0[dt & 3] : kb1[dt & 3], va[et], acc[et][dt]);
            }
        }
        SUBSTAMP(6);
        bf16* out = KV + ((((size_t)(b * 4 + h) * NCH + ch) * 2 + dir) << 15);
#pragma unroll
        for (int et = 0; et < 4; ++et)
#pragma unroll
            for (int dt = 0; dt < 8; ++dt) { u32x2 w; w.x = pk2(acc[et][dt][0], acc[et][dt][1]); w.y = pk2(acc[et][dt][2], acc[et][dt][3]);
                *(u32x2*)(out + (size_t)(64 * eq + 16 * et + fr) * 128 + 16 * dt + 4 * g) = w; }
        SUBSTAMP(7);
    }
    __syncthreads();
}
#undef PHG
#define PHG 7
__device__ __forceinline__ void phase_r2(const Frame& F_, int l) {
    Frame F = F_; asm volatile("" : "+s"(F.bid), "+s"(F.G), "+s"(F.wave)); F.lane = lane_id_(); asm volatile("" : "+v"(F.lane)); F.tid = F.wave * 64 + F.lane;
    const bf16* KV = WSP(const bf16, WS_KV); bf16* SP = WSP(bf16, WS_SPREV);
    for (int id = F.bid * 512 + F.tid; id < 64 * 4096; id += F.G * 512) {
        const int comb = id >> 12, el = (id & 4095) * 8, bh = comb >> 1, dir = comb & 1, h = bh & 3;
        const float lg = log_sigmoidf_(dir ? KIN(I_DECB)[l * 4 + h] : KIN(I_DECF)[l * 4 + h]), gC = __expf(lg * 128.f);
        float S[8];
#pragma unroll
        for (int j = 0; j < 8; ++j) S[j] = 0.f;
#pragma unroll 1
        for (int s0 = 0; s0 < NCH; s0 += 8) {
            u32x4 kv[8];
#pragma unroll
            for (int q = 0; q < 8; ++q) { const int s = s0 + q;
                if (s < NCH) { const int ch = dir == 0 ? (s < 2 ? 32 + s : s - 2) : (s < 2 ? 33 - s : 33 - s);
                    kv[q] = *(const u32x4*)(KV + ((((size_t)bh * NCH + ch) * 2 + dir) << 15) + el); } }
#pragma unroll
            for (int q = 0; q < 8; ++q) { const int s = s0 + q;
                if (s < NCH) { const int ch = dir == 0 ? (s < 2 ? 32 + s : s - 2) : (s < 2 ? 33 - s : 33 - s);
                    u32x4 w; w.x = pk2(S[0], S[1]); w.y = pk2(S[2], S[3]); w.z = pk2(S[4], S[5]); w.w = pk2(S[6], S[7]);
                    *(u32x4*)(SP + ((((size_t)bh * NCH + ch) * 2 + dir) << 15) + el) = w;
                    S[0] = gC * S[0] + bflo(kv[q].x); S[1] = gC * S[1] + bfhi(kv[q].x); S[2] = gC * S[2] + bflo(kv[q].y); S[3] = gC * S[3] + bfhi(kv[q].y);
                    S[4] = gC * S[4] + bflo(kv[q].z); S[5] = gC * S[5] + bfhi(kv[q].z); S[6] = gC * S[6] + bflo(kv[q].w); S[7] = gC * S[7] + bfhi(kv[q].w); } }
        }
    }
}
#undef PHG
#define PHG 8
__device__ __forceinline__ void phase_r3(const Frame& F_, int l) {
    Frame F = F_; asm volatile("" : "+s"(F.bid), "+s"(F.G), "+s"(F.wave)); F.lane = lane_id_(); asm volatile("" : "+v"(F.lane)); F.tid = F.wave * 64 + F.lane;
    const bf16* P = WSP(const bf16, WS_P); const bf16* SP = WSP(const bf16, WS_SPREV); bf16* YR = WSP(bf16, WS_YRET);
    const int lane = F.lane, fr0 = lane & 15, g0 = lane >> 4, w = F.wave;
    const int nch = (l == 0) ? NCH : 32;
    LAS bf16* Ql = (LAS bf16*)(F.lds + R_OFF_A); LAS bf16* Kl = (LAS bf16*)(F.lds + R_OFF_B); const LAS bf16* Vl = (const LAS bf16*)(F.lds + R_OFF_V);
    LAS float* red = (LAS float*)(F.lds + R_OFF_RED); LAS float* stt = (LAS float*)(F.lds + R_OFF_ST);
    for (int u = F.bid; u < NB * 4 * nch; u += F.G) {
        const int b = u / (4 * nch), h = (u / nch) % 4, ch = u % nch, row0 = chunk_row0(b, ch);
        const float lgf = log_sigmoidf_(KIN(I_DECF)[l * 4 + h]), lgb = log_sigmoidf_(KIN(I_DECB)[l * 4 + h]);
        int fr = fr0, g = g0; asm volatile("" : "+v"(fr), "+v"(g));
        Frame Fu = F; asm volatile("" : "+v"(Fu.tid));
        __syncthreads();
        SUBRESET();
        ret_stage_qk(Fu, P, row0, C_QR + h * 128, ch, Ql, nullptr, 0.f, 0.f, 0, 0.08838834764831845f);
        ret_stage_qk(Fu, P, row0, C_KR + h * 128, ch, Kl, nullptr, 0.f, 0.f, 0, 1.f);
        ret_stage_v(Fu, P, row0, C_VR + h * 256);
        __syncthreads();
        SUBSTAMP(0);
        facc st[8];
#pragma unroll
        for (int mt = 0; mt < 8; ++mt) st[mt] = (facc){0.f, 0.f, 0.f, 0.f};
#pragma unroll
        for (int ks = 0; ks < 4; ++ks) {
            const bf16x8 qb = *(const LAS bf16x8*)(Ql + (16 * w + fr) * R_KP + 32 * ks + 8 * g);
#pragma unroll
            for (int mt = 0; mt < 8; ++mt) { const bf16x8 ka = *(const LAS bf16x8*)(Kl + (16 * mt + fr) * R_KP + 32 * ks + 8 * g); st[mt] = mma16(ka, qb, st[mt]); }
        }
        __syncthreads();
        {
            const int c = 16 * w + fr;
#pragma unroll
            for (int mt = 0; mt < 8; ++mt) { float v[4];
#pragma unroll
                for (int r = 0; r < 4; ++r) { const int m = 16 * mt + 4 * g + r; const float dcy = (c >= m) ? __expf(lgf * (float)(c - m)) : __expf(lgb * (float)(m - c)); v[r] = st[mt][r] * dcy; }
                u32x2 pw; pw.x = pk2(v[0], v[1]); pw.y = pk2(v[2], v[3]);
                *(LAS u32x2*)(Kl + c * R_KP + 16 * mt + 4 * g) = pw; }
        }
        __syncthreads();
        SUBSTAMP(1);
        facc acc[2][8];
#pragma unroll
        for (int et = 0; et < 2; ++et)
#pragma unroll
            for (int ct = 0; ct < 8; ++ct) acc[et][ct] = (facc){0.f, 0.f, 0.f, 0.f};
#pragma unroll 1
        for (int ks = 0; ks < 4; ++ks) {
            bf16x8 va[4];
            { const unsigned a = tr_lane_addr(Vl + 32 * w, R_VP, lane) + (unsigned)(32 * ks * R_VP * 2); TR4(va, a, a + 32u, a, a + 32u, (unsigned)(4 * R_VP * 2)); }
#pragma unroll
            for (int ct = 0; ct < 8; ++ct) { const bf16x8 pb = *(const LAS bf16x8*)(Kl + (16 * ct + fr) * R_KP + 32 * ks + 8 * g);
#pragma unroll
                for (int et = 0; et < 2; ++et) acc[et][ct] = mma16(va[et], pb, acc[et][ct]); }
            __builtin_amdgcn_sched_barrier(0);
        }
        SUBSTAMP(2);
        {
            const bf16* sp0 = SP + ((((size_t)(b * 4 + h) * NCH + ch) * 2 + 0) << 15); const bf16* sp1 = sp0 + 32768;
#pragma unroll
            for (int dir = 0; dir < 2; ++dir) {
                const bf16* sp = dir == 0 ? sp0 : sp1; bf16x8 sa[4][2];
#pragma unroll
                for (int ks = 0; ks < 4; ++ks)
#pragma unroll
                    for (int et = 0; et < 2; ++et) sa[ks][et] = *(const bf16x8*)(sp + (size_t)(32 * w + 16 * et + fr) * 128 + 32 * ks + 8 * g);
#pragma unroll
                for (int hf = 0; hf < 2; ++hf) {
                    facc X[2][4];
#pragma unroll
                    for (int et = 0; et < 2; ++et)
#pragma unroll
                        for (int cq = 0; cq < 4; ++cq) X[et][cq] = (facc){0.f, 0.f, 0.f, 0.f};
#pragma unroll
                    for (int ks = 0; ks < 4; ++ks) {
#pragma unroll
                        for (int cq = 0; cq < 4; ++cq) { const int ct = 4 * hf + cq; const bf16x8 qb = *(const LAS bf16x8*)(Ql + (16 * ct + fr) * R_KP + 32 * ks + 8 * g);
#pragma unroll
                            for (int et = 0; et < 2; ++et) X[et][cq] = mma16(sa[ks][et], qb, X[et][cq]); }
                        __builtin_amdgcn_sched_barrier(0);
                    }
#pragma unroll
                    for (int cq = 0; cq < 4; ++cq) { const int ct = 4 * hf + cq, c = 16 * ct + fr; const float dq = dir == 0 ? __expf(lgf * (float)(c + 1)) : __expf(lgb * (float)(128 - c));
#pragma unroll
                        for (int et = 0; et < 2; ++et) acc[et][ct] += X[et][cq] * dq; }
                }
            }
        }
        SUBSTAMP(3);
        unsigned gtv[2][8];
        { const unsigned char* GR8 = WSP(const unsigned char, WS_GR8);
#pragma unroll
        for (int et = 0; et < 2; ++et)
#pragma unroll
            for (int ct = 0; ct < 8; ++ct) gtv[et][ct] = *(const unsigned*)(GR8 + (size_t)(row0 + 16 * ct + fr) * 1024 + h * 256 + 32 * w + 16 * et + 4 * g); }
#pragma unroll
        for (int ct = 0; ct < 8; ++ct) { float s = 0.f, ss = 0.f;
#pragma unroll
            for (int et = 0; et < 2; ++et)
#pragma unroll
                for (int r = 0; r < 4; ++r) { const float v = acc[et][ct][r]; s += v; ss += v * v; }
            s += __shfl_xor(s, 16); s += __shfl_xor(s, 32); ss += __shfl_xor(ss, 16); ss += __shfl_xor(ss, 32);
            if (g == 0) { red[(w * 128 + 16 * ct + fr) * 2] = s; red[(w * 128 + 16 * ct + fr) * 2 + 1] = ss; } }
        __syncthreads();
        if (F.tid < 128) { float s = 0.f, ss = 0.f;
#pragma unroll
            for (int q = 0; q < 8; ++q) { s += red[(q * 128 + F.tid) * 2]; ss += red[(q * 128 + F.tid) * 2 + 1]; }
            const float mean = s * (1.f / 256.f), var = fmaxf(ss * (1.f / 256.f) - mean * mean, 0.f);
            stt[F.tid * 2] = mean; stt[F.tid * 2 + 1] = 1.f / sqrtf(var + GN_EPS); }
        __syncthreads();
        const float* gnw = KIN(I_GNW) + (size_t)l * 1024 + h * 256;
#pragma unroll
        for (int et = 0; et < 2; ++et) { const int e = 32 * w + 16 * et + 4 * g; const f32x4 gw4 = *(const f32x4*)(gnw + e);
#pragma unroll
            for (int ct = 0; ct < 8; ++ct) { const int c = 16 * ct + fr; const float mean = stt[c * 2], rstd = stt[c * 2 + 1];
                const size_t tok = (size_t)(row0 + c);
                const f32x2 ga_ = __builtin_amdgcn_cvt_pk_f32_fp8((int)gtv[et][ct], false), gb_ = __builtin_amdgcn_cvt_pk_f32_fp8((int)gtv[et][ct], true);
                const float g0 = ga_.x * pg8::YS_INV, g1 = ga_.y * pg8::YS_INV, g2 = gb_.x * pg8::YS_INV, g3 = gb_.y * pg8::YS_INV;
                const float y0 = (acc[et][ct][0] - mean) * rstd * gw4[0] * siluf_(g0), y1 = (acc[et][ct][1] - mean) * rstd * gw4[1] * siluf_(g1);
                const float y2 = (acc[et][ct][2] - mean) * rstd * gw4[2] * siluf_(g2), y3 = (acc[et][ct][3] - mean) * rstd * gw4[3] * siluf_(g3);
                *(unsigned*)((unsigned char*)YR + tok * 1024 + h * 256 + e) = pg8::pack_fp8x4(y0 * pg8::YS_SCALE, y1 * pg8::YS_SCALE, y2 * pg8::YS_SCALE, y3 * pg8::YS_SCALE); } }
        SUBSTAMP(4);
    }
    __syncthreads();
}
__device__ __forceinline__ float wave_max_dpp(float v) {
#define DPPF(x, ctrl) __builtin_bit_cast(float, __builtin_amdgcn_update_dpp(0, __builtin_bit_cast(int, (x)), (ctrl), 0xF, 0xF, true))
    v = fmaxf(v, DPPF(v, 0xB1)); v = fmaxf(v, DPPF(v, 0x4E)); v = fmaxf(v, DPPF(v, 0x141)); v = fmaxf(v, DPPF(v, 0x140));
#undef DPPF
    const int x = __builtin_bit_cast(int, v);
    const float r0 = __builtin_bit_cast(float, __builtin_amdgcn_readlane(x, 0)), r1 = __builtin_bit_cast(float, __builtin_amdgcn_readlane(x, 16));
    const float r2 = __builtin_bit_cast(float, __builtin_amdgcn_readlane(x, 32)), r3 = __builtin_bit_cast(float, __builtin_amdgcn_readlane(x, 48));
    return fmaxf(fmaxf(r0, r1), fmaxf(r2, r3));
}
#undef PHG
#define PHG 9
__device__ __forceinline__ void phase_topk(const Frame& F_, int l, int Tm) {
    Frame F = F_; asm volatile("" : "+s"(F.bid), "+s"(F.G), "+s"(F.wave)); F.lane = lane_id_(); asm volatile("" : "+v"(F.lane)); F.tid = F.wave * 64 + F.lane;
    const int lane = F.lane;
    const float* LG = WSP(const float, WS_LOGIT); int* TE = WSP(int, WS_TOPE); float* TW = WSP(float, WS_TOPW); int* TP = WSP(int, WS_TPOS);
    unsigned* cnt = WSP(unsigned, WS_CTL) + CW_CNT + l * 256;
    LAS unsigned* hist = (LAS unsigned*)F.lds;
    if (F.tid < 512) hist[F.tid] = 0u;
    __syncthreads();
    const int per = (Tm + F.G - 1) / F.G, t0 = F.bid * per, t1 = (t0 + per < Tm) ? t0 + per : Tm;
    const f32x4 bias = *(const f32x4*)(KIN(I_ROUTB) + (size_t)l * 256 + 4 * lane);
    const float NEG = -__builtin_inff();
    for (int tb = t0 + F.wave; tb < t1; tb += 2 * NWAVES) {
        int tt[2]; bool ok[2]; f32x4 lg[2];
#pragma unroll
        for (int u = 0; u < 2; ++u) { tt[u] = tb + u * NWAVES; ok[u] = tt[u] < t1; lg[u] = *(const f32x4*)(LG + (size_t)(ok[u] ? tt[u] : tb) * 256 + 4 * lane); }
        float sc[2][4], v[2][4]; int my_e[2]; float my_w[2], wsum[2];
#pragma unroll
        for (int u = 0; u < 2; ++u) {
#pragma unroll
            for (int i = 0; i < 4; ++i) { sc[u][i] = sigmoidf_(lg[u][i]); v[u][i] = sc[u][i] + bias[i]; }
            float m1 = fmaxf(fmaxf(v[u][0], v[u][1]), fmaxf(v[u][2], v[u][3]));
            float m2;
            { const float a = fmaxf(v[u][0], v[u][1]), b = fminf(v[u][0], v[u][1]), c = fmaxf(v[u][2], v[u][3]), d = fminf(v[u][2], v[u][3]); m2 = fmaxf(fminf(a, c), fmaxf(b, d)); }
#pragma unroll
            for (int o = 1; o < 8; o <<= 1) { const float b1 = __shfl_xor(m1, o), b2 = __shfl_xor(m2, o); const float n1 = fmaxf(m1, b1), n2 = fmaxf(fminf(m1, b1), fmaxf(m2, b2)); m1 = n1; m2 = n2; }
            const float gs = m1 + m2; const int grp = lane >> 3; int rank = 0;
#pragma unroll
            for (int j = 0; j < 8; ++j) { const float o = __shfl(gs, j * 8); rank += (o > gs || (o == gs && j < grp)) ? 1 : 0; }
            if (rank >= 4) { v[u][0] = NEG; v[u][1] = NEG; v[u][2] = NEG; v[u][3] = NEG; }
            my_e[u] = 0; my_w[u] = 0.f; wsum[u] = 0.f;
        }
#pragma unroll 1
        for (int k = 0; k < 8; ++k) {
#pragma unroll
            for (int u = 0; u < 2; ++u) {
                float bv = v[u][0]; int bl = 0;
#pragma unroll
                for (int i = 1; i < 4; ++i) if (v[u][i] > bv) { bv = v[u][i]; bl = i; }
                const float wm = wave_max_dpp(bv);
                const unsigned long long hit = __ballot(bv == wm);
                const int own = (int)__builtin_ctzll(hit);
                const int sub = __builtin_amdgcn_readlane(bl, own), bi = own * 4 + sub;
                const float mysc = sub == 0 ? sc[u][0] : (sub == 1 ? sc[u][1] : (sub == 2 ? sc[u][2] : sc[u][3]));
                const float wv = __builtin_bit_cast(float, __builtin_amdgcn_readlane(__builtin_bit_cast(int, mysc), own));
#pragma unroll
                for (int i = 0; i < 4; ++i) v[u][i] = (lane == own && sub == i) ? NEG : v[u][i];
                wsum[u] += wv; if (lane == k) { my_e[u] = bi; my_w[u] = wv; }
            }
        }
#pragma unroll
        for (int u = 0; u < 2; ++u)
            if (ok[u] && lane < 8) {
                TE[(size_t)tt[u] * 8 + lane] = my_e[u]; TW[(size_t)tt[u] * 8 + lane] = my_w[u] / wsum[u] * 2.5f;
                TP[(size_t)tt[u] * 8 + lane] = (int)__hip_atomic_fetch_add(&hist[my_e[u]], 1u, __ATOMIC_RELAXED, __HIP_MEMORY_SCOPE_WORKGROUP);
            }
    }
    __syncthreads();
    if (F.tid < 256) { const unsigned c = hist[F.tid]; hist[256 + F.tid] = c ? __hip_atomic_fetch_add(&cnt[F.tid], c, __ATOMIC_RELAXED, __HIP_MEMORY_SCOPE_AGENT) : 0u; }
    asm volatile("s_waitcnt vmcnt(0)" ::: "memory");
    __syncthreads();
    for (int q = t0 * 8 + F.tid; q < t1 * 8; q += 512) TP[q] += (int)hist[256 + TE[q]];
    __syncthreads();
}
#undef PHG
#define PHG 9
__device__ __forceinline__ void phase_slots(const Frame& F_, int l, int Tm) {
    Frame F = F_; asm volatile("" : "+s"(F.bid), "+s"(F.G), "+s"(F.wave)); F.lane = lane_id_(); asm volatile("" : "+v"(F.lane)); F.tid = F.wave * 64 + F.lane;
    const int gw = F.bid * NWAVES + F.wave, NGW = F.G * NWAVES, lane = F.lane;
    LAS int* tst = (LAS int*)F.lds; LAS int* cn = tst + 260;
    const unsigned* cnt = WSP(const unsigned, WS_CTL) + CW_CNT + l * 256;
    if (F.tid < 256) cn[F.tid] = (int)__hip_atomic_load(&cnt[F.tid], __ATOMIC_RELAXED, __HIP_MEMORY_SCOPE_AGENT);
    __syncthreads();
    if (F.tid == 0) { int s = 0; for (int e = 0; e < 256; ++e) { tst[e] = s; s += (cn[e] + 255) >> 8; } tst[256] = s; }
    __syncthreads();
    const int NT = tst[256];
    int* meta = WSP(int, WS_META); int* tile_e = meta + 64;
    int* ST = WSP(int, WS_STOK); float* SW = WSP(float, WS_SW);
    const int* TE = WSP(const int, WS_TOPE); const float* TW = WSP(const float, WS_TOPW); const int* TP = WSP(const int, WS_TPOS); int* TS = WSP(int, WS_TSLOT);
    if (F.bid == 0) {
        if (F.tid == 0) { meta[0] = NT; meta[1] = NT + Tm / 256; }
        if (F.tid < 256) { const int e = F.tid, n = (cn[e] + 255) >> 8; for (int j = 0; j < n; ++j) tile_e[tst[e] + j] = e; }
        for (int i = F.tid; i < Tm / 256; i += 512) tile_e[NT + i] = 256;
    }
    for (int t = gw; t < Tm; t += NGW) {
        if (lane < 8) { const int e = TE[(size_t)t * 8 + lane], slot = tst[e] * 256 + TP[(size_t)t * 8 + lane];
            ST[slot] = t; SW[slot] = TW[(size_t)t * 8 + lane]; TS[(size_t)t * 8 + lane] = slot; }
    }
#pragma unroll 1
    for (int e = gw; e < 256; e += NGW) { const int c = cn[e], n = (c + 255) >> 8;
#pragma unroll 1
        for (int s = c + lane; s < n * 256; s += 64) { ST[tst[e] * 256 + s] = 0; SW[tst[e] * 256 + s] = 0.f; } }
    int gstep = F.G * 512; asm volatile("" : "+s"(gstep));
#pragma unroll 1
    for (int t = F.bid * 512 + F.tid; t < Tm; t += gstep) { ST[NT * 256 + t] = t; SW[NT * 256 + t] = 1.f; }
    __syncthreads();
}
#undef PHG
#define PHG 9
__device__ __forceinline__ void moe_units_setup(const Frame& F_, int npn, const int* rowsrc  ) {
    Frame F = F_; asm volatile("" : "+s"(F.bid), "+s"(F.G), "+s"(F.wave)); F.lane = lane_id_(); asm volatile("" : "+v"(F.lane)); F.tid = F.wave * 64 + F.lane;
    int G_ = F.G; asm volatile("" : "+s"(G_)); F.G = G_;
    const int* meta = WSP(const int, WS_META); const int* tile_e = meta + 64;
    LAS int* ut = (LAS int*)(F.lds + pg8::XT_UT); LAS int* xi = (LAS int*)(F.lds + pg8::XT_XI);
    const int nun = meta[1] * npn;
    __syncthreads();
    const int cperm = (F.G % 8 == 0) ? (F.bid & 7) * (F.G >> 3) + (F.bid >> 3) : F.bid;
#ifdef DOWN_WGMAJOR
#define MOE_L(i) ((npn == 4) ? (((i) >> 2) * F.G + cperm) * 4 + ((i) & 3) : (i) * F.G + cperm)
#else
#define MOE_L(i) ((i) * F.G + cperm)
#endif
    if (F.tid < pg8::XT_MAXU) { const int L = MOE_L(F.tid), ok = L < nun, tile = ok ? L / npn : 0;
        ut[F.tid * 4] = tile; ut[F.tid * 4 + 1] = ok ? L % npn : 0; ut[F.tid * 4 + 2] = ok ? tile_e[tile] : 0; ut[F.tid * 4 + 3] = ok; }
    for (int q = F.tid; q < pg8::XT_MAXU * 256; q += 512) { const int i = q >> 8, r = q & 255, L = MOE_L(i);
        if (L < nun) xi[q] = rowsrc[(L / npn) * 256 + r]; }
    __syncthreads();
}
#undef PHG
#define PHG 10
__device__ __forceinline__ void combine_token(const Frame& F, int l, int t, const u32x2 (&R_)[2][9], const u32x4 (&XW_)[2], const float* lw, const float* lb, bf16* X, bf16* H) {
    const int lane = F.lane;
    const float* mv = mod_vec(F, l, t);
    float v[16]; float s = 0.f;
#pragma unroll
    for (int j = 0; j < 2; ++j) { const int col = j * 512 + lane * 8; float f[8];
#pragma unroll
        for (int q = 0; q < 8; ++q) f[q] = 0.f;
#pragma unroll
        for (int k = 0; k < 9; ++k) { const u32x2 w = R_[j][k];
            const f32x2 a = __builtin_amdgcn_cvt_pk_f32_fp8((int)w.x, false), b = __builtin_amdgcn_cvt_pk_f32_fp8((int)w.x, true), c = __builtin_amdgcn_cvt_pk_f32_fp8((int)w.y, false), d = __builtin_amdgcn_cvt_pk_f32_fp8((int)w.y, true);
            f[0] += a.x; f[1] += a.y; f[2] += b.x; f[3] += b.y; f[4] += c.x; f[5] += c.y; f[6] += d.x; f[7] += d.y; }
#pragma unroll
        for (int q = 0; q < 8; ++q) f[q] *= pg8::YS_INV;
        const u32x4 xw = XW_[j];
        const f32x4 xa = {bflo(xw.x), bfhi(xw.x), bflo(xw.y), bfhi(xw.y)}, xb = {bflo(xw.z), bfhi(xw.z), bflo(xw.w), bfhi(xw.w)};
        const f32x4 ga = *(const f32x4*)(mv + 5120 + col), gb = *(const f32x4*)(mv + 5120 + col + 4);
#pragma unroll
        for (int q = 0; q < 4; ++q) { v[j * 8 + q] = DN_ALPHA * xa[q] + ga[q] * f[q]; v[j * 8 + 4 + q] = DN_ALPHA * xb[q] + gb[q] * f[4 + q]; }
#pragma unroll
        for (int q = 0; q < 8; ++q) s += v[j * 8 + q]; }
    float mean = wave_sum(s) * (1.f / D), s2 = 0.f;
#pragma unroll
    for (int q = 0; q < 16; ++q) { v[q] -= mean; s2 += v[q] * v[q]; }
    float rstd = 1.f / sqrtf(wave_sum(s2) * (1.f / D) + LN_EPS);
    s = 0.f;
#pragma unroll
    for (int j = 0; j < 2; ++j) { const int col = j * 512 + lane * 8;
        const f32x4 wa = *(const f32x4*)(lw + col), wb = *(const f32x4*)(lw + col + 4), ba = *(const f32x4*)(lb + col), bb = *(const f32x4*)(lb + col + 4);
#pragma unroll
        for (int q = 0; q < 4; ++q) { v[j * 8 + q] = v[j * 8 + q] * rstd * wa[q] + ba[q]; v[j * 8 + 4 + q] = v[j * 8 + 4 + q] * rstd * wb[q] + bb[q]; }
        if (l == 1) { float* dst = (float*)karg(27) + (size_t)t * D + col;
            *(f32x4*)dst = (f32x4){v[j * 8], v[j * 8 + 1], v[j * 8 + 2], v[j * 8 + 3]}; *(f32x4*)(dst + 4) = (f32x4){v[j * 8 + 4], v[j * 8 + 5], v[j * 8 + 6], v[j * 8 + 7]}; }
        else { u32x4 w; w.x = pk2(v[j * 8], v[j * 8 + 1]); w.y = pk2(v[j * 8 + 2], v[j * 8 + 3]); w.z = pk2(v[j * 8 + 4], v[j * 8 + 5]); w.w = pk2(v[j * 8 + 6], v[j * 8 + 7]); *(u32x4*)(X + (size_t)t * D + col) = w; }
#pragma unroll
        for (int q = 0; q < 8; ++q) s += v[j * 8 + q]; }
    if (l == 0) {
        mean = wave_sum(s) * (1.f / D); s2 = 0.f;
#pragma unroll
        for (int q = 0; q < 16; ++q) { v[q] -= mean; s2 += v[q] * v[q]; }
        rstd = 1.f / sqrtf(wave_sum(s2) * (1.f / D) + LN_EPS);
        const float* m1 = mod_vec(F, 1, t);
#pragma unroll
        for (int j = 0; j < 2; ++j) { const int col = j * 512 + lane * 8;
            const f32x4 sa = *(const f32x4*)(m1 + 1024 + col), sb = *(const f32x4*)(m1 + 1024 + col + 4), ha = *(const f32x4*)(m1 + col), hb = *(const f32x4*)(m1 + col + 4);
            float o[8];
#pragma unroll
            for (int q = 0; q < 4; ++q) { o[q] = v[j * 8 + q] * rstd * (1.f + sa[q]) + ha[q]; o[4 + q] = v[j * 8 + 4 + q] * rstd * (1.f + sb[q]) + hb[q]; }
            u32x2 w; w.x = pg8::pack_fp8x4(o[0], o[1], o[2], o[3]); w.y = pg8::pack_fp8x4(o[4], o[5], o[6], o[7]);
            *(u32x2*)((unsigned char*)H + (size_t)t * D + col) = w; }
    }
}
#undef PHG
#define PHG 10
__device__ __forceinline__ void phase_combine(const Frame& F_, int l, int Tm) {
    Frame F = F_; asm volatile("" : "+s"(F.bid), "+s"(F.G), "+s"(F.wave)); F.lane = lane_id_(); asm volatile("" : "+v"(F.lane)); F.tid = F.wave * 64 + F.lane;
    const int gw = F.bid * NWAVES + F.wave, NGW = F.G * NWAVES, lane = F.lane;
    const int* meta = WSP(const int, WS_META); const int NT = meta[0];
    const int* TS = WSP(const int, WS_TSLOT); const unsigned char* YS = WSP(const unsigned char, WS_YSLOT); bf16* X = WSP(bf16, WS_X); bf16* H = (bf16*)WSP(unsigned char, WS_H8);
    const float* lw = KIN(I_LNFW) + (size_t)l * D; const float* lb = KIN(I_LNFB) + (size_t)l * D;
#define CB_SLOT(t_) ((lane < 8 && (t_) < Tm) ? TS[(size_t)(t_) * 8 + lane] : 0)
#define CB_LOAD(R_, XW_, sl_, t_) do { int slots_[9]; _Pragma("unroll") for (int k = 0; k < 8; ++k) slots_[k] = __shfl(sl_, k); slots_[8] = NT * 256 + (t_); \
        _Pragma("unroll") for (int j = 0; j < 2; ++j) { const int col = j * 512 + lane * 8; \
            _Pragma("unroll") for (int k = 0; k < 9; ++k) R_[j][k] = *(const u32x2*)(YS + (size_t)slots_[k] * 1024 + col); \
            XW_[j] = *(const u32x4*)(X + (size_t)(t_) * D + col); } } while (0)
    u32x2 ra[2][9]; u32x4 xa_[2];
    int sl = CB_SLOT(gw);
#pragma unroll 1
    for (int t = gw; t < Tm; t += NGW) {
        const int sln = CB_SLOT(t + NGW);
        CB_LOAD(ra, xa_, sl, t);
        combine_token(F, l, t, ra, xa_, lw, lb, X, H);
        sl = sln;
    }
#undef CB_SLOT
#undef CB_LOAD
}
#ifndef MK_PER_PHASE
#define MK_PER_PHASE 0
#endif
#ifndef TSAMP
#define TSAMP 8ull
#endif
#ifndef NPREP
#define NPREP 0
#endif
#ifndef ALIGN_BIG
#define ALIGN_BIG true
#endif
#ifndef SKEW_BIG
#define SKEW_BIG 0
#endif
#ifndef SKEW_DOWN
#define SKEW_DOWN 0
#endif
constexpr int NPL = 15, NPHASE = 1 + 2 * NPL;
#undef PHG
#define PHG 0
struct Args { const float* in[27]; float* out; unsigned char* ws; int ph_lo, ph_hi; };
static_assert(sizeof(Args) == 29 * 8 + 8, "Args has no padding");

__global__ void __launch_bounds__(NWAVES * 64, 2) mk_fwd(Args args) {
    extern __shared__ __attribute__((aligned(16))) unsigned char lds_raw[];
    Frame F;
    F.lds = (LAS unsigned char*)lds_raw;
    F.wave = __builtin_amdgcn_readfirstlane((int)threadIdx.x >> 6); F.lane = lane_id_(); F.tid = F.wave * 64 + F.lane; F.G = gridDim.x; F.bid = blockIdx.x;
    F.ws = args.ws;
    volatile LAS unsigned* MISC = (volatile LAS unsigned*)(F.lds + MISC_OFF);
    { const int t_ = F.wave * 64 + lane_id_(); if (t_ < 128) MISC[t_] = 0u; }
    __syncthreads();
    unsigned* ctl = (unsigned*)(F.ws + WS_CTL);
    if (!MK_PER_PHASE) (void)xcd_barrier_post(ctl + CW_BAR, MISC, F.wave);
#ifndef PHMASK
#define PHMASK 0xFFFFFFFFu
#endif
#define PHON(k) ((PHMASK >> ((k) == 0 ? 0 : (((k) - 1) % NPL) + 1)) & 1u)
#define IN(k) (PHON(k) && karg_int(29 * 8) <= (k) && (k) < karg_int(29 * 8 + 4))
#ifndef DUPMASK
#define DUPMASK 0u
#endif
#define REPS(k) (((DUPMASK >> ((k) == 0 ? 0 : (((k) - 1) % NPL) + 1)) & 1u) ? 2 : 1)
#ifdef TSMASK
#define STAMP(i) do { if (F.bid == 0 && F.wave == 0 && lane_id_() == 0) ((volatile LAS unsigned long long*)(F.lds + MISC_OFF + 16))[i] = wall_clock64(); } while (0)
#else
#define STAMP(i) do { } while (0)
#endif
#define SEAM(k) do { if (IN(k) && IN((k) + 1)) { XcdBarrier b_; unsigned long long bp_ = (unsigned long long)(F.ws + WS_CTL) + CW_BAR * 4; asm volatile("" : "+s"(bp_));   \
        b_.bar = ((GMASK >> 11) & 1u) ? (unsigned*)(__attribute__((address_space(1))) unsigned*)bp_ : (unsigned*)bp_; b_.x = xb_xcc_id(); b_.st = (volatile LAS unsigned*)(F.lds + MISC_OFF); xcd_barrier(b_, F.wave); } STAMP((k) + 1); } while (0)
    LAS unsigned char* ring = F.lds;
    STAMP(0);

    if (IN(0)) _Pragma("unroll") for (int rep_ = 0; rep_ < REPS(0); ++rep_) { phase_init(F); } SEAM(0);

#pragma unroll 1
    for (int l = 0; l < 2; ++l) {
        const int pb = 1 + l * NPL;
        const int Mrows = (l == 0) ? T_ALL : T_LAT;
        unsigned char* wne = ws_opaque(F.ws) + WS_WNE + (size_t)l * WNE_STRIDE;
        if (IN(pb + 0)) { if (l == 0) phase_h0(F); } if (l == 0) SEAM(pb + 0); else STAMP(pb + 1);
        if (IN(pb + 1)) _Pragma("unroll") for (int rep_ = 0; rep_ < REPS(pb + 1); ++rep_) {
            const int ng = (NPREP > 0 && F.G > 4 * NPREP) ? F.G - NPREP : F.G;
            if (F.bid < ng) {
                pg8::ProbDense S{nullptr, 512  , WSP(const bf16, WS_H8), (const bf16*)(wne + WNE_WIN), T_ALL / 256, INW / 256, ng, F.bid, 0, WIN_LD / 2};
                pg8::EpiInproj E{WSP(bf16, WS_P), WSP(unsigned char, WS_G8), WSP(unsigned char, WS_GR8), 1.f / WGU_SCALE};
                pg8::gemm_phase<pg8::ProbDense, pg8::EpiInproj, ALIGN_BIG, SKEW_BIG, 8, true>(ring, S, E, F.wave);
            }
            if (ng == F.G) phase_expert_prep(F, l, F.bid, F.G); else if (F.bid >= ng) phase_expert_prep(F, l, F.bid - ng, F.G - ng);
#ifdef DUP_PREP
            phase_expert_prep(F, l, F.bid, F.G);
#endif
            if (REPS(pb + 1) > 1) __syncthreads();
        } SEAM(pb + 1);
        if (IN(pb + 2)) _Pragma("unroll") for (int rep_ = 0; rep_ < REPS(pb + 2); ++rep_) {
#ifndef NO_R1
            phase_r1(F, l);
#ifdef DUP_R1
            phase_r1(F, l);
#endif
#endif
#ifndef NO_UT
            phase_ut(F, l); __syncthreads();
#ifdef DUP_UT
            phase_ut(F, l); __syncthreads();
#endif
#endif

        } SEAM(pb + 2);
        if (IN(pb + 3)) _Pragma("unroll") for (int rep_ = 0; rep_ < REPS(pb + 3); ++rep_) {
            phase_nyquist(F);
            phase_na(F, l);
#ifdef DUP_NA
            phase_na(F, l);
#endif
            phase_r2(F, l);
#ifdef DUP_R2
            phase_r2(F, l);
#endif
#ifdef DUP_NYQ
            phase_nyquist(F);
#endif
            { pg8::ProbBatched S{nullptr, 2048  , WSP(const bf16, WS_DFT), WSP(const bf16, WS_UT), (size_t)512 * 2048  , 16, 2, NB, F.G, F.bid};
              pg8::EpiFourier E{WSP(unsigned char, WS_FF), 0, NSEQ, 8, 1, 16.f / (64.f * 724.0773439350247f)};
              pg8::gemm_phase<pg8::ProbBatched, pg8::EpiFourier, true, 0, -1, true>(ring, S, E, F.wave); }
            if (l == 0) {
              pg8::ProbBatched S{nullptr, 256, WSP(const bf16, WS_DFTC), WSP(const bf16, WS_UTC), (size_t)512 * 256, 2, 2, NB, F.G, F.bid};
              pg8::EpiFourier E{WSP(unsigned char, WS_FF), T_LAT, NCTX, 1, 0, 16.f};
              pg8::gemm_phase<pg8::ProbBatched, pg8::EpiFourier>(ring, S, E, F.wave); }
        } SEAM(pb + 3);
        if (IN(pb + 4)) _Pragma("unroll") for (int rep_ = 0; rep_ < REPS(pb + 4); ++rep_) { phase_r3(F, l);
            { const int nx = (NB * 4 * NCH) % F.G, g2 = F.G - nx, c2 = F.bid - nx;
              if (c2 >= 0) { pg8::ProbDense S{nullptr, 256  , WSP(const bf16, WS_YNA), (const bf16*)(wne + WNE_ONA), Mrows / 256, 4, g2, c2};
                pg8::EpiFp8Plain E{WSP(unsigned char, WS_ZNA), 1024, 1.f / WGU_SCALE};
                pg8::gemm_phase<pg8::ProbDense, pg8::EpiFp8Plain, true, 0, -1, true>(ring, S, E, F.wave); } }
        } SEAM(pb + 4);
        if (IN(pb + 5)) _Pragma("unroll") for (int rep_ = 0; rep_ < REPS(pb + 5); ++rep_) {
            { pg8::ProbDense S{nullptr, 512, WSP(const bf16, WS_FF), (const bf16*)(wne + WNE_WF), Mrows / 256, 4, F.G, F.bid};
              pg8::EpiFp8Plain E{WSP(unsigned char, WS_ZFF), 1024, 1.f / WGU_SCALE};
              pg8::gemm_phase<pg8::ProbDense, pg8::EpiFp8Plain, true, 0, -1, true>(ring, S, E, F.wave); }
            { pg8::ProbDense S{nullptr, 512, WSP(const bf16, WS_YRET), (const bf16*)(wne + WNE_ORET), Mrows / 256, 4, F.G, (F.bid + 128) % F.G};
              pg8::EpiFp8Plain E{WSP(unsigned char, WS_ZRET), 1024, 1.f / WGU_SCALE};
              pg8::gemm_phase<pg8::ProbDense, pg8::EpiFp8Plain, true, 0, -1, true>(ring, S, E, F.wave); }
        } SEAM(pb + 5);
        if (IN(pb + 6)) _Pragma("unroll") for (int rep_ = 0; rep_ < REPS(pb + 6); ++rep_) { phase_gatesum(F, Mrows); } SEAM(pb + 6);
        if (IN(pb + 7)) _Pragma("unroll") for (int rep_ = 0; rep_ < REPS(pb + 7); ++rep_) {
            pg8::ProbDense S{nullptr, 512, WSP(const bf16, WS_YSUMB), (const bf16*)(wne + WNE_WOUT), Mrows / 256, 4, F.G, F.bid};
            pg8::EpiFp8Plain E{WSP(unsigned char, WS_YOUT), 1024, 1.f / WGU_SCALE};
            pg8::gemm_phase<pg8::ProbDense, pg8::EpiFp8Plain, true, 0, -1, true>(ring, S, E, F.wave);
        } SEAM(pb + 7);
        if (IN(pb + 8)) _Pragma("unroll") for (int rep_ = 0; rep_ < REPS(pb + 8); ++rep_) { phase_ln_mix(F, l, Mrows); } SEAM(pb + 8);
        if (IN(pb + 9)) _Pragma("unroll") for (int rep_ = 0; rep_ < REPS(pb + 9); ++rep_) {
            pg8::ProbDense S{nullptr, 1024, WSP(const bf16, WS_H), (const bf16*)(wne + WNE_ROUT), Mrows / 256, 1, F.G, F.bid};
            pg8::EpiF32 E{WSP(float, WS_LOGIT), 256};
            pg8::gemm_phase<pg8::ProbDense, pg8::EpiF32>(ring, S, E, F.wave);
        } SEAM(pb + 9);
        if (IN(pb + 10)) _Pragma("unroll") for (int rep_ = 0; rep_ < REPS(pb + 10); ++rep_) { phase_topk(F, l, Mrows); } SEAM(pb + 10);
        if (IN(pb + 11)) _Pragma("unroll") for (int rep_ = 0; rep_ < REPS(pb + 11); ++rep_) { phase_slots(F, l, Mrows); } SEAM(pb + 11);
        if (IN(pb + 12)) _Pragma("unroll") for (int rep_ = 0; rep_ < REPS(pb + 12); ++rep_) {
            moe_units_setup(F, 2, WSP(const int, WS_STOK));
            pg8::ProbGU S{(const LAS int*)(F.lds + pg8::XT_XI), 512  , WSP(const bf16, WS_H8), WSP(const bf16, WS_WGU), (const LAS int*)(F.lds + pg8::XT_UT)};
            pg8::EpiSwiglu E{WSP(unsigned char, WS_ACT), 1.f / WGU_SCALE};
            pg8::gemm_phase<pg8::ProbGU, pg8::EpiSwiglu, ALIGN_BIG, SKEW_BIG, -1, true>(ring, S, E, F.wave);
        } SEAM(pb + 12);
        if (IN(pb + 13)) _Pragma("unroll") for (int rep_ = 0; rep_ < REPS(pb + 13); ++rep_) {
            moe_units_setup(F, 4, WSP(const int, WS_SW));
            pg8::ProbDown S{nullptr, 128  , WSP(const bf16, WS_ACT), WSP(const bf16, WS_WD), (const LAS int*)(F.lds + pg8::XT_UT)};
            pg8::EpiDown E{WSP(unsigned char, WS_YSLOT), (const LAS float*)(F.lds + pg8::XT_XI), 16.f / (16.f * WGU_SCALE)};
            pg8::gemm_phase<pg8::ProbDown, pg8::EpiDown, ALIGN_BIG, SKEW_DOWN, 10, true>(ring, S, E, F.wave);
        } SEAM(pb + 13);
        if (IN(pb + 14)) _Pragma("unroll") for (int rep_ = 0; rep_ < REPS(pb + 14); ++rep_) { phase_combine(F, l, Mrows); } SEAM(pb + 14);
    }
#ifdef SUBSEL
    if (F.bid == 0 && F.wave == 0 && lane_id_() == 0) {
        volatile LAS unsigned* sb = (volatile LAS unsigned*)(F.lds + MISC_OFF + 288);
        float tot = 0.f; for (int k = SUBLO; k <= SUBHI; ++k) tot += (float)sb[k];
        unsigned code = 0, mul = 1;
        for (int k = 0; k < 3; ++k) { int d = tot > 0.f ? (int)((float)sb[SUBSEL + k] * 15.f / tot + 0.5f) : 0; d = d > 15 ? 15 : d; code += (unsigned)d * mul; mul *= 16u; }
        const unsigned long long t0 = wall_clock64(), dt = (unsigned long long)code * 4000ull;
        while (wall_clock64() - t0 < dt) __builtin_amdgcn_s_sleep(32);
    }
#endif
#ifdef TSMASK
    if (F.bid == 0 && F.wave == 0 && lane_id_() == 0) {
        volatile LAS unsigned long long* ts = (volatile LAS unsigned long long*)(F.lds + MISC_OFF + 16);
        unsigned long long sel = 0;
        for (int k = 0; k < NPHASE; ++k) { const int slot = k == 0 ? 0 : ((k - 1) % NPL) + 1; if ((TSMASK >> slot) & 1u) sel += ts[k + 1] - ts[k]; }
        const unsigned long long t0 = wall_clock64(), dt = sel * TSAMP;
        while (wall_clock64() - t0 < dt) __builtin_amdgcn_s_sleep(32);
    }
#endif
#undef IN
#undef SEAM
}

extern "C" void kernel_launch(void* const* d_in, const int* in_sizes, int n_in, void* d_out, int out_size, void* d_ws, size_t ws_size, hipStream_t stream) {
    static int grid = 0;
    if (grid == 0) {
        if (n_in != 27 || out_size != T_LAT * D || ws_size < WS_END) { fprintf(stderr, "kernel_launch: unexpected problem (n_in %d out %d ws %zu)\n", n_in, out_size, ws_size); grid = -1; return; }
        int dev = 0, cus = 0;
        if (hipGetDevice(&dev) != hipSuccess || hipDeviceGetAttribute(&cus, hipDeviceAttributeMultiprocessorCount, dev) != hipSuccess) { grid = -1; return; }
        if (hipFuncSetAttribute((const void*)mk_fwd, hipFuncAttributeMaxDynamicSharedMemorySize, LDS_BYTES) != hipSuccess) { fprintf(stderr, "kernel_launch: hipFuncSetAttribute failed\n"); grid = -1; return; }
        int per_cu = 0;
        if (hipOccupancyMaxActiveBlocksPerMultiprocessor(&per_cu, (const void*)mk_fwd, NWAVES * 64, LDS_BYTES) != hipSuccess || per_cu < 1) fprintf(stderr, "kernel_launch: occupancy query reports %d\n", per_cu);
        (void)hipGetLastError();
        grid = cus;
    }
    if (grid < 0) return;
    if (hipMemsetAsync((char*)d_ws + WS_CTL, 0, CTL_BYTES, stream) != hipSuccess) return;
    Args a{};
    for (int i = 0; i < 27; ++i) a.in[i] = (const float*)d_in[i];
    a.out = (float*)d_out; a.ws = (unsigned char*)d_ws;
#if MK_PER_PHASE
    for (int p = 0; p < NPHASE; ++p) { a.ph_lo = p; a.ph_hi = p + 1; hipLaunchKernelGGL(mk_fwd, dim3(grid), dim3(NWAVES * 64), LDS_BYTES, stream, a); }
#else
    a.ph_lo = 0; a.ph_hi = NPHASE;
    hipLaunchKernelGGL(mk_fwd, dim3(grid), dim3(NWAVES * 64), LDS_BYTES, stream, a);
#endif
}
```

```cpp
#include <hip/hip_runtime.h>
#include <cstdio>
#include <cstdint>

#define LAS __attribute__((address_space(3)))
#define GAS __attribute__((address_space(1)))
typedef unsigned short bf16;
typedef short bf16x8 __attribute__((ext_vector_type(8)));
typedef short bf16x4 __attribute__((ext_vector_type(4)));
typedef float f32x4 __attribute__((ext_vector_type(4)));
typedef float f32x2 __attribute__((ext_vector_type(2)));
typedef unsigned u32x4 __attribute__((ext_vector_type(4)));
typedef unsigned u32x2 __attribute__((ext_vector_type(2)));

constexpr int D = 1024, NB = 8, NSEQ = 4096, NCTX = 256, GW = 64;
constexpr int T_LAT = NB * NSEQ, T_CTX = NB * NCTX, T_ALL = T_LAT + T_CTX;
constexpr int INW = 8192;
constexpr int C_QA = 0, C_KA = 512, C_VA = 1024, C_UB = 1536, C_QR = 2048, C_KR = 2560, C_VR = 3072, C_GR = 4096, C_GL = 5120;
constexpr int NE = 256, TOPK = 8, EDIM = 256;
constexpr int NCH = 34;
constexpr float DN_ALPHA = 1.41421356237309515f;
constexpr float LN_EPS = 1e-6f, GN_EPS = 1e-5f;
constexpr int MAX_TILES = 1343 + 136;

constexpr size_t MiB = 1u << 20;
constexpr size_t WS_CTL = 0, CTL_BYTES = 1 * MiB;
constexpr size_t WS_MOD = 1 * MiB;
constexpr size_t WS_ROPE = 2 * MiB;
constexpr size_t WS_META = 3 * MiB;
constexpr size_t WS_WNE = 8 * MiB, WNE_STRIDE = 24 * MiB;
constexpr size_t WNE_WIN = 0, WNE_ONA = 16 * MiB, WNE_WF = 17 * MiB, WNE_ORET = 19 * MiB, WNE_WOUT = 21 * MiB, WNE_ROUT = 23 * MiB;
#ifndef WIN_LD
#define WIN_LD 1152
#endif
constexpr size_t WS_DFT = 56 * MiB;
constexpr size_t WS_DFTC = 120 * MiB;
constexpr size_t WS_WGU = 128 * MiB;
constexpr size_t WS_WD = 386 * MiB;
constexpr size_t WS_X = 520 * MiB;
constexpr size_t WS_H = 656 * MiB;
constexpr size_t WS_R = 724 * MiB;
constexpr size_t WS_P = WS_R;
constexpr size_t WS_YNA = WS_R + 544 * MiB;
constexpr size_t WS_FF = WS_R + 578 * MiB;
constexpr size_t WS_YRET = WS_R + 646 * MiB;
constexpr size_t WS_UT = WS_R + 714 * MiB;
constexpr size_t WS_UTC = WS_UT + 32 * MiB;
constexpr size_t WS_KV = WS_R + 748 * MiB;
constexpr size_t WS_SPREV = WS_R + 1020 * MiB;
constexpr size_t WS_ZNA = WS_KV, WS_ZFF = WS_KV + 68 * MiB, WS_ZRET = WS_KV + 136 * MiB;
constexpr size_t WS_YSUMB = WS_KV + 204 * MiB;
constexpr size_t WS_YOUT = WS_KV;
constexpr size_t WS_TMIX = WS_R;
constexpr size_t WS_LOGIT = WS_R + 136 * MiB;
constexpr size_t WS_TOPE = WS_R + 170 * MiB;
constexpr size_t WS_TOPW = WS_R + 172 * MiB;
constexpr size_t WS_TPOS = WS_R + 174 * MiB;
constexpr size_t WS_TSLOT = WS_R + 176 * MiB;
constexpr size_t WS_STOK = WS_R + 178 * MiB;
constexpr size_t WS_SW = WS_R + 180 * MiB;
constexpr size_t WS_ACT = WS_R + 182 * MiB;
constexpr size_t WS_YSLOT = WS_R + 368 * MiB;
constexpr size_t WS_VT = WS_R + 1156 * MiB;
constexpr size_t WS_VTC = WS_VT + 32 * MiB;
constexpr size_t WS_H8 = WS_SPREV;
constexpr size_t WS_GR8 = WS_KV + 136 * MiB;
constexpr size_t WS_G8 = WS_R + 1190 * MiB;
constexpr size_t WS_END = 2016 * MiB;
constexpr int CW_BAR = 4096;
constexpr int CW_CNT = 16384;
constexpr int CW_CHK = 20000;

constexpr int LDS_BYTES = 159744;
constexpr int MISC_OFF = 159232;

__device__ __forceinline__ int lane_id_() { return (int)__builtin_amdgcn_mbcnt_hi(~0u, __builtin_amdgcn_mbcnt_lo(~0u, 0u)); }
#define LDS_WAIT() asm volatile("s_waitcnt lgkmcnt(0)" ::: "memory")
#define VM_WAIT() asm volatile("s_waitcnt vmcnt(0)" ::: "memory")
__device__ __forceinline__ unsigned f2bf(float f) { unsigned u = __builtin_bit_cast(unsigned, f); return (u + 0x7fffu + ((u >> 16) & 1u)) >> 16; }
__device__ __forceinline__ float bf2f(unsigned b) { return __builtin_bit_cast(float, (b & 0xffffu) << 16); }
__device__ __forceinline__ unsigned pk2(float lo, float hi) { unsigned r; asm volatile("v_cvt_pk_bf16_f32 %0, %1, %2" : "=v"(r) : "v"(lo), "v"(hi)); return r; }
__device__ __forceinline__ float bflo(unsigned w) { return __builtin_bit_cast(float, w << 16); }
__device__ __forceinline__ float bfhi(unsigned w) { return __builtin_bit_cast(float, w & 0xffff0000u); }
__device__ __forceinline__ float wave_sum(float v) {
#pragma unroll
    for (int o = 1; o < 64; o <<= 1) v += __shfl_xor(v, o);
    return v;
}
__device__ __forceinline__ float sigmoidf_(float x) { return __builtin_amdgcn_rcpf(1.f + __expf(-x)); }
__device__ __forceinline__ float siluf_(float x) { return x * __builtin_amdgcn_rcpf(1.f + __expf(-x)); }

#define XB_TMO      128
#define XB_XCNT(j)  (256  + 64 * (j))
#define XB_XSUB(j)  (1280 + 64 * (j))
#define XB_XGEN(j)  (2304 + 64 * (j))
#define XB_TOP      3328
#define XB_TOPGEN   3392
#define XCD_BAR_WORDS 3456
#define XB_SPIN_CAP (1u << 18)
__device__ __forceinline__ unsigned xb_ld(unsigned* p)              { return __hip_atomic_load(p, __ATOMIC_RELAXED, __HIP_MEMORY_SCOPE_AGENT); }
__device__ __forceinline__ unsigned xb_add(unsigned* p, unsigned v) { return __hip_atomic_fetch_add(p, v, __ATOMIC_RELAXED, __HIP_MEMORY_SCOPE_AGENT); }
__device__ __forceinline__ unsigned xb_xcc_id() { return (unsigned)__builtin_amdgcn_s_getreg((3 << 11) | 20) & 0xFu; }
#define XB_SPIN(cond, bar) do { unsigned _sp = 0; while (cond) { __builtin_amdgcn_s_sleep(1); \
    if ((++_sp & 255u) == 0u) { if (xb_ld(&(bar)[XB_TMO])) break; if (_sp > XB_SPIN_CAP) { atomicAdd(&(bar)[XB_TMO], 1u); break; } } } } while (0)
struct XcdBarrier { unsigned* bar; unsigned x; volatile LAS unsigned* st; };
__device__ __forceinline__ XcdBarrier xcd_barrier_post(unsigned* bar, volatile LAS unsigned* st, int wave_id) {
    XcdBarrier b; b.bar = bar; b.x = xb_xcc_id(); b.st = st;
    if (wave_id == 0 && lane_id_() == 0) (void)xb_add(&bar[XB_XCNT(b.x)], 1u);
    return b;
}
__device__ __forceinline__ void xcd_barrier_complete(unsigned* bar, unsigned x, unsigned& nloc, unsigned& nx) {
    const unsigned G = gridDim.x * gridDim.y * gridDim.z;
    unsigned sum, cnt, mine, sp = 0u;
    for (;;) {
        sum = 0u; cnt = 0u; mine = 0u;
#pragma unroll
        for (unsigned j = 0; j < 16; ++j) { const unsigned c = xb_ld(&bar[XB_XCNT(j)]); sum += c; cnt += (c > 0u) ? 1u : 0u; mine = (j == x) ? c : mine; }
        if (sum == G) break;
        __builtin_amdgcn_s_sleep(1);
        if ((++sp & 255u) == 0u) { if (xb_ld(&bar[XB_TMO])) break; if (sp > XB_SPIN_CAP) { atomicAdd(&bar[XB_TMO], 1u); break; } }
    }
    nloc = mine > 0u ? mine : 1u; nx = cnt > 0u ? cnt : 1u;
}
__device__ __forceinline__ void xcd_barrier(const XcdBarrier& b, int wave_id) {
    asm volatile("s_waitcnt vmcnt(0)" ::: "memory");
    __syncthreads();
    if (wave_id == 0 && lane_id_() == 0) {
        unsigned* bar = b.bar;
        __builtin_amdgcn_s_waitcnt(0);
        unsigned nloc = b.st[0], nx = b.st[1];
        if (nloc == 0u) { xcd_barrier_complete(bar, b.x, nloc, nx); b.st[0] = nloc; b.st[1] = nx; }
        const unsigned old = xb_add(&bar[XB_XSUB(b.x)], 1u);
        const unsigned gen = old / nloc;
        if (old + 1u == (gen + 1u) * nloc) {
            __builtin_amdgcn_fence(__ATOMIC_RELEASE, "agent");
            asm volatile("s_waitcnt vmcnt(0)" ::: "memory");
            const unsigned og = xb_add(&bar[XB_TOP], 1u);
            const unsigned tg = og / nx;
            if (og + 1u == (tg + 1u) * nx) xb_add(&bar[XB_TOPGEN], 1u);
            else XB_SPIN(xb_ld(&bar[XB_TOPGEN]) == tg, bar);
            __builtin_amdgcn_fence(__ATOMIC_ACQUIRE, "agent");
            xb_add(&bar[XB_XGEN(b.x)], 1u);
            asm volatile("s_waitcnt vmcnt(0)" ::: "memory");
        } else {
            XB_SPIN(xb_ld(&bar[XB_XGEN(b.x)]) == gen, bar);
            __builtin_amdgcn_fence(__ATOMIC_ACQUIRE, "agent");
            asm volatile("s_waitcnt vmcnt(0)" ::: "memory");
        }
    }
    __syncthreads();
}
namespace pg8 {
#ifndef SKEW_TICKS
#define SKEW_TICKS 27u
#endif
constexpr int BM = 256, BK = 64, HALF = 128, HTB = HALF * BK * 2, STAGE_BYTES = 8 * HTB, NXCD = 8, WGM = 8;
__host__ __device__ __forceinline__ int lds_byte(int r, int c) { const int st = (r >> 4) * 2 + (c >> 5), rr = r & 15, cc = c & 31, ob = rr * 64 + cc * 2; return st * 1024 + (ob ^ (((ob >> 9) & 1) << 5)); }
__host__ __device__ __forceinline__ void stage_rc(int b, int& R, int& C) { const int st = b / 1024, sb = b % 1024, swz = sb ^ (((sb >> 9) & 1) << 5); R = (st >> 1) * 16 + swz / 64; C = (st & 1) * 32 + (swz % 64) / 2; }
__host__ __device__ __forceinline__ int perm32(int rho) { const int n = rho >> 4, i = rho & 15; return 8 * (i >> 2) + 4 * n + (i & 3); }
__host__ __device__ __forceinline__ int perm64(int R) { return (R >> 5) * 64 + ((R >> 2) & 3) * 16 + ((R >> 4) & 1) * 4 + (R & 3); }

struct Unit { int pm, pn, e, aux; };
typedef int i8v_ __attribute__((ext_vector_type(8)));
__device__ __forceinline__ unsigned cvt_pk_bf16(float lo, float hi) { unsigned r; asm volatile("v_cvt_pk_bf16_f32 %0, %1, %2" : "=v"(r) : "v"(lo), "v"(hi)); return r; }

__device__ __forceinline__ bool static_tile(int nM, int nN, int G, int c, int i, int& pm, int& pn) {
    const int nwg = nM * nN; const long L = (long)i * G + c; if (L >= nwg) return false;
    int wgid = (int)L; { const int q = nwg / NXCD, r = nwg % NXCD, xcd = wgid % NXCD, off = wgid / NXCD; wgid = (xcd < r ? xcd * (q + 1) : r * (q + 1) + (xcd - r) * q) + off; }
    const int nig = WGM * nN, gid = wgid / nig, fm = gid * WGM, gsz = (nM - fm) < WGM ? (nM - fm) : WGM;
    pm = fm + ((wgid % nig) % gsz); pn = (wgid % nig) / gsz; return true;
}

template <class Prob, class Epi, bool ALIGN_EPI = true, int SKEW = 0  , int STAMP = -1  ,
          bool F8 = false  >
__device__ __forceinline__ void gemm_phase(LAS unsigned char* lds, const Prob& S, const Epi& E, int wave_id) {
    int lane_ = lane_id_(); asm volatile("" : "+v"(lane_));
    const int wid = wave_id, lane = lane_, tid = wid * 64 + lane, wr = wid >> 2, wc = wid & 3, fr = lane & 15, fq = lane >> 4;
    int K_ = S.K, la_ = S.lda(), lb_ = S.ldb(); asm volatile("" : "+s"(K_), "+s"(la_), "+s"(lb_));
    const int K = K_, nt = K / BK, lda = la_, ldb = lb_;
    unsigned voffA[2], voffB[2]; int RA[2], CA[2];
#pragma unroll
    for (int i = 0; i < 2; ++i) { int R, C; stage_rc(tid * 16 + i * 8192, R, C); const int Rb = (int)Epi::PERM == 2 ? perm64(R) : (Epi::PERM ? ((R & ~31) + perm32(R & 31)) : R);
        RA[i] = R; CA[i] = C; voffA[i] = (unsigned)(R * lda + C) * 2u; voffB[i] = (unsigned)(Rb * ldb + C) * 2u; }
    const size_t kstep = (size_t)(BK * 2);
    const size_t hstepA = (size_t)HALF * lda * 2, hstepB = (size_t)((int)Epi::PERM == 2 ? 8 : HALF) * ldb * 2;
    const unsigned ldsw = (unsigned)wid * 1024u;
    const int aoff = lds_byte(wr * 64 + fr, fq * 8), boff = lds_byte(wc * 32 + fr, fq * 8);
#define PG8_SA(b, h) (((b) * 2 + (h)) * HTB)
#define PG8_SB(b, h) ((4 + (b) * 2 + (h)) * HTB)
#define PG8_STAGE(bufoff, gbase, voff) do { _Pragma("unroll") for (int _i = 0; _i < 2; ++_i) \
        __builtin_amdgcn_global_load_lds((const unsigned*)((const char*)(gbase) + (voff)[_i]), (LAS unsigned*)(lds + (bufoff) + ldsw + _i * 8192), 16, 0, 0); } while (0)
#define PG8_STAGE_A(bufoff, kp, h, g0, g1) do { if constexpr (Prob::GATHER) { if ((h) == 0) PG8_STAGE(bufoff, kp, g0); else PG8_STAGE(bufoff, kp, g1); } \
        else PG8_STAGE(bufoff, (kp) + (h) * hstepA, voffA); } while (0)
#define PG8_LDA(dst, b, h) do { _Pragma("unroll") for (int m = 0; m < 4; ++m) _Pragma("unroll") for (int k = 0; k < 2; ++k) dst[m][k] = *(const LAS bf16x8*)(lds + PG8_SA(b, h) + aoff + m * 2048 + k * 1024); } while (0)
#define PG8_LDB(dst, b, h) do { _Pragma("unroll") for (int n = 0; n < 2; ++n) _Pragma("unroll") for (int k = 0; k < 2; ++k) dst[n][k] = *(const LAS bf16x8*)(lds + PG8_SB(b, h) + boff + n * 2048 + k * 1024); } while (0)
#define PG8_MMA(ai, bj, At, Bt) do { __builtin_amdgcn_s_setprio(1); _Pragma("unroll") for (int m = 0; m < 4; ++m) _Pragma("unroll") for (int n = 0; n < 2; ++n) { \
        if constexpr (F8) { typedef int i4_ __attribute__((ext_vector_type(4))); \
            const i8v_ b_ = __builtin_shufflevector(__builtin_bit_cast(i4_, Bt[n][0]), __builtin_bit_cast(i4_, Bt[n][1]), 0, 1, 2, 3, 4, 5, 6, 7), a_ = __builtin_shufflevector(__builtin_bit_cast(i4_, At[m][0]), __builtin_bit_cast(i4_, At[m][1]), 0, 1, 2, 3, 4, 5, 6, 7); \
            asm volatile("v_mfma_f32_16x16x128_f8f6f4 %0, %1, %2, %0" : "+v"(acc[ai][bj][m][n]) : "v"(b_), "v"(a_));   } \
        else { _Pragma("unroll") for (int k = 0; k < 2; ++k) acc[ai][bj][m][n] = __builtin_amdgcn_mfma_f32_16x16x32_bf16(Bt[n][k], At[m][k], acc[ai][bj][m][n], 0, 0, 0); } } __builtin_amdgcn_s_setprio(0); } while (0)
#define PG8_WAIT_V(n) asm volatile("s_waitcnt vmcnt(" #n ")" ::: "memory")
#define PG8_WAIT_L(n) asm volatile("s_waitcnt lgkmcnt(" #n ")" ::: "memory")
#define PG8_BAR __builtin_amdgcn_s_barrier()
#define PG8_SCHED __builtin_amdgcn_sched_barrier(0)
#ifdef SUBSEL
#define PG8_TS(k, add) do { if (STAMP >= 0 && blockIdx.x == 0 && wid == 0) { volatile LAS unsigned* sb_ = (volatile LAS unsigned*)(lds + MISC_OFF + 288); const unsigned n_ = (unsigned)__builtin_amdgcn_s_memrealtime(); if (add) sb_[STAMP + (k)] += n_ - sb_[15]; sb_[15] = n_; } } while (0)
#else
#define PG8_TS(k, add) do { } while (0)
#endif
    Unit cur, nxt; int ui = 0;
    if (!S.next(0, cur)) return;
    if constexpr (SKEW > 0) {
        const unsigned grp = (blockIdx.x >> 3) & 3u;
        if (grp) { const unsigned long long t0 = wall_clock64(), dt = (unsigned long long)(grp * (unsigned)SKEW);
            while (wall_clock64() - t0 < dt) __builtin_amdgcn_s_sleep(8); } }
    f32x4 acc[2][2][4][2];
#pragma unroll
    for (int a = 0; a < 2; ++a)
#pragma unroll
        for (int b = 0; b < 2; ++b)
#pragma unroll
            for (int m = 0; m < 4; ++m)
#pragma unroll
                for (int n = 0; n < 2; ++n) acc[a][b][m][n] = (f32x4){0.f, 0.f, 0.f, 0.f};
    bf16x8 At[4][2], B0[2][2], B1[2][2];
    const char* cA = S.a_tile(cur); const char* cB = S.b_tile(cur);
    unsigned gc0[2] = {0u, 0u}, gc1[2] = {0u, 0u}, gn0[2] = {0u, 0u}, gn1[2] = {0u, 0u};
    if constexpr (Prob::GATHER) {
#pragma unroll
        for (int i = 0; i < 2; ++i) { const int r0 = S.gidx[cur.aux * 256 + RA[i]], r1 = S.gidx[cur.aux * 256 + 128 + RA[i]];
            gc0[i] = (unsigned)(r0 * lda + CA[i]) * 2u; gc1[i] = (unsigned)(r1 * lda + CA[i]) * 2u; }
    }
    PG8_STAGE(PG8_SB(0, 0), cB, voffB); PG8_STAGE(PG8_SB(0, 1), cB + hstepB, voffB); PG8_STAGE_A(PG8_SA(0, 0), cA, 0, gc0, gc1); PG8_STAGE_A(PG8_SA(0, 1), cA, 1, gc0, gc1);
    if (wr == 1) PG8_BAR;
    PG8_WAIT_V(2); PG8_BAR;
    PG8_STAGE(PG8_SB(1, 0), cB + kstep, voffB); PG8_STAGE_A(PG8_SA(1, 0), cA + kstep, 0, gc0, gc1); PG8_STAGE(PG8_SB(1, 1), cB + hstepB + kstep, voffB);
    PG8_WAIT_V(6); PG8_BAR;
    for (;;) {
        const bool has_next = S.next(ui + 1, nxt);
        const char* nA = has_next ? S.a_tile(nxt) : cA; const char* nB = has_next ? S.b_tile(nxt) : cB;
        if constexpr (Prob::GATHER) {
            if (has_next) {
#pragma unroll
                for (int i = 0; i < 2; ++i) { const int r0 = S.gidx[nxt.aux * 256 + RA[i]], r1 = S.gidx[nxt.aux * 256 + 128 + RA[i]];
                    gn0[i] = (unsigned)(r0 * lda + CA[i]) * 2u; gn1[i] = (unsigned)(r1 * lda + CA[i]) * 2u; }
            } else { gn0[0] = gc0[0]; gn0[1] = gc0[1]; gn1[0] = gc1[0]; gn1[1] = gc1[1]; }
        }
        PG8_TS(1, ui > 0);
#ifdef EXP_KDUP
        constexpr bool kdup = (STAMP == EXP_KDUP);
#else
        constexpr bool kdup = false;
#endif
        const int ntx = kdup ? 2 * nt : nt;
        for (int t = 0; t < ntx; t += 2) {
            const bool last = (t == ntx - 2);
            const int tw = kdup ? (t & (nt - 1)) : t, t2 = kdup ? ((t + 2) & (nt - 1)) : t + 2;
            const char* a1 = cA + (size_t)(tw + 1) * kstep;
            const char* a2 = last ? nA : cA + (size_t)t2 * kstep; const char* b2 = last ? nB : cB + (size_t)t2 * kstep;
            const char* a3 = a2 + kstep; const char* b3 = b2 + kstep;
            unsigned g20[2], g21[2];
            g20[0] = last ? gn0[0] : gc0[0]; g20[1] = last ? gn0[1] : gc0[1]; g21[0] = last ? gn1[0] : gc1[0]; g21[1] = last ? gn1[1] : gc1[1];
            PG8_LDB(B0, 0, 0); PG8_LDB(B1, 0, 1); PG8_SCHED; PG8_LDA(At, 0, 0); PG8_STAGE_A(PG8_SA(1, 1), a1, 1, gc0, gc1);
            PG8_WAIT_V(8); PG8_WAIT_L(0); PG8_BAR; PG8_MMA(0, 0, At, B0); PG8_MMA(0, 1, At, B1); PG8_BAR; PG8_SCHED;
            PG8_LDA(At, 0, 1); PG8_STAGE(PG8_SB(0, 0), b2, voffB); PG8_STAGE(PG8_SB(0, 1), b2 + hstepB, voffB); PG8_STAGE_A(PG8_SA(0, 0), a2, 0, g20, g21);
            PG8_WAIT_V(8); PG8_WAIT_L(0); PG8_BAR; PG8_MMA(1, 0, At, B0); PG8_MMA(1, 1, At, B1); PG8_BAR; PG8_SCHED;
            PG8_LDB(B0, 1, 0); PG8_LDB(B1, 1, 1); PG8_SCHED; PG8_LDA(At, 1, 0); PG8_STAGE_A(PG8_SA(0, 1), a2, 1, g20, g21);
            PG8_WAIT_V(8); PG8_WAIT_L(0); PG8_BAR; PG8_MMA(0, 0, At, B0); PG8_MMA(0, 1, At, B1); PG8_BAR; PG8_SCHED;
            PG8_LDA(At, 1, 1); PG8_STAGE(PG8_SB(1, 0), b3, voffB); PG8_STAGE(PG8_SB(1, 1), b3 + hstepB, voffB); PG8_STAGE_A(PG8_SA(1, 0), a3, 0, g20, g21);
            PG8_WAIT_V(8); PG8_WAIT_L(0); PG8_BAR; PG8_MMA(1, 0, At, B0); PG8_MMA(1, 1, At, B1); PG8_BAR; PG8_SCHED;
        }
        PG8_TS(0, true);
        if constexpr (F8) asm volatile("s_nop 15\n\ts_nop 15" ::: "memory");
        if constexpr (kdup) {
#pragma unroll
            for (int a = 0; a < 2; ++a)
#pragma unroll
                for (int b = 0; b < 2; ++b)
#pragma unroll
                    for (int m = 0; m < 4; ++m)
#pragma unroll
                        for (int n = 0; n < 2; ++n) acc[a][b][m][n] *= 0.5f; }
        if constexpr (ALIGN_EPI) { if (wr == 0) PG8_BAR; }
        E(acc, cur, wr, wc, fr, fq);
#ifdef EXP_EPI2
        if constexpr (STAMP == EXP_EPI2) { asm volatile("" ::: "memory"); E(acc, cur, wr, wc, fr, fq); }
#endif
#ifdef EXP_WAIT0
        PG8_WAIT_V(0);
#endif
        if (!has_next) break;
#pragma unroll
        for (int a = 0; a < 2; ++a)
#pragma unroll
            for (int b = 0; b < 2; ++b)
#pragma unroll
                for (int m = 0; m < 4; ++m)
#pragma unroll
                    for (int n = 0; n < 2; ++n) acc[a][b][m][n] = (f32x4){0.f, 0.f, 0.f, 0.f};
        cur = nxt; cA = nA; cB = nB; ++ui;
        if constexpr (Prob::GATHER) { gc0[0] = gn0[0]; gc0[1] = gn0[1]; gc1[0] = gn1[0]; gc1[1] = gn1[1]; }
        if constexpr (ALIGN_EPI) { if (wr == 1) PG8_BAR; }
    }
    PG8_WAIT_V(0);
    if constexpr (!ALIGN_EPI) { if (wr == 0) PG8_BAR; }
    PG8_BAR;
#undef PG8_TS
#undef PG8_SA
#undef PG8_SB
#undef PG8_STAGE
#undef PG8_STAGE_A
#undef PG8_LDA
#undef PG8_LDB
#undef PG8_MMA
#undef PG8_WAIT_V
#undef PG8_WAIT_L
#undef PG8_BAR
#undef PG8_SCHED
}
}
namespace pg8 {
struct ProbDense {
    static constexpr bool GATHER = false; const LAS int* gidx;
    int K; const bf16* A; const bf16* Bt; int nM, nN, G, c;
    int ldA = 0, ldB = 0;
    __device__ __forceinline__ int lda() const { return ldA ? ldA : K; }
    __device__ __forceinline__ int ldb() const { return ldB ? ldB : K; }
    __device__ __forceinline__ bool next(int i, Unit& u) const { u.e = 0; u.aux = 0; return static_tile(nM, nN, G, c, i, u.pm, u.pn); }
    __device__ __forceinline__ const char* a_tile(const Unit& u) const { return (const char*)A + (size_t)u.pm * 256 * lda() * 2; }
    __device__ __forceinline__ const char* b_tile(const Unit& u) const { return (const char*)Bt + (size_t)u.pn * 256 * ldb() * 2; }
};
struct ProbBatched {
    static constexpr bool GATHER = false; const LAS int* gidx;
    int K; const bf16* A; const bf16* Bt; size_t bstride  ; int nPm, nPn, nb, G, c;
    __device__ __forceinline__ int lda() const { return K; } __device__ __forceinline__ int ldb() const { return K; }
    __device__ __forceinline__ bool next(int i, Unit& u) const {
        const int per = nPm * nPn; int b, r;
        if (G == 256 && nb == 8) { b = c & 7; r = i * 32 + (c >> 3); if (r >= per) return false; }
        else { const int L = i * G + c; if (L >= nb * per) return false; b = L / per; r = L % per; }
        u.e = b; u.pm = r / nPn; u.pn = r % nPn; u.aux = 0; return true; }
    __device__ __forceinline__ const char* a_tile(const Unit& u) const { return (const char*)A + (size_t)u.pm * 256 * K * 2; }
    __device__ __forceinline__ const char* b_tile(const Unit& u) const { return (const char*)(Bt + (size_t)u.e * bstride) + (size_t)u.pn * 256 * K * 2; }
};
constexpr int XT_OFF = 131072, XT_MAXU = 24, XT_UT = XT_OFF, XT_XI = XT_OFF + XT_MAXU * 16;
struct ProbGU {
    static constexpr bool GATHER = true; const LAS int* gidx  ;
    int K; const bf16* A; const bf16* W; const LAS int* ut;
    __device__ __forceinline__ int lda() const { return K; } __device__ __forceinline__ int ldb() const { return K; }
    __device__ __forceinline__ bool next(int i, Unit& u) const {
        if (i >= XT_MAXU) return false; if (__builtin_amdgcn_readfirstlane(ut[i * 4 + 3]) == 0) return false;
        u.pm = __builtin_amdgcn_readfirstlane(ut[i * 4]); u.pn = __builtin_amdgcn_readfirstlane(ut[i * 4 + 1]); u.e = __builtin_amdgcn_readfirstlane(ut[i * 4 + 2]); u.aux = i; return true; }
    __device__ __forceinline__ const char* a_tile(const Unit&) const { return (const char*)A; }
    __device__ __forceinline__ const char* b_tile(const Unit& u) const { return (const char*)W + ((size_t)u.e * 512 + (size_t)u.pn * 256) * K * 2; }
};
struct ProbDown {
    static constexpr bool GATHER = false; const LAS int* gidx;
    int K; const bf16* A; const bf16* W; const LAS int* ut;
    __device__ __forceinline__ int lda() const { return K; } __device__ __forceinline__ int ldb() const { return K; }
    __device__ __forceinline__ bool next(int i, Unit& u) const {
        if (i >= XT_MAXU) return false; if (__builtin_amdgcn_readfirstlane(ut[i * 4 + 3]) == 0) return false;
        u.pm = __builtin_amdgcn_readfirstlane(ut[i * 4]); u.pn = __builtin_amdgcn_readfirstlane(ut[i * 4 + 1]); u.e = __builtin_amdgcn_readfirstlane(ut[i * 4 + 2]); u.aux = i; return true; }
    __device__ __forceinline__ const char* a_tile(const Unit& u) const { return (const char*)A + (size_t)u.pm * 256 * K * 2; }
    __device__ __forceinline__ const char* b_tile(const Unit& u) const { return (const char*)W + ((size_t)u.e * 1024 + (size_t)u.pn * 256) * K * 2; }
};

typedef f32x4 Acc[2][2][4][2];
template <class T> __device__ __forceinline__ T* at(T* base, unsigned byte_off) { return (T*)((char*)base + byte_off); }
template <class T> __device__ __forceinline__ const T* at(const T* base, unsigned byte_off) { return (const T*)((const char*)base + byte_off); }
#ifndef USE_NT
template <class V> __device__ __forceinline__ void st_stream(V* p, const V& v) { *p = v; }
#else
template <class V> __device__ __forceinline__ void st_stream(V* p, const V& v) { __builtin_nontemporal_store(v, p); }
#endif
__device__ __forceinline__ u32x4 pack_bf16x8(const f32x4& v0, const f32x4& v1) { u32x4 w; w.x = cvt_pk_bf16(v0[0], v0[1]); w.y = cvt_pk_bf16(v0[2], v0[3]); w.z = cvt_pk_bf16(v1[0], v1[1]); w.w = cvt_pk_bf16(v1[2], v1[3]); return w; }
constexpr float YS_SCALE = 16.f, YS_INV = 1.f / 16.f;
__device__ __forceinline__ unsigned pack_fp8x4(float a, float b, float c, float d) {
    a = fminf(fmaxf(a, -448.f), 448.f); b = fminf(fmaxf(b, -448.f), 448.f); c = fminf(fmaxf(c, -448.f), 448.f); d = fminf(fmaxf(d, -448.f), 448.f);
    int w = 0; w = __builtin_amdgcn_cvt_pk_fp8_f32(a, b, w, false); w = __builtin_amdgcn_cvt_pk_fp8_f32(c, d, w, true); return (unsigned)w; }
__device__ __forceinline__ u32x2 pack_fp8x8(const f32x4& v0, const f32x4& v1, float sc) { u32x2 w; w.x = pack_fp8x4(v0[0] * sc, v0[1] * sc, v0[2] * sc, v0[3] * sc); w.y = pack_fp8x4(v1[0] * sc, v1[1] * sc, v1[2] * sc, v1[3] * sc); return w; }
struct EpiInproj {
    static constexpr int PERM = 2; bf16* O; unsigned char* G8; unsigned char* GR8; float inv  ;
    __device__ __forceinline__ void operator()(const Acc& acc0, const Unit& u, int wr, int wc, int fr, int fq) const {
        Acc acc;
#pragma unroll
        for (int a_ = 0; a_ < 2; ++a_)
#pragma unroll
            for (int b_ = 0; b_ < 2; ++b_)
#pragma unroll
                for (int m_ = 0; m_ < 4; ++m_)
#pragma unroll
                    for (int n_ = 0; n_ < 2; ++n_) acc[a_][b_][m_][n_] = acc0[a_][b_][m_][n_] * inv;
        const int row = u.pm * 256 + wr * 64 + fr, col = u.pn * 256 + wc * 64 + 16 * fq;
        if (u.pn >= C_GR / 256 && u.pn < C_GL / 256) {
            const unsigned o0 = (unsigned)(row * 1024 + col - C_GR);
#pragma unroll
            for (int ai = 0; ai < 2; ++ai)
#pragma unroll
                for (int m = 0; m < 4; ++m) { const u32x2 lo = pack_fp8x8(acc[ai][0][m][0], acc[ai][0][m][1], YS_SCALE), hi = pack_fp8x8(acc[ai][1][m][0], acc[ai][1][m][1], YS_SCALE);
                    u32x4 w; w.x = lo.x; w.y = lo.y; w.z = hi.x; w.w = hi.y; *(u32x4*)at(GR8, o0 + (unsigned)(ai * HALF + m * 16) * 1024u) = w; }
        } else if (u.pn < C_GL / 256) {
            const unsigned o0 = (unsigned)(row * INW + col) * 2u;
#pragma unroll
            for (int ai = 0; ai < 2; ++ai)
#pragma unroll
                for (int m = 0; m < 4; ++m)
#pragma unroll
                    for (int bj = 0; bj < 2; ++bj) *(u32x4*)at(O, o0 + (unsigned)(ai * HALF + m * 16) * (INW * 2u) + bj * 16) = pack_bf16x8(acc[ai][bj][m][0], acc[ai][bj][m][1]);
        } else {
            const unsigned o0 = (unsigned)(row * 3072 + col - C_GL);
#pragma unroll
            for (int ai = 0; ai < 2; ++ai)
#pragma unroll
                for (int m = 0; m < 4; ++m) { const u32x2 lo = pack_fp8x8(acc[ai][0][m][0], acc[ai][0][m][1], YS_SCALE), hi = pack_fp8x8(acc[ai][1][m][0], acc[ai][1][m][1], YS_SCALE);
                    u32x4 w; w.x = lo.x; w.y = lo.y; w.z = hi.x; w.w = hi.y; *(u32x4*)at(G8, o0 + (unsigned)(ai * HALF + m * 16) * 3072u) = w; }
        }
    }
};
struct EpiFp8Plain {
    static constexpr int PERM = 2; unsigned char* O; int ldc; float sc;
    __device__ __forceinline__ void operator()(const Acc& acc, const Unit& u, int wr, int wc, int fr, int fq) const {
        const unsigned o0 = (unsigned)((u.pm * 256 + wr * 64 + fr) * ldc + u.pn * 256 + wc * 64 + 16 * fq), rs = (unsigned)ldc;
#pragma unroll
        for (int ai = 0; ai < 2; ++ai)
#pragma unroll
            for (int m = 0; m < 4; ++m) { const u32x2 lo = pack_fp8x8(acc[ai][0][m][0], acc[ai][0][m][1], sc), hi = pack_fp8x8(acc[ai][1][m][0], acc[ai][1][m][1], sc);
                u32x4 w; w.x = lo.x; w.y = lo.y; w.z = hi.x; w.w = hi.y; *(u32x4*)at(O, o0 + (unsigned)(ai * HALF + m * 16) * rs) = w; }
    }
};
struct EpiBf16Plain {
    static constexpr int PERM = 1; bf16* O; int ldc;
    __device__ __forceinline__ void operator()(const Acc& acc, const Unit& u, int wr, int wc, int fr, int fq) const {
        const unsigned o0 = (unsigned)((u.pm * 256 + wr * 64 + fr) * ldc + u.pn * 256 + wc * 32 + 8 * fq) * 2u, rs = (unsigned)ldc * 2u;
#pragma unroll
        for (int ai = 0; ai < 2; ++ai)
#pragma unroll
            for (int m = 0; m < 4; ++m)
#pragma unroll
                for (int bj = 0; bj < 2; ++bj) { const u32x4 w = pack_bf16x8(acc[ai][bj][m][0], acc[ai][bj][m][1]); u32x4* p = (u32x4*)at(O, o0 + (unsigned)(ai * HALF + m * 16) * rs + bj * HALF * 2);
                    *p = w;
#ifdef EXP_DOUBLE_STORE
                    if (ldc == INW) { asm volatile("" ::: "memory"); *p = w; asm volatile("" ::: "memory"); }
#endif
                }
    }
};
struct EpiFourier {
    static constexpr int PERM = 1; unsigned char* FF  ; int rowbase, rows_b, hp, mirror; float osc  ;
    __device__ __forceinline__ void operator()(const Acc& acc, const Unit& u, int wr, int wc, int fr, int fq) const {
        const int reim = u.pm / hp, pr = u.pm % hp;
        const int n0 = pr * 256 + wr * 64 + fr, rb = rowbase + u.e * rows_b;
        const unsigned c0 = (unsigned)(reim * 512 + u.pn * 256 + wc * 32 + 8 * fq);
        const float sg = (mirror && reim) ? -osc : osc;
#pragma unroll
        for (int ai = 0; ai < 2; ++ai)
#pragma unroll
            for (int m = 0; m < 4; ++m) { const int np = n0 + ai * HALF + m * 16;
#pragma unroll
                for (int bj = 0; bj < 2; ++bj) {
                    *(u32x2*)at(FF, (unsigned)(rb + np) * 1024u + c0 + bj * HALF) = pack_fp8x8(acc[ai][bj][m][0], acc[ai][bj][m][1], osc);
                    if (mirror && np != 0) *(u32x2*)at(FF, (unsigned)(rb + rows_b - np) * 1024u + c0 + bj * HALF) = pack_fp8x8(acc[ai][bj][m][0], acc[ai][bj][m][1], sg); } }
    }
};
struct EpiF32 {
    static constexpr int PERM = 0; float* C; int ldc;
    __device__ __forceinline__ void operator()(const Acc& acc, const Unit& u, int wr, int wc, int fr, int fq) const {
        const unsigned o0 = (unsigned)((u.pm * 256 + wr * 64 + fr) * ldc + u.pn * 256 + wc * 32 + 4 * fq) * 4u, rs = (unsigned)ldc * 4u;
#pragma unroll
        for (int ai = 0; ai < 2; ++ai)
#pragma unroll
            for (int m = 0; m < 4; ++m)
#pragma unroll
                for (int bj = 0; bj < 2; ++bj)
#pragma unroll
                    for (int n = 0; n < 2; ++n) *(f32x4*)at(C, o0 + (unsigned)(ai * HALF + m * 16) * rs + (bj * HALF + n * 16) * 4) = acc[ai][bj][m][n];
    }
};
template <int MODE  > struct EpiGate {
    static constexpr int PERM = 0; float* Y; bf16* YB; const bf16* P; int br;
    __device__ __forceinline__ void operator()(const Acc& acc, const Unit& u, int wr, int wc, int fr, int fq) const {
        const int row0 = u.pm * 256 + wr * 64 + fr, col0 = u.pn * 256 + wc * 32 + 4 * fq;
        const unsigned e0 = (unsigned)(row0 * 1024 + col0), p0 = (unsigned)(row0 * INW + C_GL + br * 1024 + col0) * 2u;
#pragma unroll
        for (int ai = 0; ai < 2; ++ai)
#pragma unroll
            for (int m = 0; m < 4; ++m)
#pragma unroll
                for (int bj = 0; bj < 2; ++bj)
#pragma unroll
                    for (int n = 0; n < 2; ++n) { const unsigned rr = (unsigned)(ai * HALF + m * 16), cc = (unsigned)(bj * HALF + n * 16), e = e0 + rr * 1024u + cc;
                        const u32x2 gw = *(const u32x2*)at(P, p0 + rr * (INW * 2u) + cc * 2u);
                        f32x4 g; g[0] = sigmoidf_(bflo(gw.x)); g[1] = sigmoidf_(bfhi(gw.x)); g[2] = sigmoidf_(bflo(gw.y)); g[3] = sigmoidf_(bfhi(gw.y));
                        f32x4 v = acc[ai][bj][m][n] * g;
                        if (MODE >= 1) v += *(const f32x4*)at(Y, e * 4u);
                        if (MODE <= 1) *(f32x4*)at(Y, e * 4u) = v;
                        else { u32x2 w; w.x = cvt_pk_bf16(v[0], v[1]); w.y = cvt_pk_bf16(v[2], v[3]); *(u32x2*)at(YB, e * 2u) = w; } }
    }
};
struct EpiWout {
    static constexpr int PERM = 0; float* tmix; const float* xlat; const float* xctx; const float* modl  ; int goff  ;
    __device__ __forceinline__ void operator()(const Acc& acc, const Unit& u, int wr, int wc, int fr, int fq) const {
        const int rowt = u.pm * 256; const bool isctx = rowt >= T_LAT;
        const int v = isctx ? 8 : rowt / NSEQ;
        const float* xs = isctx ? xctx + (size_t)(rowt - T_LAT) * 1024 : xlat + (size_t)rowt * 1024;
        float* tm = tmix + (size_t)rowt * 1024;
        const float* gv = modl + v * 6144 + goff;
        const unsigned col0 = (unsigned)(u.pn * 256 + wc * 32 + 4 * fq), e0 = (unsigned)((wr * 64 + fr) * 1024) + col0;
        f32x4 gg[2][2];
#pragma unroll
        for (int bj = 0; bj < 2; ++bj)
#pragma unroll
            for (int n = 0; n < 2; ++n) gg[bj][n] = *(const f32x4*)at(gv, (col0 + bj * HALF + n * 16) * 4u);
#pragma unroll
        for (int ai = 0; ai < 2; ++ai)
#pragma unroll
            for (int m = 0; m < 4; ++m)
#pragma unroll
                for (int bj = 0; bj < 2; ++bj)
#pragma unroll
                    for (int n = 0; n < 2; ++n) { const unsigned e = (e0 + (unsigned)(ai * HALF + m * 16) * 1024u + (unsigned)(bj * HALF + n * 16)) * 4u;
                        const f32x4 xv = *(const f32x4*)at(xs, e);
                        *(f32x4*)at(tm, e) = xv * DN_ALPHA + gg[bj][n] * acc[ai][bj][m][n]; }
    }
};
struct EpiSwiglu {
    static constexpr int PERM = 1; unsigned char* ACT; float inv;
    __device__ __forceinline__ void operator()(const Acc& acc, const Unit& u, int wr, int wc, int fr, int fq) const {
        const unsigned o0 = (unsigned)((u.pm * 256 + wr * 64 + fr) * 256 + u.pn * 128 + wc * 32 + 8 * fq);
#pragma unroll
        for (int ai = 0; ai < 2; ++ai)
#pragma unroll
            for (int m = 0; m < 4; ++m) {
                const f32x4 g0 = acc[ai][0][m][0] * inv, g1 = acc[ai][0][m][1] * inv, u0 = acc[ai][1][m][0] * inv, u1 = acc[ai][1][m][1] * inv;
                f32x4 a, b;
#pragma unroll
                for (int j = 0; j < 4; ++j) { a[j] = siluf_(g0[j]) * u0[j]; b[j] = siluf_(g1[j]) * u1[j]; }
                *(u32x2*)at(ACT, o0 + (unsigned)(ai * HALF + m * 16) * 256u) = pack_fp8x8(a, b, YS_SCALE); }
    }
};
struct EpiDown {
    static constexpr int PERM = 2; unsigned char* Y; const LAS float* sw  ; float osc  ;
    __device__ __forceinline__ void operator()(const Acc& acc, const Unit& u, int wr, int wc, int fr, int fq) const {
        const int r0 = u.pm * 256 + wr * 64 + fr; const LAS float* swu = sw + u.aux * 256 + wr * 64 + fr;
        const unsigned o0 = (unsigned)(r0 * 1024 + u.pn * 256 + wc * 64 + 16 * fq);
#pragma unroll
        for (int ai = 0; ai < 2; ++ai)
#pragma unroll
            for (int m = 0; m < 4; ++m) { const float w8 = swu[ai * HALF + m * 16] * osc;
                if (w8 != 0.f) {
                    u32x4 w;
                    { const f32x4 v0 = acc[ai][0][m][0] * w8, v1 = acc[ai][0][m][1] * w8; w.x = pack_fp8x4(v0[0], v0[1], v0[2], v0[3]); w.y = pack_fp8x4(v1[0], v1[1], v1[2], v1[3]); }
                    { const f32x4 v0 = acc[ai][1][m][0] * w8, v1 = acc[ai][1][m][1] * w8; w.z = pack_fp8x4(v0[0], v0[1], v0[2], v0[3]); w.w = pack_fp8x4(v1[0], v1[1], v1[2], v1[3]); }
                    *(u32x4*)at(Y, o0 + (unsigned)(ai * HALF + m * 16) * 1024u) = w; } }
    }
};
}
struct Frame {
    LAS unsigned char* lds; int tid, lane, wave, G, bid;
    unsigned char* ws;
};
#ifndef GMASK
#define GMASK 0x1u
#endif
#define PHG_ON (((GMASK >> PHG) & 1u) != 0)
template <bool G> __device__ __forceinline__ const float* karg_t(int i) {
    unsigned long long p = (unsigned long long)__builtin_amdgcn_kernarg_segment_ptr();
    asm volatile("" : "+s"(p));
    if (!G) return ((const float* const __attribute__((address_space(4)))*)p)[i];
    return (const float*)(((const float __attribute__((address_space(1)))* const __attribute__((address_space(4)))*)p)[i]);
}
#define KIN(i) karg_t<PHG_ON>(i)
#define karg(i) KIN(i)
__device__ __forceinline__ int karg_int(int byte_off) {
    unsigned long long p = (unsigned long long)__builtin_amdgcn_kernarg_segment_ptr();
    asm volatile("" : "+s"(p));
    return *(const int __attribute__((address_space(4)))*)(p + byte_off);
}
#ifdef SUBSEL
__device__ __forceinline__ void substamp_(LAS unsigned char* lds, int k, bool add) {
    volatile LAS unsigned* sb = (volatile LAS unsigned*)(lds + MISC_OFF + 288);
    const unsigned n = (unsigned)__builtin_amdgcn_s_memrealtime();
    if (add) sb[k] += n - sb[15];
    sb[15] = n;
}
#define SUBSTAMP(k) do { if (F.bid == 0 && F.wave == 0) substamp_(F.lds, (k), true); } while (0)
#define SUBRESET() do { if (F.bid == 0 && F.wave == 0) substamp_(F.lds, 0, false); } while (0)
#else
#define SUBSTAMP(k) do { } while (0)
#define SUBRESET() do { } while (0)
#endif
enum { I_X = 0, I_C, I_CTX, I_CCTX, I_ADAW, I_ADAB, I_WIN, I_RPB, I_WONA, I_WFOUR, I_DECF, I_DECB, I_GNW, I_WORET, I_WOUT, I_LNMW, I_LNMB,
       I_ROUTW, I_ROUTB, I_EWG, I_EWU, I_EWD, I_SWG, I_SWU, I_SWD, I_LNFW, I_LNFB };
template <bool G> __device__ __forceinline__ unsigned char* ws_opaque_t(unsigned char* p) { unsigned long long v = (unsigned long long)p; asm volatile("" : "+s"(v));
    if (G) return (unsigned char*)(__attribute__((address_space(1))) unsigned char*)v;
    return (unsigned char*)v; }
#define ws_opaque(p) ws_opaque_t<PHG_ON>(p)
#define WSP(T, off) ((T*)(ws_opaque(F.ws) + (off)))
constexpr int NWAVES = 8;
#define PHG 1

__device__ __forceinline__ void tr_item(const float* W, int N, int k0, int n0, bf16* WT, int ldt, int drow0, LAS float* scr, int lane) {
#pragma unroll
    for (int hb = 0; hb < 2; ++hb) { float wv[16];
#pragma unroll
        for (int i = 0; i < 16; ++i) { const int kk = 2 * (16 * hb + i) + (lane >> 5); wv[i] = W[(size_t)(k0 + kk) * N + n0 + (lane & 31)]; }
#pragma unroll
        for (int i = 0; i < 16; ++i) { const int kk = 2 * (16 * hb + i) + (lane >> 5); scr[kk * 33 + (lane & 31)] = wv[i]; } }
    LDS_WAIT(); asm volatile("" ::: "memory");
    const int c = lane & 7;
#pragma unroll
    for (int j = 0; j < 4; ++j) { const int n = (lane >> 3) + 8 * j; const LAS float* s = scr + (8 * c) * 33 + n;
        u32x4 o; o.x = pk2(s[0 * 33], s[1 * 33]); o.y = pk2(s[2 * 33], s[3 * 33]); o.z = pk2(s[4 * 33], s[5 * 33]); o.w = pk2(s[6 * 33], s[7 * 33]);
        *(u32x4*)(WT + (size_t)(drow0 + n) * ldt + k0 + 8 * c) = o; }
    LDS_WAIT(); asm volatile("" ::: "memory");
}

__device__ __forceinline__ void row_load(const float* p, int lane, f32x4 (&v)[4]) {
#pragma unroll
    for (int j = 0; j < 4; ++j) v[j] = __builtin_nontemporal_load((const f32x4*)(p + 4 * lane + 256 * j));
}
__device__ __forceinline__ void row_ln(f32x4 (&v)[4]) {
    float s = 0.f;
#pragma unroll
    for (int j = 0; j < 4; ++j) s += (v[j][0] + v[j][1]) + (v[j][2] + v[j][3]);
    const float mean = wave_sum(s) * (1.f / D); float s2 = 0.f;
#pragma unroll
    for (int j = 0; j < 4; ++j) { v[j] = v[j] - mean; s2 += (v[j][0] * v[j][0] + v[j][1] * v[j][1]) + (v[j][2] * v[j][2] + v[j][3] * v[j][3]); }
    const float rstd = 1.f / sqrtf(wave_sum(s2) * (1.f / D) + LN_EPS);
#pragma unroll
    for (int j = 0; j < 4; ++j) v[j] = v[j] * rstd;
}
__device__ __forceinline__ void row_affine(f32x4 (&v)[4], const float* w, const float* b, int lane, bool one_plus) {
#pragma unroll
    for (int j = 0; j < 4; ++j) { f32x4 ww = *(const f32x4*)(w + 4 * lane + 256 * j); const f32x4 bb = *(const f32x4*)(b + 4 * lane + 256 * j);
        if (one_plus) ww = ww + 1.f; v[j] = v[j] * ww + bb; }
}
__device__ __forceinline__ void row_affine_r(f32x4 (&v)[4], const f32x4 (&w)[4], const f32x4 (&b)[4], bool one_plus) {
#pragma unroll
    for (int j = 0; j < 4; ++j) { f32x4 ww = w[j]; if (one_plus) ww = ww + 1.f; v[j] = v[j] * ww + b[j]; }
}
__device__ __forceinline__ void row_store_bf16(bf16* p, int lane, const f32x4 (&v)[4]) {
#pragma unroll
    for (int j = 0; j < 4; ++j) { u32x2 w; w.x = pk2(v[j][0], v[j][1]); w.y = pk2(v[j][2], v[j][3]); *(u32x2*)(p + 4 * lane + 256 * j) = w; }
}
__device__ __forceinline__ void row_store_bf16_nt(bf16* p, int lane, const f32x4 (&v)[4]) {
#pragma unroll
    for (int j = 0; j < 4; ++j) { u32x2 w; w.x = pk2(v[j][0], v[j][1]); w.y = pk2(v[j][2], v[j][3]); __builtin_nontemporal_store(w, (u32x2*)(p + 4 * lane + 256 * j)); }
}
__device__ __forceinline__ void row_store_f32(float* p, int lane, const f32x4 (&v)[4]) {
#pragma unroll
    for (int j = 0; j < 4; ++j) *(f32x4*)(p + 4 * lane + 256 * j) = v[j];
}
__device__ __forceinline__ const float* mod_vec(const Frame& F, int l, int row) {
    const int v = row >= T_LAT ? 8 : row / NSEQ; return WSP(const float, WS_MOD) + ((size_t)l * 9 + v) * 6144;
}

constexpr int TRF_P = 72, TRF_BYTES = 128 * TRF_P * 2;
__device__ __forceinline__ void tr_item_fast(const float* W, int N, int k0, int n0, bf16* WT, int ldt, int drow0, LAS bf16* tl, int lane) {
    const int hf = lane >> 5, c = lane & 31;
    f32x4 v[16][2];
#pragma unroll
    for (int i = 0; i < 16; ++i)
#pragma unroll
        for (int q = 0; q < 2; ++q) v[i][q] = *(const f32x4*)(W + (size_t)(k0 + 4 * i + 2 * hf + q) * N + n0 + 4 * c);
#pragma unroll
    for (int i = 0; i < 16; ++i)
#pragma unroll
        for (int j = 0; j < 4; ++j) *(LAS unsigned*)(tl + (4 * c + j) * TRF_P + 4 * i + 2 * hf) = pk2(v[i][0][j], v[i][1][j]);
    LDS_WAIT(); asm volatile("" ::: "memory");
#pragma unroll
    for (int it = 0; it < 16; ++it) { const int p = it * 64 + lane, n = p >> 3, kc = p & 7;
        *(u32x4*)(WT + (size_t)(drow0 + n) * ldt + k0 + 8 * kc) = *(const LAS u32x4*)(tl + n * TRF_P + 8 * kc); }
    LDS_WAIT(); asm volatile("" ::: "memory");
}
__device__ __forceinline__ void tr_item_fast8(const float* W, int N, int k0, int n0, unsigned char* WT8, int ldt, int drow0, LAS unsigned char* tl, int lane, float wscale) {
    const int hf = lane >> 5, c = lane & 31;
    f32x4 v[8][4];
#pragma unroll
    for (int i = 0; i < 8; ++i)
#pragma unroll
        for (int q = 0; q < 4; ++q) v[i][q] = __builtin_nontemporal_load((const f32x4*)(W + (size_t)(k0 + 8 * i + 4 * hf + q) * N + n0 + 4 * c));
#pragma unroll
    for (int i = 0; i < 8; ++i)
#pragma unroll
        for (int j = 0; j < 4; ++j) *(LAS unsigned*)(tl + (4 * c + j) * 80 + 8 * i + 4 * hf) = pg8::pack_fp8x4(v[i][0][j] * wscale, v[i][1][j] * wscale, v[i][2][j] * wscale, v[i][3][j] * wscale);
    LDS_WAIT(); asm volatile("" ::: "memory");
#pragma unroll
    for (int it = 0; it < 8; ++it) { const int p = it * 64 + lane, n = p >> 2, kc = p & 3;
        *(u32x4*)(WT8 + (size_t)(drow0 + n) * ldt + k0 + 16 * kc) = *(const LAS u32x4*)(tl + n * 80 + 16 * kc); }
    LDS_WAIT(); asm volatile("" ::: "memory");
}
constexpr float WGU_SCALE = 32.f;
#undef PHG
#define PHG 1
__device__ __forceinline__ void phase_init(const Frame& F_) {
    Frame F = F_; asm volatile("" : "+s"(F.bid), "+s"(F.G), "+s"(F.wave)); F.lane = lane_id_(); asm volatile("" : "+v"(F.lane)); F.tid = F.wave * 64 + F.lane;
    const int gw = F.bid * NWAVES + F.wave, NGW = F.G * NWAVES;
    {
        LAS float* red = (LAS float*)F.lds;
        float* mod = WSP(float, WS_MOD);
        for (int u = F.bid; u < 2 * 96; u += F.G) {
            const int l = u / 96, n0 = (u % 96) * 64;
            const float* aw = KIN(I_ADAW) + (size_t)l * D * 6144;
            float acc[9];
#pragma unroll
            for (int v = 0; v < 9; ++v) acc[v] = 0.f;
            const float* cin = KIN(I_C); const float* ccx = KIN(I_CCTX);
            LAS float* sct = (LAS float*)(F.lds + 32768) + F.wave * (9 * 128);
            for (int i = F.lane; i < 9 * 128; i += 64) { const int v = i >> 7, k = F.wave * 128 + (i & 127); sct[i] = siluf_(v < 8 ? cin[v * D + k] : ccx[k]); }
            LDS_WAIT(); asm volatile("" ::: "memory");
            for (int kk = 0; kk < 128; kk += 16) { const int k0 = F.wave * 128 + kk;
                float wv[16];
#pragma unroll
                for (int j = 0; j < 16; ++j) wv[j] = aw[(size_t)(k0 + j) * 6144 + n0 + F.lane];
#pragma unroll
                for (int j = 0; j < 16; ++j)
#pragma unroll
                    for (int v = 0; v < 9; ++v) acc[v] += sct[v * 128 + kk + j] * wv[j];
            }
#pragma unroll
            for (int v = 0; v < 9; ++v) red[(F.wave * 9 + v) * 64 + F.lane] = acc[v];
            __syncthreads();
            for (int o = F.tid; o < 9 * 64; o += 512) { const int v = o / 64, ln = o % 64; float s = 0.f;
#pragma unroll
                for (int w = 0; w < 8; ++w) s += red[(w * 9 + v) * 64 + ln];
                mod[((size_t)l * 9 + v) * 6144 + n0 + ln] = s + KIN(I_ADAB)[(size_t)l * 6144 + n0 + ln]; }
            __syncthreads();
        }
    }
    {
        float* rc = WSP(float, WS_ROPE); float* rs = rc + 2048;
        for (int i = F.bid * 512 + F.tid; i < 2048; i += F.G * 512) { const int pos = i / 32, f = i % 32;
            const double ang = (double)pos * pow(10000.0, -(double)f / 32.0); rc[i] = (float)cos(ang); rs[i] = (float)sin(ang); }
    }
    {
        __syncthreads();
#define COSREV(m_) __builtin_amdgcn_cosf((float)(m_) * (1.0f / 4096.0f))
        LAS float* ctab = (LAS float*)F.lds;
        for (int i = F.tid; i < 4096; i += 512) ctab[i] = cospif((float)i * (1.0f / 2048.0f));
        __syncthreads();
        unsigned char* dft = WSP(unsigned char, WS_DFT);
        for (size_t i = (size_t)F.bid * 512 + F.tid; i < (size_t)4096 * 512; i += (size_t)F.G * 512) {
            const int row = (int)(i / 512), n0 = (int)(i % 512) * 8, reim = row / 2048, np = row % 2048; float v[8];
#pragma unroll
            for (int j = 0; j < 8; ++j) { const int m = ((n0 + j) * np) & 4095; v[j] = (reim ? -COSREV((m - 1024) & 4095) : COSREV(m)) * 64.f; }
            u32x2 o; o.x = pg8::pack_fp8x4(v[0], v[1], v[2], v[3]); o.y = pg8::pack_fp8x4(v[4], v[5], v[6], v[7]);
            *(u32x2*)(dft + (size_t)row * 4096 + n0) = o;
        }
        bf16* dftc = WSP(bf16, WS_DFTC); const float scc = 1.0f / 181.01933598375618f;
        for (int i = F.bid * 512 + F.tid; i < 512 * 32; i += F.G * 512) {
            const int row = i / 32, n0 = (i % 32) * 8, reim = row / 256, np = row % 256; float v[8];
#pragma unroll
            for (int j = 0; j < 8; ++j) { const int m = (((n0 + j) * np) & 255) * 16; v[j] = (reim ? -COSREV((m - 1024) & 4095) : COSREV(m)) * scc; }
            u32x4 o; o.x = pk2(v[0], v[1]); o.y = pk2(v[2], v[3]); o.z = pk2(v[4], v[5]); o.w = pk2(v[6], v[7]);
            *(u32x4*)(dftc + (size_t)row * 256 + n0) = o;
        }
        __syncthreads();
    }
    {
        LAS float* scr = (LAS float*)(F.lds + 16384 + F.wave * 16384);
        constexpr int I_IN = 16 * 64, I_NA = 8 * 8, I_RET = 16 * 8, I_OUT = 16 * 8, I_RT = 16 * 8, PER = I_IN + I_NA + I_RET + I_OUT + I_RT;
        for (int it = gw; it < 2 * PER; it += NGW) {
            const int l = it / PER; int r = it % PER; unsigned char* wb = ws_opaque(F.ws) + WS_WNE + (size_t)l * WNE_STRIDE;
            const float* W; int K, N; bf16* WT;
            if (r < I_IN) {
                tr_item_fast8(KIN(I_WIN) + (size_t)l * 1024 * 8192, 8192, (r / 64) * 64, (r % 64) * 128, wb + WNE_WIN, WIN_LD, (r % 64) * 128, (LAS unsigned char*)scr, F.lane, WGU_SCALE); continue; }
            else if ((r -= I_IN) < I_NA) {
                tr_item_fast8(KIN(I_WONA) + (size_t)l * 512 * 1024, 1024, (r / 8) * 64, (r % 8) * 128, wb + WNE_ONA, 512, (r % 8) * 128, (LAS unsigned char*)scr, F.lane, WGU_SCALE); continue; }
            else if ((r -= I_NA) < I_RET) {
                tr_item_fast8(KIN(I_WORET) + (size_t)l * 1024 * 1024, 1024, (r / 8) * 64, (r % 8) * 128, wb + WNE_ORET, 1024, (r % 8) * 128, (LAS unsigned char*)scr, F.lane, WGU_SCALE); continue; }
            else if ((r -= I_RET) < I_OUT) {
                tr_item_fast8(KIN(I_WOUT) + (size_t)l * 1024 * 1024, 1024, (r / 8) * 64, (r % 8) * 128, wb + WNE_WOUT, 1024, (r % 8) * 128, (LAS unsigned char*)scr, F.lane, WGU_SCALE); continue; }
            else { r -= I_OUT; W = KIN(I_ROUTW) + (size_t)l * 1024 * 256; K = 1024; N = 256; WT = (bf16*)(wb + WNE_ROUT); }
            const int nblk = N / 32, kb = r / nblk, nb = r % nblk;
            tr_item(W, N, kb * 64, nb * 32, WT, K, nb * 32, scr, F.lane);
        }
        __syncthreads();
        LAS float* ctab2 = (LAS float*)F.lds;
        for (int i = F.tid; i < 4096; i += 512) ctab2[i] = cospif((float)i * (1.0f / 2048.0f));
        __syncthreads();
        for (int it = gw; it < 2 * 4 * 16 * 16; it += NGW) {
            const int l = it >> 10, r = it & 1023, g = r >> 8, c0 = ((r >> 4) & 15) * 8, n = (r & 15) * 64 + F.lane;
            const float* wf = KIN(I_WFOUR) + (size_t)l * 512 * 1024 + (size_t)g * 128 * 1024 + n;
            float ar[8], ai[8];
#pragma unroll
            for (int q = 0; q < 8; ++q) { ar[q] = 0.f; ai[q] = 0.f; }
#pragma unroll 4
            for (int cp = 0; cp < 128; ++cp) { const float w = wf[(size_t)cp * 1024];
#pragma unroll
                for (int q = 0; q < 8; ++q) { const int m = (((c0 + q) * cp) & 127) * 32; ar[q] += ctab2[m] * w; ai[q] += ctab2[(m - 1024) & 4095] * w; } }
            unsigned char* WT = ws_opaque(F.ws) + WS_WNE + (size_t)l * WNE_STRIDE + WNE_WF + (size_t)n * 1024 + g * 128 + c0;
            u32x2 o;
            o.x = pg8::pack_fp8x4(ar[0] * WGU_SCALE, ar[1] * WGU_SCALE, ar[2] * WGU_SCALE, ar[3] * WGU_SCALE); o.y = pg8::pack_fp8x4(ar[4] * WGU_SCALE, ar[5] * WGU_SCALE, ar[6] * WGU_SCALE, ar[7] * WGU_SCALE); *(u32x2*)WT = o;
            o.x = pg8::pack_fp8x4(ai[0] * WGU_SCALE, ai[1] * WGU_SCALE, ai[2] * WGU_SCALE, ai[3] * WGU_SCALE); o.y = pg8::pack_fp8x4(ai[4] * WGU_SCALE, ai[5] * WGU_SCALE, ai[6] * WGU_SCALE, ai[7] * WGU_SCALE); *(u32x2*)(WT + 512) = o;
        }
    }
}

#undef PHG
#define PHG 2
__device__ __forceinline__ void phase_expert_prep(const Frame& F_, int l, int wi, int nw, int i0, int i1) {
    Frame F = F_; asm volatile("" : "+s"(F.bid), "+s"(F.G), "+s"(F.wave)); F.lane = lane_id_(); asm volatile("" : "+v"(F.lane)); F.tid = F.wave * 64 + F.lane;
    const int gw = wi * NWAVES + F.wave, NGW = nw * NWAVES;
    LAS bf16* tl = (LAS bf16*)(F.lds + F.wave * TRF_BYTES);
    unsigned char* WGU8 = WSP(unsigned char, WS_WGU); unsigned char* WD8 = WSP(unsigned char, WS_WD);
    for (int it = i0 + gw; it < i1; it += NGW) {
        const int e = it / 96, r = it % 96, which = r / 32, q = r % 32;
        if (which < 2) {
            const float* We = which ? KIN(I_EWU) : KIN(I_EWG); const float* Ws = which ? KIN(I_SWU) : KIN(I_SWG);
            const float* W = e < 256 ? We + ((size_t)l * 256 + e) * 1024 * 256 : Ws + (size_t)l * 1024 * 256;
            const int kb = q / 2, nb = q % 2;
            tr_item_fast8(W, 256, kb * 64, nb * 128, WGU8 + (size_t)e * 512 * 1024, 1024, 256 * nb + which * 128, (LAS unsigned char*)tl, F.lane, WGU_SCALE);
        } else {
            const float* W = e < 256 ? KIN(I_EWD) + ((size_t)l * 256 + e) * 256 * 1024 : KIN(I_SWD) + (size_t)l * 256 * 1024;
            const int kb = q / 8, nb = q % 8;
            tr_item_fast8(W, 1024, kb * 64, nb * 128, WD8 + (size_t)e * 1024 * 256, 256, nb * 128, (LAS unsigned char*)tl, F.lane, WGU_SCALE);
        }
    }
}
#undef PHG
#define PHG 3
__device__ __forceinline__ void phase_h0(const Frame& F_) {
    Frame F = F_; asm volatile("" : "+s"(F.bid), "+s"(F.G), "+s"(F.wave)); F.lane = lane_id_(); asm volatile("" : "+v"(F.lane)); F.tid = F.wave * 64 + F.lane;
    const int gw = F.bid * NWAVES + F.wave, NGW = F.G * NWAVES;
    unsigned char* H8 = WSP(unsigned char, WS_H8);
    const int per = (T_ALL + NGW - 1) / NGW, rA = gw * per, rB = (rA + per < T_ALL) ? rA + per : T_ALL, lane = F.lane;
    f32x4 SC[4], SH[4]; int curv = -1;
#pragma unroll
    for (int j = 0; j < 4; ++j) SC[j] = SH[j] = (f32x4){0.f, 0.f, 0.f, 0.f};
#define H0_LOAD(V_, row_) row_load((row_) < T_LAT ? KIN(I_X) + (size_t)(row_) * D : KIN(I_CTX) + (size_t)((row_) - T_LAT) * D, lane, V_)
#define H0_COMP(V_, row_) do { row_ln(V_); { const int vv_ = (row_) >= T_LAT ? 8 : (row_) / NSEQ; if (vv_ != curv) { curv = vv_; const float* mv = mod_vec(F, 0, (row_)); \
            _Pragma("unroll") for (int j = 0; j < 4; ++j) { SC[j] = *(const f32x4*)(mv + 1024 + 4 * lane + 256 * j); SH[j] = *(const f32x4*)(mv + 4 * lane + 256 * j); } } } \
        row_affine_r(V_, SC, SH, true); \
        _Pragma("unroll") for (int j = 0; j < 4; ++j) *(unsigned*)(H8 + (size_t)(row_) * D + 4 * lane + 256 * j) = pg8::pack_fp8x4(V_[j][0], V_[j][1], V_[j][2], V_[j][3]); } while (0)
    f32x4 va[4], vb[4];
    int row = rA;
    if (row < rB) H0_LOAD(va, row);
    while (row < rB) {
        const int r1 = row + 1, r2 = r1 + 1;
        if (r1 < rB) H0_LOAD(vb, r1);
        H0_COMP(va, row);
        if (r1 < rB) { if (r2 < rB) H0_LOAD(va, r2); H0_COMP(vb, r1); }
        row = r2;
    }
#undef H0_LOAD
#undef H0_COMP
}

#undef PHG
#define PHG 3
__device__ __forceinline__ void phase_gatesum(const Frame& F_, int nrows) {
    Frame F = F_; asm volatile("" : "+s"(F.bid), "+s"(F.G), "+s"(F.wave)); F.lane = lane_id_(); asm volatile("" : "+v"(F.lane)); F.tid = F.wave * 64 + F.lane;
    const int gw = F.bid * NWAVES + F.wave, NGW = F.G * NWAVES, lane = F.lane;
    const unsigned char* G8 = WSP(const unsigned char, WS_G8); unsigned char* Y = WSP(unsigned char, WS_YSUMB);
    const unsigned char* Z0 = WSP(const unsigned char, WS_ZNA); const unsigned char* Z1 = WSP(const unsigned char, WS_ZFF); const unsigned char* Z2 = WSP(const unsigned char, WS_ZRET);
#define GS_LOAD(G_, Z_, row_) do { _Pragma("unroll") for (int j = 0; j < 2; ++j) { const int col = j * 512 + lane * 8; \
        _Pragma("unroll") for (int b = 0; b < 3; ++b) { const unsigned char* Zb = b == 0 ? Z0 : (b == 1 ? Z1 : Z2); \
            G_[j][b] = __builtin_nontemporal_load((const u32x2*)(G8 + (size_t)(row_) * 3072 + b * 1024 + col)); Z_[j][b] = __builtin_nontemporal_load((const u32x2*)(Zb + (size_t)(row_) * 1024 + col)); } } } while (0)
#define GS_COMP(G_, Z_, row_) do { _Pragma("unroll") for (int j = 0; j < 2; ++j) { const int col = j * 512 + lane * 8; float acc[8]; \
        _Pragma("unroll") for (int q = 0; q < 8; ++q) acc[q] = 0.f; \
        _Pragma("unroll") for (int b = 0; b < 3; ++b) { \
            _Pragma("unroll") for (int hw = 0; hw < 2; ++hw) { const int gwd = hw ? (int)G_[j][b].y : (int)G_[j][b].x, zwd = hw ? (int)Z_[j][b].y : (int)Z_[j][b].x; \
                const f32x2 g0 = __builtin_amdgcn_cvt_pk_f32_fp8(gwd, false), g1 = __builtin_amdgcn_cvt_pk_f32_fp8(gwd, true), z0 = __builtin_amdgcn_cvt_pk_f32_fp8(zwd, false), z1 = __builtin_amdgcn_cvt_pk_f32_fp8(zwd, true); \
                acc[4 * hw + 0] += sigmoidf_(g0.x * pg8::YS_INV) * z0.x; acc[4 * hw + 1] += sigmoidf_(g0.y * pg8::YS_INV) * z0.y; \
                acc[4 * hw + 2] += sigmoidf_(g1.x * pg8::YS_INV) * z1.x; acc[4 * hw + 3] += sigmoidf_(g1.y * pg8::YS_INV) * z1.y; } } \
        u32x2 o; o.x = pg8::pack_fp8x4(acc[0], acc[1], acc[2], acc[3]); o.y = pg8::pack_fp8x4(acc[4], acc[5], acc[6], acc[7]);     \
        *(u32x2*)(Y + (size_t)(row_) * 1024 + col) = o; } } while (0)
    u32x2 ga[2][3], za[2][3], gb[2][3], zb[2][3];
    int row = gw;
    if (row < nrows) GS_LOAD(ga, za, row);
    while (row < nrows) {
        const int r1 = row + NGW, r2 = r1 + NGW;
        if (r1 < nrows) GS_LOAD(gb, zb, r1);
        GS_COMP(ga, za, row);
        if (r1 < nrows) { if (r2 < nrows) GS_LOAD(ga, za, r2); GS_COMP(gb, zb, r1); }
        row = r2;
    }
#undef GS_LOAD
#undef GS_COMP
}
#undef PHG
#define PHG 3
__device__ __forceinline__ void phase_ln_mix(const Frame& F_, int l, int nrows) {
    Frame F = F_; asm volatile("" : "+s"(F.bid), "+s"(F.G), "+s"(F.wave)); F.lane = lane_id_(); asm volatile("" : "+v"(F.lane)); F.tid = F.wave * 64 + F.lane;
    const int gw = F.bid * NWAVES + F.wave, NGW = F.G * NWAVES, lane = F.lane;
    const unsigned char* YO = WSP(const unsigned char, WS_YOUT); bf16* X = WSP(bf16, WS_X); bf16* H = WSP(bf16, WS_H); unsigned char* H8 = WSP(unsigned char, WS_H8);
    const float* xin = KIN(I_X); const float* cin = KIN(I_CTX);
    const float* lnw = KIN(I_LNMW) + (size_t)l * D; const float* lnb = KIN(I_LNMB) + (size_t)l * D;
#define LM_LOAD(V_, Y_, row_) do { if (l == 0) row_load((row_) < T_LAT ? xin + (size_t)(row_) * D : cin + (size_t)((row_) - T_LAT) * D, lane, V_); \
        else { _Pragma("unroll") for (int j = 0; j < 4; ++j) { const u32x2 xw = __builtin_nontemporal_load((const u32x2*)(X + (size_t)(row_) * D + 4 * lane + 256 * j)); V_[j][0] = bflo(xw.x); V_[j][1] = bfhi(xw.x); V_[j][2] = bflo(xw.y); V_[j][3] = bfhi(xw.y); } } \
        _Pragma("unroll") for (int j = 0; j < 4; ++j) Y_[j] = __builtin_nontemporal_load((const unsigned*)(YO + (size_t)(row_) * D + 4 * lane + 256 * j)); } while (0)
#define LM_COMP(V_, Y_, row_) do { { const int vv_ = (row_) >= T_LAT ? 8 : (row_) / NSEQ; if (vv_ != curv) { curv = vv_; const float* mv = mod_vec(F, l, (row_)); \
            _Pragma("unroll") for (int j = 0; j < 4; ++j) { G1[j] = *(const f32x4*)(mv + 2048 + 4 * lane + 256 * j) * pg8::YS_INV; SC[j] = *(const f32x4*)(mv + 4096 + 4 * lane + 256 * j); SH[j] = *(const f32x4*)(mv + 3072 + 4 * lane + 256 * j); } } } \
        _Pragma("unroll") for (int j = 0; j < 4; ++j) { const f32x2 y0 = __builtin_amdgcn_cvt_pk_f32_fp8((int)Y_[j], false), y1 = __builtin_amdgcn_cvt_pk_f32_fp8((int)Y_[j], true); const f32x4 g1 = G1[j]; \
            V_[j][0] = DN_ALPHA * V_[j][0] + g1[0] * y0.x; V_[j][1] = DN_ALPHA * V_[j][1] + g1[1] * y0.y; V_[j][2] = DN_ALPHA * V_[j][2] + g1[2] * y1.x; V_[j][3] = DN_ALPHA * V_[j][3] + g1[3] * y1.y; } \
        row_ln(V_); row_affine_r(V_, LNW, LNB, false); row_store_bf16_nt(X + (size_t)(row_) * D, lane, V_); \
        row_ln(V_); row_affine_r(V_, SC, SH, true); row_store_bf16(H + (size_t)(row_) * D, lane, V_); \
        _Pragma("unroll") for (int j = 0; j < 4; ++j) __builtin_nontemporal_store(pg8::pack_fp8x4(V_[j][0], V_[j][1], V_[j][2], V_[j][3]), (unsigned*)(H8 + (size_t)(row_) * D + 4 * lane + 256 * j)); } while (0)
    f32x4 LNW[4], LNB[4], G1[4], SC[4], SH[4]; int curv = -1;
#pragma unroll
    for (int j = 0; j < 4; ++j) { LNW[j] = *(const f32x4*)(lnw + 4 * lane + 256 * j); LNB[j] = *(const f32x4*)(lnb + 4 * lane + 256 * j); G1[j] = SC[j] = SH[j] = (f32x4){0.f, 0.f, 0.f, 0.f}; }
    const int per = (nrows + NGW - 1) / NGW, rA = gw * per, rB = (rA + per < nrows) ? rA + per : nrows;
    f32x4 va[4], vb[4]; unsigned ya[4], yb[4];
    int row = rA;
    if (row < rB) LM_LOAD(va, ya, row);
    while (row < rB) {
        const int r1 = row + 1, r2 = r1 + 1;
        if (r1 < rB) LM_LOAD(vb, yb, r1);
        LM_COMP(va, ya, row);
        if (r1 < rB) { if (r2 < rB) LM_LOAD(va, ya, r2); LM_COMP(vb, yb, r1); }
        row = r2;
    }
#undef LM_LOAD
#undef LM_COMP
}
typedef __attribute__((ext_vector_type(4))) float facc;
__device__ __forceinline__ facc mma16(bf16x8 a, bf16x8 b, facc c) { return __builtin_amdgcn_mfma_f32_16x16x32_bf16(a, b, c, 0, 0, 0); }
__device__ __forceinline__ bf16x8 lds_gather8(const LAS bf16* p, int stride) {
    bf16x8 r;
#pragma unroll
    for (int j = 0; j < 8; ++j) r[j] = (short)p[j * stride];
    return r;
}
__device__ __forceinline__ bf16x8 pack8(const facc& a, const facc& b) {
    u32x4 w; w.x = pg8::cvt_pk_bf16(a[0], a[1]); w.y = pg8::cvt_pk_bf16(a[2], a[3]); w.z = pg8::cvt_pk_bf16(b[0], b[1]); w.w = pg8::cvt_pk_bf16(b[2], b[3]);
    return __builtin_bit_cast(bf16x8, w);
}
constexpr float LOG2E = 1.4426950408889634f;
typedef short bf16x4s __attribute__((ext_vector_type(4)));
__device__ __forceinline__ unsigned lds_addr_(const LAS void* p) { return (unsigned)(unsigned long long)(const LAS char*)p; }
__device__ __forceinline__ unsigned tr_lane_addr(const LAS bf16* tile  , int pitch, int lane) {
    const int g = lane >> 4, q = (lane & 15) >> 2, p = lane & 3; return lds_addr_(tile + (8 * g + q) * pitch + 4 * p); }
#define TR4(o, a0, a1, a2, a3, off4  ) do { bf16x4s l0_, h0_, l1_, h1_, l2_, h2_, l3_, h3_; \
    const unsigned b0_ = (a0) + (off4), b1_ = (a1) + (off4), b2_ = (a2) + (off4), b3_ = (a3) + (off4); \
    asm volatile("ds_read_b64_tr_b16 %0, %8\n\tds_read_b64_tr_b16 %1, %9\n\tds_read_b64_tr_b16 %2, %10\n\tds_read_b64_tr_b16 %3, %11\n\t" \
                 "ds_read_b64_tr_b16 %4, %12\n\tds_read_b64_tr_b16 %5, %13\n\tds_read_b64_tr_b16 %6, %14\n\tds_read_b64_tr_b16 %7, %15\n\ts_waitcnt lgkmcnt(0)" \
                 : "=&v"(l0_), "=&v"(h0_), "=&v"(l1_), "=&v"(h1_), "=&v"(l2_), "=&v"(h2_), "=&v"(l3_), "=&v"(h3_) \
                 : "v"(a0), "v"(b0_), "v"(a1), "v"(b1_), "v"(a2), "v"(b2_), "v"(a3), "v"(b3_) : "memory"); \
    __builtin_amdgcn_sched_barrier(0); \
    (o)[0] = __builtin_shufflevector(l0_, h0_, 0, 1, 2, 3, 4, 5, 6, 7); (o)[1] = __builtin_shufflevector(l1_, h1_, 0, 1, 2, 3, 4, 5, 6, 7); \
    (o)[2] = __builtin_shufflevector(l2_, h2_, 0, 1, 2, 3, 4, 5, 6, 7); (o)[3] = __builtin_shufflevector(l3_, h3_, 0, 1, 2, 3, 4, 5, 6, 7); } while (0)

constexpr int UT_P = 68;
template <bool OUT8  >
__device__ __forceinline__ void ut_tile(const Frame& F, const bf16* P, int colbase, int rowbase, int n0, int c0, bf16* UT, int ldn, LAS bf16* tl) {
    const int lane = F.lane;
#pragma unroll
    for (int i = 0; i < 8; ++i) { const int r = (lane >> 3) + 8 * i, pc = lane & 7;
        const u32x4 v = __builtin_nontemporal_load((const u32x4*)(P + (size_t)(rowbase + n0 + r) * INW + colbase + c0 + pc * 8));
        LAS u32x2* d = (LAS u32x2*)(tl + r * UT_P + pc * 8); d[0] = (u32x2){v.x, v.y}; d[1] = (u32x2){v.z, v.w}; }
    LDS_WAIT(); asm volatile("" ::: "memory");
    const unsigned ta = tr_lane_addr(tl, UT_P, lane);
    const int fr = lane & 15, g = lane >> 4;
#pragma unroll
    for (int rb = 0; rb < 2; ++rb) {
        bf16x8 fv[4]; const unsigned a = ta + (unsigned)(32 * rb * UT_P * 2);
        TR4(fv, a, a + 32u, a + 64u, a + 96u, (unsigned)(4 * UT_P * 2));
#pragma unroll
        for (int cb = 0; cb < 4; ++cb) {
            if constexpr (OUT8) { const u32x4 w = __builtin_bit_cast(u32x4, fv[cb]);
                u32x2 o; o.x = pg8::pack_fp8x4(bflo(w.x), bfhi(w.x), bflo(w.y), bfhi(w.y)); o.y = pg8::pack_fp8x4(bflo(w.z), bfhi(w.z), bflo(w.w), bfhi(w.w));
                *(u32x2*)((unsigned char*)UT + (size_t)(c0 + 16 * cb + fr) * ldn + n0 + 32 * rb + 8 * g) = o; }
            else *(bf16x8*)(UT + (size_t)(c0 + 16 * cb + fr) * ldn + n0 + 32 * rb + 8 * g) = fv[cb]; } }
    LDS_WAIT(); asm volatile("" ::: "memory");
}
#undef PHG
#define PHG 4
__device__ __forceinline__ void phase_ut(const Frame& F_, int l) {
    Frame F = F_; asm volatile("" : "+s"(F.bid), "+s"(F.G), "+s"(F.wave)); F.lane = lane_id_(); asm volatile("" : "+v"(F.lane)); F.tid = F.wave * 64 + F.lane;
    const int gw = F.bid * NWAVES + F.wave, NGW = F.G * NWAVES;
    const bf16* P = WSP(const bf16, WS_P); LAS bf16* tl = (LAS bf16*)(F.lds + F.wave * 8704);
    const int ntl = NB * 64 * 8, ntc = (l == 0) ? NB * 4 * 8 : 0;
    const int hvw = ((NB * 4 * NCH) % F.G) * NWAVES, nlw = NGW - hvw, lw = gw - hvw;
#define UT_LIST(...) do { if (nlw > 0 && nlw < NGW && NGW <= ntl) { { const int it = gw; __VA_ARGS__ } if (lw >= 0) for (int it = NGW + lw; it < ntl; it += nlw) { __VA_ARGS__ } } else for (int it = gw; it < ntl; it += NGW) { __VA_ARGS__ } } while (0)
    UT_LIST({ const int b = it / 512, r = it % 512; ut_tile<true>(F, P, C_UB, b * NSEQ, (r / 8) * 64, (r % 8) * 64, (bf16*)(WSP(unsigned char, WS_UT) + (size_t)b * 512 * 4096), 4096, tl); });
    for (int q = NGW - 1 - gw; q < ntc; q += NGW) { const int b = q / 32, r = q % 32; ut_tile<false>(F, P, C_UB, T_LAT + b * NCTX, (r / 8) * 64, (r % 8) * 64, WSP(bf16, WS_UTC) + (size_t)b * 512 * 256, 256, tl); }
    UT_LIST({ const int b = it / 512, r = it % 512; ut_tile<false>(F, P, C_VA, b * NSEQ, (r / 8) * 64, (r % 8) * 64, WSP(bf16, WS_VT) + (size_t)b * 512 * 4096, 4096, tl); });
#undef UT_LIST
    for (int q = NGW - 1 - gw; q < NB * 4 * 8; q += NGW) { const int b = q / 32, r = q % 32; ut_tile<false>(F, P, C_VA, T_LAT + b * NCTX, (r / 8) * 64, (r % 8) * 64, WSP(bf16, WS_VTC) + (size_t)b * 512 * 256, 256, tl); }
}
#undef PHG
#define PHG 4
__device__ __forceinline__ void phase_nyquist(const Frame& F_) {
    Frame F = F_; asm volatile("" : "+s"(F.bid), "+s"(F.G), "+s"(F.wave)); F.lane = lane_id_(); asm volatile("" : "+v"(F.lane)); F.tid = F.wave * 64 + F.lane;
    const int gw = F.bid * NWAVES + F.wave, NGW = F.G * NWAVES, lane = F.lane;
    const unsigned char* UT = WSP(const unsigned char, WS_UT); unsigned char* FF = WSP(unsigned char, WS_FF);
    for (int it0 = gw; it0 < NB * 512; it0 += 2 * NGW) {
        u32x2 w[2][8];
#pragma unroll
        for (int u = 0; u < 2; ++u) { const int it = it0 + u * NGW; const unsigned char* row = UT + (size_t)(it < NB * 512 ? it : it0) * 4096;
#pragma unroll
            for (int k = 0; k < 8; ++k) w[u][k] = *(const u32x2*)(row + k * 512 + lane * 8); }
#pragma unroll
        for (int u = 0; u < 2; ++u) { const int it = it0 + u * NGW; const int b = it >> 9, ch = it & 511; float acc = 0.f;
#pragma unroll
            for (int k = 0; k < 8; ++k) { const f32x2 a0 = __builtin_amdgcn_cvt_pk_f32_fp8((int)w[u][k].x, false), a1 = __builtin_amdgcn_cvt_pk_f32_fp8((int)w[u][k].x, true), a2 = __builtin_amdgcn_cvt_pk_f32_fp8((int)w[u][k].y, false), a3 = __builtin_amdgcn_cvt_pk_f32_fp8((int)w[u][k].y, true);
                acc += (a0.x - a0.y) + (a1.x - a1.y) + (a2.x - a2.y) + (a3.x - a3.y); }
            acc = wave_sum(acc);
            if (lane == 0 && it < NB * 512) { FF[(size_t)(b * NSEQ + NSEQ / 2) * 1024 + ch] = (unsigned char)(pg8::pack_fp8x4(acc * (pg8::YS_SCALE / 724.0773439350247f), 0.f, 0.f, 0.f) & 0xffu); FF[(size_t)(b * NSEQ + NSEQ / 2) * 1024 + 512 + ch] = (unsigned char)0; } }
    }
}

constexpr int NA_RPB_OFF = 0, NA_CK_OFF = 2048, NA_CK_P = 80, NA_CV_OFF = NA_CK_OFF + 256 * NA_CK_P * 2, NA_CV_P = 264;
template <bool WIN, bool CLDS  >
__device__ __forceinline__ void na_chunk(const Frame& F, const char* kb  , const char* vb  , int vpitch  ,
                                         const bf16x8 (&qf)[2], int kc0, int qrow_minus_r0, int qc, float& m, float& lsum, facc (&o)[4]) {
    const int lane = F.lane, fr = lane & 15, g = lane >> 4;
    const LAS float* rpb = (const LAS float*)(F.lds + NA_RPB_OFF);
    int dci[2][4]; unsigned okm = 0u;
    if (WIN) { const int c0 = qc - 8 < 0 ? 0 : (qc - 8 > 48 ? 48 : qc - 8);
#pragma unroll
        for (int tt = 0; tt < 2; ++tt)
#pragma unroll
            for (int r = 0; r < 4; ++r) { const int kc = kc0 + 8 * g + 4 * tt + r; int dc = kc - qc; dc = dc < -15 ? -15 : (dc > 15 ? 15 : dc); dci[tt][r] = dc + 15;
                okm |= (kc >= c0 && kc < c0 + 16) ? (1u << (tt * 4 + r)) : 0u; } }
    const unsigned koff0 = (unsigned)((8 * (fr >> 2) + (fr & 3)) * INW + 8 * g) * 2u, koff1 = koff0 + 4u * INW * 2u;
    const unsigned voff = (unsigned)(fr * vpitch + 8 * g) * 2u;
    facc s[16];
    constexpr int KD = 2;
    bf16x8 kf[KD][4];
    const LAS bf16* ckl = (const LAS bf16*)(F.lds + NA_CK_OFF) + (8 * (fr >> 2) + (fr & 3)) * NA_CK_P + 8 * g;
    const LAS bf16* cvl = (const LAS bf16*)(F.lds + NA_CV_OFF) + fr * NA_CV_P + 8 * g;
#define NA_KLOAD(slot, i) do { if constexpr (CLDS) { const LAS bf16* kl_ = ckl + 32 * (i) * NA_CK_P; \
            kf[slot][0] = *(const LAS bf16x8*)kl_; kf[slot][1] = *(const LAS bf16x8*)(kl_ + 32); kf[slot][2] = *(const LAS bf16x8*)(kl_ + 4 * NA_CK_P); kf[slot][3] = *(const LAS bf16x8*)(kl_ + 4 * NA_CK_P + 32); } \
        else { const char* kp_ = WIN ? kb + (size_t)((i) * 64) * INW * 2 : kb + (size_t)(32 * (i)) * INW * 2; \
        kf[slot][0] = *(const bf16x8*)(kp_ + koff0); kf[slot][1] = *(const bf16x8*)(kp_ + koff0 + 64); kf[slot][2] = *(const bf16x8*)(kp_ + koff1); kf[slot][3] = *(const bf16x8*)(kp_ + koff1 + 64); } } while (0)
#pragma unroll
    for (int i = 0; i < KD; ++i) NA_KLOAD(i, i);
#pragma unroll
    for (int i = 0; i < 8; ++i) {
        facc a = {0.f, 0.f, 0.f, 0.f}, c = {0.f, 0.f, 0.f, 0.f};
        a = mma16(kf[i % KD][0], qf[0], a); a = mma16(kf[i % KD][1], qf[1], a); c = mma16(kf[i % KD][2], qf[0], c); c = mma16(kf[i % KD][3], qf[1], c);
        if (i + KD < 8) NA_KLOAD(i % KD, i + KD);
        if (WIN) {
            const int rb = (i - qrow_minus_r0 + 7) * 31;
#pragma unroll
            for (int r = 0; r < 4; ++r) { const float b0 = rpb[rb + dci[0][r]], b1 = rpb[rb + dci[1][r]];
                a[r] = ((okm >> r) & 1u) ? a[r] * 0.125f + b0 : -1e30f; c[r] = ((okm >> (4 + r)) & 1u) ? c[r] * 0.125f + b1 : -1e30f; }
        } else {
#pragma unroll
            for (int r = 0; r < 4; ++r) { a[r] *= 0.125f; c[r] *= 0.125f; }
        }
        s[2 * i] = a; s[2 * i + 1] = c;
        __builtin_amdgcn_sched_barrier(0);
    }
#undef NA_KLOAD
    constexpr int VD = 2;
    bf16x8 vf[VD][4];
#define NA_VLOAD(slot, i) do { if constexpr (CLDS) { _Pragma("unroll") for (int dt_ = 0; dt_ < 4; ++dt_) vf[slot][dt_] = *(const LAS bf16x8*)(cvl + 16 * dt_ * NA_CV_P + 32 * (i)); } \
        else { const char* vp_ = WIN ? vb + (size_t)((i) * 64) * 2 : vb + (size_t)(32 * (i)) * 2; \
        _Pragma("unroll") for (int dt_ = 0; dt_ < 4; ++dt_) vf[slot][dt_] = *(const bf16x8*)(vp_ + (size_t)(16 * dt_ * vpitch) * 2 + voff); } } while (0)
#pragma unroll
    for (int i = 0; i < VD; ++i) NA_VLOAD(i, i);
    float mx = -1e30f;
#pragma unroll
    for (int t = 0; t < 16; ++t) mx = fmaxf(mx, fmaxf(fmaxf(s[t][0], s[t][1]), fmaxf(s[t][2], s[t][3])));
    mx = fmaxf(mx, __shfl_xor(mx, 16)); mx = fmaxf(mx, __shfl_xor(mx, 32));
    const float mn = fmaxf(m, mx), alpha = __builtin_amdgcn_exp2f((m - mn) * LOG2E);
    m = mn; lsum *= alpha;
#pragma unroll
    for (int dt = 0; dt < 4; ++dt) o[dt] = o[dt] * alpha;
#pragma unroll
    for (int t = 0; t < 16; ++t) {
#pragma unroll
        for (int r = 0; r < 4; ++r) { const float p = __builtin_amdgcn_exp2f((s[t][r] - mn) * LOG2E); s[t][r] = p; lsum += p; }
    }
    __builtin_amdgcn_sched_barrier(0);
#pragma unroll
    for (int i = 0; i < 8; ++i) {
        const bf16x8 pb = pack8(s[2 * i], s[2 * i + 1]);
#pragma unroll
        for (int dt = 0; dt < 4; ++dt) o[dt] = mma16(vf[i % VD][dt], pb, o[dt]);
        if (i + VD < 8) NA_VLOAD(i % VD, i + VD);
        __builtin_amdgcn_sched_barrier(0);
    }
#undef NA_VLOAD
}
template <bool CTX>
__device__ __forceinline__ void na_wave(const Frame& F, const bf16* P, bf16* YNA, int b, int h, int tq  , int r0  , int kc0, int qrow_minus_r0, int qc) {
    const int lane = F.lane, g = lane >> 4;
    bf16x8 qf[2];
#pragma unroll
    for (int ks = 0; ks < 2; ++ks) qf[ks] = *(const bf16x8*)(P + (size_t)tq * INW + C_QA + h * 64 + ks * 32 + 8 * g);
    float m = -1e30f, lsum = 0.f; facc o[4];
#pragma unroll
    for (int dt = 0; dt < 4; ++dt) o[dt] = (facc){0.f, 0.f, 0.f, 0.f};
    const int ctxrow0 = T_LAT + b * NCTX;
    SUBRESET();
    if (!CTX) na_chunk<true, false>(F, (const char*)P + ((size_t)(b * NSEQ + r0 * 64 + kc0) * INW + C_KA + h * 64) * 2,
                             (const char*)(WSP(const bf16, WS_VT) + ((size_t)(b * 8 + h) * 64) * 4096 + r0 * 64 + kc0), 4096, qf, kc0, qrow_minus_r0, qc, m, lsum, o);
    SUBSTAMP(13);
    if (!CTX) na_chunk<false, true>(F, nullptr, nullptr, 256, qf, 0, 0, 0, m, lsum, o);
    else na_chunk<false, false>(F, (const char*)P + ((size_t)ctxrow0 * INW + C_KA + h * 64) * 2, (const char*)(WSP(const bf16, WS_VTC) + ((size_t)(b * 8 + h) * 64) * 256), 256, qf, 0, 0, 0, m, lsum, o);
    lsum += __shfl_xor(lsum, 16); lsum += __shfl_xor(lsum, 32);
    const float inv = pg8::YS_SCALE / lsum;
#pragma unroll
    for (int dt = 0; dt < 4; ++dt)
        *(unsigned*)((unsigned char*)YNA + (size_t)tq * 512 + h * 64 + 16 * dt + 4 * g) = pg8::pack_fp8x4(o[dt][0] * inv, o[dt][1] * inv, o[dt][2] * inv, o[dt][3] * inv);
    SUBSTAMP(14);
}
#undef PHG
#define PHG 5
__device__ __forceinline__ void phase_na(const Frame& F_, int l) {
    const bf16* P = (const bf16*)(ws_opaque(F_.ws) + WS_P); bf16* YNA = (bf16*)(ws_opaque(F_.ws) + WS_YNA);
    const int nlat = NB * 8 * 32, nctx = (l == 0) ? NB * 8 * 2 : 0;
    LAS float* rpb = (LAS float*)(F_.lds + NA_RPB_OFF);
    const int per = (nlat + F_.G - 1) / F_.G, u0 = F_.bid * per, u1 = (u0 + per < nlat) ? u0 + per : nlat;
    int bhcur = -1;
    for (int u = u0; u < u1; ++u) {
        Frame F = F_; asm volatile("" : "+s"(F.bid), "+s"(F.G), "+s"(F.wave)); F.lane = lane_id_(); asm volatile("" : "+v"(F.lane)); F.tid = F.wave * 64 + F.lane;
        const int b = u / 256, h = (u % 256) / 32, rp = u % 32;
        if (b * 8 + h != bhcur) {
            __syncthreads();
            for (int i = F.tid; i < 15 * 31; i += 512) rpb[i] = KIN(I_RPB)[((size_t)l * 8 + h) * 465 + i];
            {   int tq = F.tid; asm volatile("" : "+v"(tq));
                u32x4 kv[4];
#pragma unroll
                for (int k = 0; k < 4; ++k) { const int q = tq + 512 * k; kv[k] = *(const u32x4*)(P + (size_t)(T_LAT + b * NCTX + (q >> 3)) * INW + C_KA + h * 64 + (q & 7) * 8); }
#pragma unroll
                for (int k = 0; k < 4; ++k) { const int q = tq + 512 * k; *(LAS u32x4*)((LAS bf16*)(F.lds + NA_CK_OFF) + (q >> 3) * NA_CK_P + (q & 7) * 8) = kv[k]; } }
            {   int tq = F.tid; asm volatile("" : "+v"(tq));
                u32x4 vv[4];
#pragma unroll
                for (int k = 0; k < 4; ++k) { const int q = tq + 512 * k; vv[k] = *(const u32x4*)(WSP(const bf16, WS_VTC) + ((size_t)(b * 8 + h) * 64 + (q >> 5)) * 256 + (q & 31) * 8); }
#pragma unroll
                for (int k = 0; k < 4; ++k) { const int q = tq + 512 * k; *(LAS u32x4*)((LAS bf16*)(F.lds + NA_CV_OFF) + (q >> 5) * NA_CV_P + (q & 31) * 8) = vv[k]; } }
            __syncthreads(); bhcur = b * 8 + h;
        }
        const int qrow = 2 * rp + (F.wave >> 2), j = F.wave & 3;
        const int r0 = qrow - 4 < 0 ? 0 : (qrow - 4 > 56 ? 56 : qrow - 4);
        const int kc0 = (j == 0) ? 0 : (j == 1 ? 8 : (j == 2 ? 24 : 32));
        const int qc = 16 * j + (F.lane & 15);
        na_wave<false>(F, P, YNA, b, h, b * NSEQ + qrow * 64 + qc, r0, kc0, qrow - r0, qc);
    }
    for (int q = F_.bid; q < nctx; q += F_.G) {
        Frame F = F_; asm volatile("" : "+s"(F.bid), "+s"(F.G), "+s"(F.wave)); F.lane = lane_id_(); asm volatile("" : "+v"(F.lane)); F.tid = F.wave * 64 + F.lane;
        const int b = q / 16, h = (q % 16) / 2, qt = (q % 2) * 8 + F.wave;
        na_wave<true>(F, P, YNA, b, h, T_LAT + b * NCTX + qt * 16 + (F.lane & 15), 0, 0, 0, 0);
    }
    __syncthreads();
}

constexpr int R_KP = 136, R_VP = 264;
constexpr int R_OFF_A = 0, R_OFF_B = 128 * R_KP * 2, R_OFF_V = 2 * 128 * R_KP * 2, R_OFF_RED = R_OFF_V + 128 * R_VP * 2, R_OFF_ST = R_OFF_RED + 8192;
__device__ __forceinline__ float log_sigmoidf_(float x) { return -log1pf(__expf(-x)); }
__device__ __forceinline__ int chunk_row0(int b, int ch) { return ch < 32 ? b * NSEQ + ch * 128 : T_LAT + b * NCTX + (ch - 32) * 128; }
template <bool PD = false>
__device__ __forceinline__ void ret_stage_qk(const Frame& F, const bf16* P, int row0, int col0, int ch, LAS bf16* out0, LAS bf16* out1, float lg0, float lg1, int mode  , float scale) {
    const float* rc = WSP(const float, WS_ROPE); const float* rs = rc + 2048;
    u32x4 a[2], bq[2]; f32x4 cs[2][2], sn[2][2];
#pragma unroll
    for (int it = 0; it < 2; ++it) { const int i = F.tid + 512 * it, m = i >> 3, pp = i & 7, d0 = (pp & 3) * 8 + (pp >> 2) * 64;
        a[it] = __builtin_nontemporal_load((const u32x4*)(P + (size_t)(row0 + m) * INW + col0 + d0)); bq[it] = __builtin_nontemporal_load((const u32x4*)(P + (size_t)(row0 + m) * INW + col0 + d0 + 32));
        if (ch < 32) { const int n = ch * 128 + m, pos = (pp >> 2) ? (n & 63) : (n >> 6), fi = pos * 32 + (pp & 3) * 8;
            cs[it][0] = *(const f32x4*)(rc + fi); cs[it][1] = *(const f32x4*)(rc + fi + 4); sn[it][0] = *(const f32x4*)(rs + fi); sn[it][1] = *(const f32x4*)(rs + fi + 4); } }
#pragma unroll
    for (int it = 0; it < 2; ++it) { const int i = F.tid + 512 * it, m = i >> 3, pp = i & 7, d0 = (pp & 3) * 8 + (pp >> 2) * 64;
        float x1[8], x2[8];
        x1[0] = bflo(a[it].x); x1[1] = bfhi(a[it].x); x1[2] = bflo(a[it].y); x1[3] = bfhi(a[it].y); x1[4] = bflo(a[it].z); x1[5] = bfhi(a[it].z); x1[6] = bflo(a[it].w); x1[7] = bfhi(a[it].w);
        x2[0] = bflo(bq[it].x); x2[1] = bfhi(bq[it].x); x2[2] = bflo(bq[it].y); x2[3] = bfhi(bq[it].y); x2[4] = bflo(bq[it].z); x2[5] = bfhi(bq[it].z); x2[6] = bflo(bq[it].w); x2[7] = bfhi(bq[it].w);
        if (ch < 32) {
#pragma unroll
            for (int e = 0; e < 8; ++e) { const float c = cs[it][e >> 2][e & 3], sv = sn[it][e >> 2][e & 3], y1 = x1[e] * c - x2[e] * sv, y2 = x1[e] * sv + x2[e] * c; x1[e] = y1; x2[e] = y2; }
        }
        float w0 = scale, w1 = scale;
        if (mode == 1) { w0 = __expf(lg0 * (float)(127 - m)); w1 = __expf(lg1 * (float)m); }
        const int dp = PD ? ((d0 & ~31) + ((d0 >> 3) & 3) * 4) : d0;
        {
            LAS unsigned* p1 = (LAS unsigned*)(out0 + m * R_KP + dp); LAS unsigned* p2 = (LAS unsigned*)(out0 + m * R_KP + dp + 32);
#pragma unroll
            for (int e = 0; e < 4; ++e) { const int o = PD ? (e >> 1) * 8 + (e & 1) : e; p1[o] = pk2(x1[2 * e] * w0, x1[2 * e + 1] * w0); p2[o] = pk2(x2[2 * e] * w0, x2[2 * e + 1] * w0); }
        }
        if (out1) {
            LAS unsigned* p1 = (LAS unsigned*)(out1 + m * R_KP + dp); LAS unsigned* p2 = (LAS unsigned*)(out1 + m * R_KP + dp + 32);
#pragma unroll
            for (int e = 0; e < 4; ++e) { const int o = PD ? (e >> 1) * 8 + (e & 1) : e; p1[o] = pk2(x1[2 * e] * w1, x1[2 * e + 1] * w1); p2[o] = pk2(x2[2 * e] * w1, x2[2 * e + 1] * w1); }
        }
    }
}
__device__ __forceinline__ void ret_stage_v(const Frame& F, const bf16* P, int row0, int col0) {
    LAS bf16* Vl = (LAS bf16*)(F.lds + R_OFF_V);
    u32x4 v[8];
#pragma unroll
    for (int k = 0; k < 8; ++k) { const int i = F.tid + 512 * k, m = i >> 5, pc = i & 31; v[k] = __builtin_nontemporal_load((const u32x4*)(P + (size_t)(row0 + m) * INW + col0 + pc * 8)); }
#pragma unroll
    for (int k = 0; k < 8; ++k) { const int i = F.tid + 512 * k, m = i >> 5, pc = i & 31;
        LAS unsigned* d = (LAS unsigned*)(Vl + m * R_VP + pc * 8); d[0] = v[k].x; d[1] = v[k].y; d[2] = v[k].z; d[3] = v[k].w; }
}
#undef PHG
#define PHG 6
__device__ __forceinline__ void phase_r1(const Frame& F_, int l) {
    Frame F = F_; asm volatile("" : "+s"(F.bid), "+s"(F.G), "+s"(F.wave)); F.lane = lane_id_(); asm volatile("" : "+v"(F.lane)); F.tid = F.wave * 64 + F.lane;
    const bf16* P = WSP(const bf16, WS_P); bf16* KV = WSP(bf16, WS_KV);
    const int lane = F.lane, fr0 = lane & 15, g0 = lane >> 4;
    for (int u = F.bid; u < NB * 4 * NCH; u += F.G) {
        const int b = u / (4 * NCH), h = (u / NCH) % 4, ch = u % NCH, row0 = chunk_row0(b, ch);
        const float lgf = log_sigmoidf_(KIN(I_DECF)[l * 4 + h]), lgb = log_sigmoidf_(KIN(I_DECB)[l * 4 + h]);
        int fr = fr0, g = g0; asm volatile("" : "+v"(fr), "+v"(g));
        Frame Fu = F; asm volatile("" : "+v"(Fu.tid));
        __syncthreads();
        SUBRESET();
        ret_stage_qk<true>(Fu, P, row0, C_KR + h * 128, ch, (LAS bf16*)(F.lds + R_OFF_A), (LAS bf16*)(F.lds + R_OFF_B), lgf, lgb, 1, 1.f);
        ret_stage_v(Fu, P, row0, C_VR + h * 256);
        __syncthreads();
        SUBSTAMP(5);
        const int dir = F.wave >> 2, eq = F.wave & 3;
        const LAS bf16* Kl = (const LAS bf16*)(F.lds + (dir ? R_OFF_B : R_OFF_A)); const LAS bf16* Vl = (const LAS bf16*)(F.lds + R_OFF_V);
        facc acc[4][8];
#pragma unroll
        for (int et = 0; et < 4; ++et)
#pragma unroll
            for (int dt = 0; dt < 8; ++dt) acc[et][dt] = (facc){0.f, 0.f, 0.f, 0.f};
        const unsigned vta = tr_lane_addr(Vl + 64 * eq, R_VP, lane), kta = tr_lane_addr(Kl, R_KP, lane);
#pragma unroll 1
        for (int ks = 0; ks < 4; ++ks) {
            bf16x8 va[4], kb0[4], kb1[4];
            const unsigned vk = vta + (unsigned)(32 * ks * R_VP * 2), kk = kta + (unsigned)(32 * ks * R_KP * 2);
            TR4(va, vk, vk + 32u, vk + 64u, vk + 96u, (unsigned)(4 * R_VP * 2));
            TR4(kb0, kk, kk + 32u, kk + 64u, kk + 96u, (unsigned)(4 * R_KP * 2));
            TR4(kb1, kk + 128u, kk + 160u, kk + 192u, kk + 224u, (unsigned)(4 * R_KP * 2));
#pragma unroll
            for (int dt = 0; dt < 8; ++dt) {
#pragma unroll
                for (int et = 0; et < 4; ++et) acc[et][dt] = mma16(dt < 4 ? kb0[dt & 3] : kb1[dt & 3], va[et], acc[et][dt]);
            }
        }
        SUBSTAMP(6);
        bf16* out = KV + ((((size_t)(b * 4 + h) * NCH + ch) * 2 + dir) << 15);
#pragma unroll
        for (int et = 0; et < 4; ++et)
#pragma unroll
            for (int a = 0; a < 4; ++a) { u32x4 w; w.x = pk2(acc[et][2 * a][0], acc[et][2 * a][1]); w.y = pk2(acc[et][2 * a][2], acc[et][2 * a][3]); w.z = pk2(acc[et][2 * a + 1][0], acc[et][2 * a + 1][1]); w.w = pk2(acc[et][2 * a + 1][2], acc[et][2 * a + 1][3]);
                *(u32x4*)(out + (size_t)(64 * eq + 16 * et + fr) * 128 + 32 * a + 8 * g) = w; }
        SUBSTAMP(7);
    }
    __syncthreads();
}
#undef PHG
#define PHG 7
__device__ __forceinline__ void phase_r2(const Frame& F_, int l) {
    Frame F = F_; asm volatile("" : "+s"(F.bid), "+s"(F.G), "+s"(F.wave)); F.lane = lane_id_(); asm volatile("" : "+v"(F.lane)); F.tid = F.wave * 64 + F.lane;
    const bf16* KV = WSP(const bf16, WS_KV); bf16* SP = WSP(bf16, WS_SPREV);
    for (int id = F.bid * 512 + F.tid; id < 64 * 4096; id += F.G * 512) {
        const int comb = id >> 12, el = (id & 4095) * 8, bh = comb >> 1, dir = comb & 1, h = bh & 3;
        const float lg = log_sigmoidf_(dir ? KIN(I_DECB)[l * 4 + h] : KIN(I_DECF)[l * 4 + h]), gC = __expf(lg * 128.f);
        float S[8];
#pragma unroll
        for (int j = 0; j < 8; ++j) S[j] = 0.f;
#pragma unroll 1
        for (int s0 = 0; s0 < NCH; s0 += 8) {
            u32x4 kv[8];
#pragma unroll
            for (int q = 0; q < 8; ++q) { const int s = s0 + q;
                if (s < NCH) { const int ch = dir == 0 ? (s < 2 ? 32 + s : s - 2) : (s < 2 ? 33 - s : 33 - s);
                    kv[q] = __builtin_nontemporal_load((const u32x4*)(KV + ((((size_t)bh * NCH + ch) * 2 + dir) << 15) + el)); } }
#pragma unroll
            for (int q = 0; q < 8; ++q) { const int s = s0 + q;
                if (s < NCH) { const int ch = dir == 0 ? (s < 2 ? 32 + s : s - 2) : (s < 2 ? 33 - s : 33 - s);
                    u32x4 w; w.x = pk2(S[0], S[1]); w.y = pk2(S[2], S[3]); w.z = pk2(S[4], S[5]); w.w = pk2(S[6], S[7]);
                    *(u32x4*)(SP + ((((size_t)bh * NCH + ch) * 2 + dir) << 15) + el) = w;
                    S[0] = gC * S[0] + bflo(kv[q].x); S[1] = gC * S[1] + bfhi(kv[q].x); S[2] = gC * S[2] + bflo(kv[q].y); S[3] = gC * S[3] + bfhi(kv[q].y);
                    S[4] = gC * S[4] + bflo(kv[q].z); S[5] = gC * S[5] + bfhi(kv[q].z); S[6] = gC * S[6] + bflo(kv[q].w); S[7] = gC * S[7] + bfhi(kv[q].w); } }
        }
    }
}
#undef PHG
#define PHG 8
__device__ __forceinline__ void phase_r3(const Frame& F_, int l) {
    Frame F = F_; asm volatile("" : "+s"(F.bid), "+s"(F.G), "+s"(F.wave)); F.lane = lane_id_(); asm volatile("" : "+v"(F.lane)); F.tid = F.wave * 64 + F.lane;
    const bf16* P = WSP(const bf16, WS_P); const bf16* SP = WSP(const bf16, WS_SPREV); bf16* YR = WSP(bf16, WS_YRET);
    const int lane = F.lane, fr0 = lane & 15, g0 = lane >> 4, w = F.wave;
    const int nch = (l == 0) ? NCH : 32;
    LAS bf16* Ql = (LAS bf16*)(F.lds + R_OFF_A); LAS bf16* Kl = (LAS bf16*)(F.lds + R_OFF_B); const LAS bf16* Vl = (const LAS bf16*)(F.lds + R_OFF_V);
    LAS float* red = (LAS float*)(F.lds + R_OFF_RED); LAS float* stt = (LAS float*)(F.lds + R_OFF_ST);
    for (int u = F.bid; u < NB * 4 * nch; u += F.G) {
        const int b = u / (4 * nch), h = (u / nch) % 4, ch = u % nch, row0 = chunk_row0(b, ch);
        const float lgf = log_sigmoidf_(KIN(I_DECF)[l * 4 + h]), lgb = log_sigmoidf_(KIN(I_DECB)[l * 4 + h]);
        int fr = fr0, g = g0; asm volatile("" : "+v"(fr), "+v"(g));
        Frame Fu = F; asm volatile("" : "+v"(Fu.tid));
        __syncthreads();
        SUBRESET();
        ret_stage_qk(Fu, P, row0, C_QR + h * 128, ch, Ql, nullptr, 0.f, 0.f, 0, 0.08838834764831845f);
        ret_stage_qk(Fu, P, row0, C_KR + h * 128, ch, Kl, nullptr, 0.f, 0.f, 0, 1.f);
        ret_stage_v(Fu, P, row0, C_VR + h * 256);
        __syncthreads();
        SUBSTAMP(0);
        facc st[8];
#pragma unroll
        for (int mt = 0; mt < 8; ++mt) st[mt] = (facc){0.f, 0.f, 0.f, 0.f};
#pragma unroll
        for (int ks = 0; ks < 4; ++ks) {
            const bf16x8 qb = *(const LAS bf16x8*)(Ql + (16 * w + fr) * R_KP + 32 * ks + 8 * g);
#pragma unroll
            for (int mt = 0; mt < 8; ++mt) { const bf16x8 ka = *(const LAS bf16x8*)(Kl + (16 * mt + fr) * R_KP + 32 * ks + 8 * g); st[mt] = mma16(ka, qb, st[mt]); }
        }
        __syncthreads();
        {
            const int c = 16 * w + fr;
#pragma unroll
            for (int mt = 0; mt < 8; ++mt) { float v[4];
#pragma unroll
                for (int r = 0; r < 4; ++r) { const int m = 16 * mt + 4 * g + r; const float dcy = (c >= m) ? __expf(lgf * (float)(c - m)) : __expf(lgb * (float)(m - c)); v[r] = st[mt][r] * dcy; }
                u32x2 pw; pw.x = pk2(v[0], v[1]); pw.y = pk2(v[2], v[3]);
                *(LAS u32x2*)(Kl + c * R_KP + 16 * mt + 4 * g) = pw; }
        }
        __syncthreads();
        SUBSTAMP(1);
        facc acc[2][8];
#pragma unroll
        for (int et = 0; et < 2; ++et)
#pragma unroll
            for (int ct = 0; ct < 8; ++ct) acc[et][ct] = (facc){0.f, 0.f, 0.f, 0.f};
#pragma unroll 1
        for (int ks = 0; ks < 4; ++ks) {
            bf16x8 va[4];
            { const unsigned a = tr_lane_addr(Vl + 32 * w, R_VP, lane) + (unsigned)(32 * ks * R_VP * 2); TR4(va, a, a + 32u, a, a + 32u, (unsigned)(4 * R_VP * 2)); }
#pragma unroll
            for (int ct = 0; ct < 8; ++ct) { const bf16x8 pb = *(const LAS bf16x8*)(Kl + (16 * ct + fr) * R_KP + 32 * ks + 8 * g);
#pragma unroll
                for (int et = 0; et < 2; ++et) acc[et][ct] = mma16(va[et], pb, acc[et][ct]); }
            __builtin_amdgcn_sched_barrier(0);
        }
        SUBSTAMP(2);
        {
            const bf16* sp0 = SP + ((((size_t)(b * 4 + h) * NCH + ch) * 2 + 0) << 15); const bf16* sp1 = sp0 + 32768;
#pragma unroll
            for (int dir = 0; dir < 2; ++dir) {
                const bf16* sp = dir == 0 ? sp0 : sp1; bf16x8 sa[4][2];
#pragma unroll
                for (int ks = 0; ks < 4; ++ks)
#pragma unroll
                    for (int et = 0; et < 2; ++et) sa[ks][et] = __builtin_nontemporal_load((const bf16x8*)(sp + (size_t)(32 * w + 16 * et + fr) * 128 + 32 * ks + 8 * g));
#pragma unroll
                for (int hf = 0; hf < 2; ++hf) {
                    facc X[2][4];
#pragma unroll
                    for (int et = 0; et < 2; ++et)
#pragma unroll
                        for (int cq = 0; cq < 4; ++cq) X[et][cq] = (facc){0.f, 0.f, 0.f, 0.f};
#pragma unroll
                    for (int ks = 0; ks < 4; ++ks) {
#pragma unroll
                        for (int cq = 0; cq < 4; ++cq) { const int ct = 4 * hf + cq; const bf16x8 qb = *(const LAS bf16x8*)(Ql + (16 * ct + fr) * R_KP + 32 * ks + 8 * g);
#pragma unroll
                            for (int et = 0; et < 2; ++et) X[et][cq] = mma16(sa[ks][et], qb, X[et][cq]); }
                        __builtin_amdgcn_sched_barrier(0);
                    }
#pragma unroll
                    for (int cq = 0; cq < 4; ++cq) { const int ct = 4 * hf + cq, c = 16 * ct + fr; const float dq = dir == 0 ? __expf(lgf * (float)(c + 1)) : __expf(lgb * (float)(128 - c));
#pragma unroll
                        for (int et = 0; et < 2; ++et) acc[et][ct] += X[et][cq] * dq; }
                }
            }
        }
        SUBSTAMP(3);
        unsigned gtv[2][8];
        { const unsigned char* GR8 = WSP(const unsigned char, WS_GR8);
#pragma unroll
        for (int et = 0; et < 2; ++et)
#pragma unroll
            for (int ct = 0; ct < 8; ++ct) gtv[et][ct] = __builtin_nontemporal_load((const unsigned*)(GR8 + (size_t)(row0 + 16 * ct + fr) * 1024 + h * 256 + 32 * w + 16 * et + 4 * g)); }
#pragma unroll
        for (int ct = 0; ct < 8; ++ct) { float s = 0.f, ss = 0.f;
#pragma unroll
            for (int et = 0; et < 2; ++et)
#pragma unroll
                for (int r = 0; r < 4; ++r) { const float v = acc[et][ct][r]; s += v; ss += v * v; }
            s += __shfl_xor(s, 16); s += __shfl_xor(s, 32); ss += __shfl_xor(ss, 16); ss += __shfl_xor(ss, 32);
            if (g == 0) { red[(w * 128 + 16 * ct + fr) * 2] = s; red[(w * 128 + 16 * ct + fr) * 2 + 1] = ss; } }
        __syncthreads();
        if (F.tid < 128) { float s = 0.f, ss = 0.f;
#pragma unroll
            for (int q = 0; q < 8; ++q) { s += red[(q * 128 + F.tid) * 2]; ss += red[(q * 128 + F.tid) * 2 + 1]; }
            const float mean = s * (1.f / 256.f), var = fmaxf(ss * (1.f / 256.f) - mean * mean, 0.f);
            stt[F.tid * 2] = mean; stt[F.tid * 2 + 1] = 1.f / sqrtf(var + GN_EPS); }
        __syncthreads();
        const float* gnw = KIN(I_GNW) + (size_t)l * 1024 + h * 256;
#pragma unroll
        for (int et = 0; et < 2; ++et) { const int e = 32 * w + 16 * et + 4 * g; const f32x4 gw4 = *(const f32x4*)(gnw + e);
#pragma unroll
            for (int ct = 0; ct < 8; ++ct) { const int c = 16 * ct + fr; const float mean = stt[c * 2], rstd = stt[c * 2 + 1];
                const size_t tok = (size_t)(row0 + c);
                const f32x2 ga_ = __builtin_amdgcn_cvt_pk_f32_fp8((int)gtv[et][ct], false), gb_ = __builtin_amdgcn_cvt_pk_f32_fp8((int)gtv[et][ct], true);
                const float g0 = ga_.x * pg8::YS_INV, g1 = ga_.y * pg8::YS_INV, g2 = gb_.x * pg8::YS_INV, g3 = gb_.y * pg8::YS_INV;
                const float y0 = (acc[et][ct][0] - mean) * rstd * gw4[0] * siluf_(g0), y1 = (acc[et][ct][1] - mean) * rstd * gw4[1] * siluf_(g1);
                const float y2 = (acc[et][ct][2] - mean) * rstd * gw4[2] * siluf_(g2), y3 = (acc[et][ct][3] - mean) * rstd * gw4[3] * siluf_(g3);
                *(unsigned*)((unsigned char*)YR + tok * 1024 + h * 256 + e) = pg8::pack_fp8x4(y0 * pg8::YS_SCALE, y1 * pg8::YS_SCALE, y2 * pg8::YS_SCALE, y3 * pg8::YS_SCALE); } }
        SUBSTAMP(4);
    }
    __syncthreads();
}
__device__ __forceinline__ float wave_max_dpp(float v) {
#define DPPF(x, ctrl) __builtin_bit_cast(float, __builtin_amdgcn_update_dpp(0, __builtin_bit_cast(int, (x)), (ctrl), 0xF, 0xF, true))
    v = fmaxf(v, DPPF(v, 0xB1)); v = fmaxf(v, DPPF(v, 0x4E)); v = fmaxf(v, DPPF(v, 0x141)); v = fmaxf(v, DPPF(v, 0x140));
#undef DPPF
    const int x = __builtin_bit_cast(int, v);
    const float r0 = __builtin_bit_cast(float, __builtin_amdgcn_readlane(x, 0)), r1 = __builtin_bit_cast(float, __builtin_amdgcn_readlane(x, 16));
    const float r2 = __builtin_bit_cast(float, __builtin_amdgcn_readlane(x, 32)), r3 = __builtin_bit_cast(float, __builtin_amdgcn_readlane(x, 48));
    return fmaxf(fmaxf(r0, r1), fmaxf(r2, r3));
}
#undef PHG
#define PHG 9
__device__ __forceinline__ void phase_topk(const Frame& F_, int l, int Tm) {
    Frame F = F_; asm volatile("" : "+s"(F.bid), "+s"(F.G), "+s"(F.wave)); F.lane = lane_id_(); asm volatile("" : "+v"(F.lane)); F.tid = F.wave * 64 + F.lane;
    const int lane = F.lane;
    const float* LG = WSP(const float, WS_LOGIT); int* TE = WSP(int, WS_TOPE); float* TW = WSP(float, WS_TOPW); int* TP = WSP(int, WS_TPOS);
    unsigned* cnt = WSP(unsigned, WS_CTL) + CW_CNT + l * 256;
    LAS unsigned* hist = (LAS unsigned*)F.lds;
    if (F.tid < 512) hist[F.tid] = 0u;
    __syncthreads();
    const int per = (Tm + F.G - 1) / F.G, t0 = F.bid * per, t1 = (t0 + per < Tm) ? t0 + per : Tm;
    const f32x4 bias = *(const f32x4*)(KIN(I_ROUTB) + (size_t)l * 256 + 4 * lane);
    const float NEG = -__builtin_inff();
    for (int tb = t0 + F.wave; tb < t1; tb += 2 * NWAVES) {
        int tt[2]; bool ok[2]; f32x4 lg[2];
#pragma unroll
        for (int u = 0; u < 2; ++u) { tt[u] = tb + u * NWAVES; ok[u] = tt[u] < t1; lg[u] = __builtin_nontemporal_load((const f32x4*)(LG + (size_t)(ok[u] ? tt[u] : tb) * 256 + 4 * lane)); }
        float sc[2][4], v[2][4]; int my_e[2]; float my_w[2], wsum[2];
#pragma unroll
        for (int u = 0; u < 2; ++u) {
#pragma unroll
            for (int i = 0; i < 4; ++i) { sc[u][i] = sigmoidf_(lg[u][i]); v[u][i] = sc[u][i] + bias[i]; }
            float m1 = fmaxf(fmaxf(v[u][0], v[u][1]), fmaxf(v[u][2], v[u][3]));
            float m2;
            { const float a = fmaxf(v[u][0], v[u][1]), b = fminf(v[u][0], v[u][1]), c = fmaxf(v[u][2], v[u][3]), d = fminf(v[u][2], v[u][3]); m2 = fmaxf(fminf(a, c), fmaxf(b, d)); }
#pragma unroll
            for (int o = 1; o < 8; o <<= 1) { const float b1 = __shfl_xor(m1, o), b2 = __shfl_xor(m2, o); const float n1 = fmaxf(m1, b1), n2 = fmaxf(fminf(m1, b1), fmaxf(m2, b2)); m1 = n1; m2 = n2; }
            const float gs = m1 + m2; const int grp = lane >> 3; int rank = 0;
#pragma unroll
            for (int j = 0; j < 8; ++j) { const float o = __shfl(gs, j * 8); rank += (o > gs || (o == gs && j < grp)) ? 1 : 0; }
            if (rank >= 4) { v[u][0] = NEG; v[u][1] = NEG; v[u][2] = NEG; v[u][3] = NEG; }
            my_e[u] = 0; my_w[u] = 0.f; wsum[u] = 0.f;
        }
#pragma unroll 1
        for (int k = 0; k < 8; ++k) {
#pragma unroll
            for (int u = 0; u < 2; ++u) {
                float bv = v[u][0]; int bl = 0;
#pragma unroll
                for (int i = 1; i < 4; ++i) if (v[u][i] > bv) { bv = v[u][i]; bl = i; }
                const float wm = wave_max_dpp(bv);
                const unsigned long long hit = __ballot(bv == wm);
                const int own = (int)__builtin_ctzll(hit);
                const int sub = __builtin_amdgcn_readlane(bl, own), bi = own * 4 + sub;
                const float mysc = sub == 0 ? sc[u][0] : (sub == 1 ? sc[u][1] : (sub == 2 ? sc[u][2] : sc[u][3]));
                const float wv = __builtin_bit_cast(float, __builtin_amdgcn_readlane(__builtin_bit_cast(int, mysc), own));
#pragma unroll
                for (int i = 0; i < 4; ++i) v[u][i] = (lane == own && sub == i) ? NEG : v[u][i];
                wsum[u] += wv; if (lane == k) { my_e[u] = bi; my_w[u] = wv; }
            }
        }
#pragma unroll
        for (int u = 0; u < 2; ++u)
            if (ok[u] && lane < 8) {
                TE[(size_t)tt[u] * 8 + lane] = my_e[u]; TW[(size_t)tt[u] * 8 + lane] = my_w[u] / wsum[u] * 2.5f;
                TP[(size_t)tt[u] * 8 + lane] = (int)__hip_atomic_fetch_add(&hist[my_e[u]], 1u, __ATOMIC_RELAXED, __HIP_MEMORY_SCOPE_WORKGROUP);
            }
    }
    __syncthreads();
    if (F.tid < 256) { const unsigned c = hist[F.tid]; hist[256 + F.tid] = c ? __hip_atomic_fetch_add(&cnt[F.tid], c, __ATOMIC_RELAXED, __HIP_MEMORY_SCOPE_AGENT) : 0u; }
    asm volatile("s_waitcnt vmcnt(0)" ::: "memory");
    __syncthreads();
    for (int q = t0 * 8 + F.tid; q < t1 * 8; q += 512) TP[q] += (int)hist[256 + TE[q]];
    __syncthreads();
}
#undef PHG
#define PHG 9
__device__ __forceinline__ void phase_slots(const Frame& F_, int l, int Tm) {
    Frame F = F_; asm volatile("" : "+s"(F.bid), "+s"(F.G), "+s"(F.wave)); F.lane = lane_id_(); asm volatile("" : "+v"(F.lane)); F.tid = F.wave * 64 + F.lane;
    const int gw = F.bid * NWAVES + F.wave, NGW = F.G * NWAVES, lane = F.lane;
    LAS int* tst = (LAS int*)F.lds; LAS int* cn = tst + 260;
    const unsigned* cnt = WSP(const unsigned, WS_CTL) + CW_CNT + l * 256;
    if (F.tid < 256) cn[F.tid] = (int)__hip_atomic_load(&cnt[F.tid], __ATOMIC_RELAXED, __HIP_MEMORY_SCOPE_AGENT);
    __syncthreads();
    if (F.wave == 0) {
        const int a0 = (cn[4 * lane] + 255) >> 8, a1 = (cn[4 * lane + 1] + 255) >> 8, a2 = (cn[4 * lane + 2] + 255) >> 8, a3 = (cn[4 * lane + 3] + 255) >> 8, s = a0 + a1 + a2 + a3;
        int inc = s;
#define SCAN_DPP(ctrl, rmask) inc += __builtin_amdgcn_update_dpp(0, inc, (ctrl), (rmask), 0xF, false)
        SCAN_DPP(0x111, 0xF); SCAN_DPP(0x112, 0xF); SCAN_DPP(0x114, 0xF); SCAN_DPP(0x118, 0xF);
        SCAN_DPP(0x142, 0xA); SCAN_DPP(0x143, 0xC);
#undef SCAN_DPP
        const int run = inc - s;
        tst[4 * lane] = run; tst[4 * lane + 1] = run + a0; tst[4 * lane + 2] = run + a0 + a1; tst[4 * lane + 3] = run + a0 + a1 + a2;
        if (lane == 63) tst[256] = inc;
    }
    __syncthreads();
    const int NT = tst[256];
    int* meta = WSP(int, WS_META); int* tile_e = meta + 64;
    int* ST = WSP(int, WS_STOK); float* SW = WSP(float, WS_SW);
    const int* TE = WSP(const int, WS_TOPE); const float* TW = WSP(const float, WS_TOPW); const int* TP = WSP(const int, WS_TPOS); int* TS = WSP(int, WS_TSLOT);
    if (F.bid == 0) {
        if (F.tid == 0) { meta[0] = NT; meta[1] = NT + Tm / 256; }
        if (F.tid < 256) { const int e = F.tid, n = (cn[e] + 255) >> 8; for (int j = 0; j < n; ++j) tile_e[tst[e] + j] = e; }
        for (int i = F.tid; i < Tm / 256; i += 512) tile_e[NT + i] = 256;
    }
    for (int p = gw * 64 + lane; p < Tm * 8; p += NGW * 64) {
        const int e = TE[p], slot = tst[e] * 256 + TP[p];
        ST[slot] = p >> 3; SW[slot] = TW[p]; TS[p] = slot; }
#pragma unroll 1
    for (int e = gw; e < 256; e += NGW) { const int c = cn[e], n = (c + 255) >> 8;
#pragma unroll 1
        for (int s = c + lane; s < n * 256; s += 64) { ST[tst[e] * 256 + s] = 0; SW[tst[e] * 256 + s] = 0.f; } }
    int gstep = F.G * 512; asm volatile("" : "+s"(gstep));
#pragma unroll 1
    for (int t = F.bid * 512 + F.tid; t < Tm; t += gstep) { ST[NT * 256 + t] = t; SW[NT * 256 + t] = 1.f; }
    __syncthreads();
}
#undef PHG
#define PHG 9
__device__ __forceinline__ void moe_units_setup(const Frame& F_, int npn, const int* rowsrc  ) {
    Frame F = F_; asm volatile("" : "+s"(F.bid), "+s"(F.G), "+s"(F.wave)); F.lane = lane_id_(); asm volatile("" : "+v"(F.lane)); F.tid = F.wave * 64 + F.lane;
    int G_ = F.G; asm volatile("" : "+s"(G_)); F.G = G_;
    const int* meta = WSP(const int, WS_META); const int* tile_e = meta + 64;
    LAS int* ut = (LAS int*)(F.lds + pg8::XT_UT); LAS int* xi = (LAS int*)(F.lds + pg8::XT_XI);
    const int nun = meta[1] * npn;
    __syncthreads();
    const int cperm = (F.G % 8 == 0) ? (F.bid & 7) * (F.G >> 3) + (F.bid >> 3) : F.bid;
#ifdef DOWN_WGMAJOR
#define MOE_L(i) ((npn == 4) ? (((i) >> 2) * F.G + cperm) * 4 + ((i) & 3) : (i) * F.G + cperm)
#else
#define MOE_L(i) ((i) * F.G + cperm)
#endif
    if (F.tid < pg8::XT_MAXU) { const int L = MOE_L(F.tid), ok = L < nun, tile = ok ? L / npn : 0;
        ut[F.tid * 4] = tile; ut[F.tid * 4 + 1] = ok ? L % npn : 0; ut[F.tid * 4 + 2] = ok ? tile_e[tile] : 0; ut[F.tid * 4 + 3] = ok; }
    for (int q = F.tid; q < pg8::XT_MAXU * 256; q += 512) { const int i = q >> 8, r = q & 255, L = MOE_L(i);
        if (L < nun) xi[q] = rowsrc[(L / npn) * 256 + r]; }
    __syncthreads();
}
#undef PHG
#define PHG 10
__device__ __forceinline__ void combine_token(const Frame& F, int l, int t, const u32x2 (&R_)[2][9], const u32x4 (&XW_)[2], const f32x4 (&LW)[2][2], const f32x4 (&LB)[2][2], const f32x4 (&GV)[2][2], const f32x4 (&S1)[2][2], const f32x4 (&H1)[2][2], bf16* X, bf16* H) {
    const int lane = F.lane;
    float v[16]; float s = 0.f;
#pragma unroll
    for (int j = 0; j < 2; ++j) { const int col = j * 512 + lane * 8; float f[8];
#pragma unroll
        for (int q = 0; q < 8; ++q) f[q] = 0.f;
#pragma unroll
        for (int k = 0; k < 9; ++k) { const u32x2 w = R_[j][k];
            const f32x2 a = __builtin_amdgcn_cvt_pk_f32_fp8((int)w.x, false), b = __builtin_amdgcn_cvt_pk_f32_fp8((int)w.x, true), c = __builtin_amdgcn_cvt_pk_f32_fp8((int)w.y, false), d = __builtin_amdgcn_cvt_pk_f32_fp8((int)w.y, true);
            f[0] += a.x; f[1] += a.y; f[2] += b.x; f[3] += b.y; f[4] += c.x; f[5] += c.y; f[6] += d.x; f[7] += d.y; }
#pragma unroll
        for (int q = 0; q < 8; ++q) f[q] *= pg8::YS_INV;
        const u32x4 xw = XW_[j];
        const f32x4 xa = {bflo(xw.x), bfhi(xw.x), bflo(xw.y), bfhi(xw.y)}, xb = {bflo(xw.z), bfhi(xw.z), bflo(xw.w), bfhi(xw.w)};
        const f32x4 ga = GV[j][0], gb = GV[j][1];
#pragma unroll
        for (int q = 0; q < 4; ++q) { v[j * 8 + q] = DN_ALPHA * xa[q] + ga[q] * f[q]; v[j * 8 + 4 + q] = DN_ALPHA * xb[q] + gb[q] * f[4 + q]; }
#pragma unroll
        for (int q = 0; q < 8; ++q) s += v[j * 8 + q]; }
    float mean = wave_sum(s) * (1.f / D), s2 = 0.f;
#pragma unroll
    for (int q = 0; q < 16; ++q) { v[q] -= mean; s2 += v[q] * v[q]; }
    float rstd = 1.f / sqrtf(wave_sum(s2) * (1.f / D) + LN_EPS);
    s = 0.f;
#pragma unroll
    for (int j = 0; j < 2; ++j) { const int col = j * 512 + lane * 8;
        const f32x4 wa = LW[j][0], wb = LW[j][1], ba = LB[j][0], bb = LB[j][1];
#pragma unroll
        for (int q = 0; q < 4; ++q) { v[j * 8 + q] = v[j * 8 + q] * rstd * wa[q] + ba[q]; v[j * 8 + 4 + q] = v[j * 8 + 4 + q] * rstd * wb[q] + bb[q]; }
        if (l == 1) { float* dst = (float*)karg(27) + (size_t)t * D + col;
            __builtin_nontemporal_store((f32x4){v[j * 8], v[j * 8 + 1], v[j * 8 + 2], v[j * 8 + 3]}, (f32x4*)dst); __builtin_nontemporal_store((f32x4){v[j * 8 + 4], v[j * 8 + 5], v[j * 8 + 6], v[j * 8 + 7]}, (f32x4*)(dst + 4)); }
        else { u32x4 w; w.x = pk2(v[j * 8], v[j * 8 + 1]); w.y = pk2(v[j * 8 + 2], v[j * 8 + 3]); w.z = pk2(v[j * 8 + 4], v[j * 8 + 5]); w.w = pk2(v[j * 8 + 6], v[j * 8 + 7]); __builtin_nontemporal_store(w, (u32x4*)(X + (size_t)t * D + col)); }
#pragma unroll
        for (int q = 0; q < 8; ++q) s += v[j * 8 + q]; }
    if (l == 0) {
        mean = wave_sum(s) * (1.f / D); s2 = 0.f;
#pragma unroll
        for (int q = 0; q < 16; ++q) { v[q] -= mean; s2 += v[q] * v[q]; }
        rstd = 1.f / sqrtf(wave_sum(s2) * (1.f / D) + LN_EPS);
#pragma unroll
        for (int j = 0; j < 2; ++j) { const int col = j * 512 + lane * 8;
            const f32x4 sa = S1[j][0], sb = S1[j][1], ha = H1[j][0], hb = H1[j][1];
            float o[8];
#pragma unroll
            for (int q = 0; q < 4; ++q) { o[q] = v[j * 8 + q] * rstd * (1.f + sa[q]) + ha[q]; o[4 + q] = v[j * 8 + 4 + q] * rstd * (1.f + sb[q]) + hb[q]; }
            u32x2 w; w.x = pg8::pack_fp8x4(o[0], o[1], o[2], o[3]); w.y = pg8::pack_fp8x4(o[4], o[5], o[6], o[7]);
            *(u32x2*)((unsigned char*)H + (size_t)t * D + col) = w; }
    }
}
#undef PHG
#define PHG 10
__device__ __forceinline__ void phase_combine(const Frame& F_, int l, int Tm) {
    Frame F = F_; asm volatile("" : "+s"(F.bid), "+s"(F.G), "+s"(F.wave)); F.lane = lane_id_(); asm volatile("" : "+v"(F.lane)); F.tid = F.wave * 64 + F.lane;
    const int gw = F.bid * NWAVES + F.wave, NGW = F.G * NWAVES, lane = F.lane;
    const int* meta = WSP(const int, WS_META); const int NT = meta[0];
    const int* TS = WSP(const int, WS_TSLOT); const unsigned char* YS = WSP(const unsigned char, WS_YSLOT); bf16* X = WSP(bf16, WS_X); bf16* H = (bf16*)WSP(unsigned char, WS_H8);
    const float* lw = KIN(I_LNFW) + (size_t)l * D; const float* lb = KIN(I_LNFB) + (size_t)l * D;
#define CB_SLOT(t_) ((lane < 8 && (t_) < Tm) ? TS[(size_t)(t_) * 8 + lane] : 0)
#define CB_LOAD(R_, XW_, sl_, t_) do { int slots_[9]; _Pragma("unroll") for (int k = 0; k < 8; ++k) slots_[k] = __shfl(sl_, k); slots_[8] = NT * 256 + (t_); \
        _Pragma("unroll") for (int j = 0; j < 2; ++j) { const int col = j * 512 + lane * 8; \
            _Pragma("unroll") for (int k = 0; k < 9; ++k) R_[j][k] = __builtin_nontemporal_load((const u32x2*)(YS + (size_t)slots_[k] * 1024 + col)); \
            XW_[j] = __builtin_nontemporal_load((const u32x4*)(X + (size_t)(t_) * D + col)); } } while (0)
    const int per = (Tm + NGW - 1) / NGW, tA = gw * per, tB = (tA + per < Tm) ? tA + per : Tm;
    f32x4 LW[2][2], LB[2][2], GV[2][2], S1[2][2], H1[2][2];
#pragma unroll
    for (int j = 0; j < 2; ++j) { const int col = j * 512 + lane * 8; LW[j][0] = *(const f32x4*)(lw + col); LW[j][1] = *(const f32x4*)(lw + col + 4); LB[j][0] = *(const f32x4*)(lb + col); LB[j][1] = *(const f32x4*)(lb + col + 4);
        GV[j][0] = GV[j][1] = S1[j][0] = S1[j][1] = H1[j][0] = H1[j][1] = (f32x4){0.f, 0.f, 0.f, 0.f}; }
    int curv = -1;
    u32x2 ra[2][9]; u32x4 xa_[2];
    int sl = CB_SLOT(tA);
#pragma unroll 1
    for (int t = tA; t < tB; ++t) {
        const int sln = CB_SLOT(t + 1);
        CB_LOAD(ra, xa_, sl, t);
        const int vv = t >= T_LAT ? 8 : t / NSEQ;
        if (vv != curv) { curv = vv; const float* mv = mod_vec(F, l, t); const float* m1 = mod_vec(F, 1, t);
#pragma unroll
            for (int j = 0; j < 2; ++j) { const int col = j * 512 + lane * 8; GV[j][0] = *(const f32x4*)(mv + 5120 + col); GV[j][1] = *(const f32x4*)(mv + 5120 + col + 4);
                if (l == 0) { S1[j][0] = *(const f32x4*)(m1 + 1024 + col); S1[j][1] = *(const f32x4*)(m1 + 1024 + col + 4); H1[j][0] = *(const f32x4*)(m1 + col); H1[j][1] = *(const f32x4*)(m1 + col + 4); } } }
        combine_token(F, l, t, ra, xa_, LW, LB, GV, S1, H1, X, H);
        sl = sln;
    }
#undef CB_SLOT
#undef CB_LOAD
}
#ifndef MK_PER_PHASE
#define MK_PER_PHASE 0
#endif
#ifndef TSAMP
#define TSAMP 8ull
#endif
#ifndef NPREP
#define NPREP 0
#endif
#ifndef ALIGN_BIG
#define ALIGN_BIG true
#endif
#ifndef SKEW_BIG
#define SKEW_BIG 0
#endif
#ifndef PREP_LATE_PER
#define PREP_LATE_PER 4
#endif
#ifndef PREP_FILL_PER
#define PREP_FILL_PER 2
#endif
#ifndef SKEW_DOWN
#define SKEW_DOWN 0
#endif
constexpr int NPL = 15, NPHASE = 1 + 2 * NPL;
#undef PHG
#define PHG 0
struct Args { const float* in[27]; float* out; unsigned char* ws; int ph_lo, ph_hi; };
static_assert(sizeof(Args) == 29 * 8 + 8, "Args has no padding");

__global__ void __launch_bounds__(NWAVES * 64, 2) mk_fwd(Args args) {
    extern __shared__ __attribute__((aligned(16))) unsigned char lds_raw[];
    Frame F;
    F.lds = (LAS unsigned char*)lds_raw;
    F.wave = __builtin_amdgcn_readfirstlane((int)threadIdx.x >> 6); F.lane = lane_id_(); F.tid = F.wave * 64 + F.lane; F.G = gridDim.x; F.bid = blockIdx.x;
    F.ws = args.ws;
    volatile LAS unsigned* MISC = (volatile LAS unsigned*)(F.lds + MISC_OFF);
    { const int t_ = F.wave * 64 + lane_id_(); if (t_ < 128) MISC[t_] = 0u; }
    __syncthreads();
    unsigned* ctl = (unsigned*)(F.ws + WS_CTL);
    if (!MK_PER_PHASE) (void)xcd_barrier_post(ctl + CW_BAR, MISC, F.wave);
#ifdef EXP_BAR2
#define EXP_BAR_EXTRA xcd_barrier(b_, F.wave); xcd_barrier(b_, F.wave);
#else
#define EXP_BAR_EXTRA
#endif
#ifndef PHMASK
#define PHMASK 0xFFFFFFFFu
#endif
#define PHON(k) ((PHMASK >> ((k) == 0 ? 0 : (((k) - 1) % NPL) + 1)) & 1u)
#define IN(k) (PHON(k) && karg_int(29 * 8) <= (k) && (k) < karg_int(29 * 8 + 4))
#ifndef DUPMASK
#define DUPMASK 0u
#endif
#define REPS(k) (((DUPMASK >> ((k) == 0 ? 0 : (((k) - 1) % NPL) + 1)) & 1u) ? 2 : 1)
#ifdef TSMASK
#define STAMP(i) do { if (F.bid == 0 && F.wave == 0 && lane_id_() == 0) ((volatile LAS unsigned long long*)(F.lds + MISC_OFF + 16))[i] = wall_clock64(); } while (0)
#else
#define STAMP(i) do { } while (0)
#endif
#define SEAM(k) do { if (IN(k) && IN((k) + 1)) { XcdBarrier b_; unsigned long long bp_ = (unsigned long long)(F.ws + WS_CTL) + CW_BAR * 4; asm volatile("" : "+s"(bp_));   \
        b_.bar = ((GMASK >> 11) & 1u) ? (unsigned*)(__attribute__((address_space(1))) unsigned*)bp_ : (unsigned*)bp_; b_.x = xb_xcc_id(); b_.st = (volatile LAS unsigned*)(F.lds + MISC_OFF); xcd_barrier(b_, F.wave); EXP_BAR_EXTRA }  STAMP((k) + 1); } while (0)
    LAS unsigned char* ring = F.lds;
    STAMP(0);

    if (IN(0)) _Pragma("unroll") for (int rep_ = 0; rep_ < REPS(0); ++rep_) { phase_init(F); } SEAM(0);

#pragma unroll 1
    for (int l = 0; l < 2; ++l) {
        const int pb = 1 + l * NPL;
        const int Mrows = (l == 0) ? T_ALL : T_LAT;
        unsigned char* wne = ws_opaque(F.ws) + WS_WNE + (size_t)l * WNE_STRIDE;
        const int rt_idle = F.G - Mrows / 256;
        const int late9 = rt_idle > 0 ? rt_idle * NWAVES * PREP_LATE_PER : 0;
        const int ex4 = ((Mrows / 256) * 4) % F.G;
        const int idle7 = (ex4 > 0) ? F.G - ex4 : 0, idle5 = (ex4 > 0 && 2 * ex4 < F.G) ? F.G - 2 * ex4 : 0;
        const int late7 = idle7 * NWAVES * PREP_FILL_PER, late5 = idle5 * NWAVES * PREP_FILL_PER;
        const int prep_late = late9 + late7 + late5, NI = 257 * 96;
        if (IN(pb + 0)) { if (l == 0) phase_h0(F); } if (l == 0) SEAM(pb + 0); else STAMP(pb + 1);
        if (IN(pb + 1)) _Pragma("unroll") for (int rep_ = 0; rep_ < REPS(pb + 1); ++rep_) {
            const int ng = (NPREP > 0 && F.G > 4 * NPREP) ? F.G - NPREP : F.G;
            if (F.bid < ng) {
                pg8::ProbDense S{nullptr, 512  , WSP(const bf16, WS_H8), (const bf16*)(wne + WNE_WIN), T_ALL / 256, INW / 256, ng, F.bid, 0, WIN_LD / 2};
                pg8::EpiInproj E{WSP(bf16, WS_P), WSP(unsigned char, WS_G8), WSP(unsigned char, WS_GR8), 1.f / WGU_SCALE};
                pg8::gemm_phase<pg8::ProbDense, pg8::EpiInproj, ALIGN_BIG, SKEW_BIG, 8, true>(ring, S, E, F.wave);
            }
            if (ng == F.G) phase_expert_prep(F, l, F.bid, F.G, 0, 257 * 96 - prep_late); else if (F.bid >= ng) phase_expert_prep(F, l, F.bid - ng, F.G - ng, 0, 257 * 96 - prep_late);
#ifdef DUP_PREP
            phase_expert_prep(F, l, F.bid, F.G, 0, 257 * 96 - prep_late);
#endif
            if (REPS(pb + 1) > 1) __syncthreads();
        } SEAM(pb + 1);
        if (IN(pb + 2)) _Pragma("unroll") for (int rep_ = 0; rep_ < REPS(pb + 2); ++rep_) {
#ifndef NO_R1
            phase_r1(F, l);
#ifdef DUP_R1
            phase_r1(F, l);
#endif
#endif
#ifndef NO_UT
            phase_ut(F, l); __syncthreads();
#ifdef DUP_UT
            phase_ut(F, l); __syncthreads();
#endif
#endif

        } SEAM(pb + 2);
        if (IN(pb + 3)) _Pragma("unroll") for (int rep_ = 0; rep_ < REPS(pb + 3); ++rep_) {
            phase_nyquist(F);
            phase_na(F, l);
#ifdef DUP_NA
            phase_na(F, l);
#endif
            phase_r2(F, l);
#ifdef DUP_R2
            phase_r2(F, l);
#endif
#ifdef DUP_NYQ
            phase_nyquist(F);
#endif
            { pg8::ProbBatched S{nullptr, 2048  , WSP(const bf16, WS_DFT), WSP(const bf16, WS_UT), (size_t)512 * 2048  , 16, 2, NB, F.G, F.bid};
              pg8::EpiFourier E{WSP(unsigned char, WS_FF), 0, NSEQ, 8, 1, 16.f / (64.f * 724.0773439350247f)};
              pg8::gemm_phase<pg8::ProbBatched, pg8::EpiFourier, true, 0, -1, true>(ring, S, E, F.wave); }
            if (l == 0) {
              pg8::ProbBatched S{nullptr, 256, WSP(const bf16, WS_DFTC), WSP(const bf16, WS_UTC), (size_t)512 * 256, 2, 2, NB, F.G, F.bid};
              pg8::EpiFourier E{WSP(unsigned char, WS_FF), T_LAT, NCTX, 1, 0, 16.f};
              pg8::gemm_phase<pg8::ProbBatched, pg8::EpiFourier>(ring, S, E, F.wave); }
        } SEAM(pb + 3);
        if (IN(pb + 4)) _Pragma("unroll") for (int rep_ = 0; rep_ < REPS(pb + 4); ++rep_) { phase_r3(F, l);
            { const int nx = (NB * 4 * (l == 0 ? NCH : 32)) % F.G, g2 = F.G - nx, c2 = F.bid - nx;
              if (c2 >= 0) { pg8::ProbDense S{nullptr, 256  , WSP(const bf16, WS_YNA), (const bf16*)(wne + WNE_ONA), Mrows / 256, 4, g2, c2};
                pg8::EpiFp8Plain E{WSP(unsigned char, WS_ZNA), 1024, 1.f / WGU_SCALE};
                pg8::gemm_phase<pg8::ProbDense, pg8::EpiFp8Plain, true, 0, -1, true>(ring, S, E, F.wave); } }
        } SEAM(pb + 4);
        if (IN(pb + 5)) _Pragma("unroll") for (int rep_ = 0; rep_ < REPS(pb + 5); ++rep_) {
            { pg8::ProbDense S{nullptr, 512, WSP(const bf16, WS_FF), (const bf16*)(wne + WNE_WF), Mrows / 256, 4, F.G, F.bid};
              pg8::EpiFp8Plain E{WSP(unsigned char, WS_ZFF), 1024, 1.f / WGU_SCALE};
              pg8::gemm_phase<pg8::ProbDense, pg8::EpiFp8Plain, true, 0, -1, true>(ring, S, E, F.wave); }
            { pg8::ProbDense S{nullptr, 512, WSP(const bf16, WS_YRET), (const bf16*)(wne + WNE_ORET), Mrows / 256, 4, F.G, (F.bid + F.G - ex4) % F.G};
              pg8::EpiFp8Plain E{WSP(unsigned char, WS_ZRET), 1024, 1.f / WGU_SCALE};
              pg8::gemm_phase<pg8::ProbDense, pg8::EpiFp8Plain, true, 0, -1, true>(ring, S, E, F.wave); }
            if (late5 > 0 && F.bid >= 2 * ex4) phase_expert_prep(F, l, F.bid - 2 * ex4, idle5, NI - prep_late, NI - prep_late + late5);
        } SEAM(pb + 5);
        if (IN(pb + 6)) _Pragma("unroll") for (int rep_ = 0; rep_ < REPS(pb + 6); ++rep_) { phase_gatesum(F, Mrows); } SEAM(pb + 6);
        if (IN(pb + 7)) _Pragma("unroll") for (int rep_ = 0; rep_ < REPS(pb + 7); ++rep_) {
            pg8::ProbDense S{nullptr, 512, WSP(const bf16, WS_YSUMB), (const bf16*)(wne + WNE_WOUT), Mrows / 256, 4, F.G, F.bid};
            pg8::EpiFp8Plain E{WSP(unsigned char, WS_YOUT), 1024, 1.f / WGU_SCALE};
            pg8::gemm_phase<pg8::ProbDense, pg8::EpiFp8Plain, true, 0, -1, true>(ring, S, E, F.wave);
            if (late7 > 0 && F.bid >= ex4) phase_expert_prep(F, l, F.bid - ex4, idle7, NI - late9 - late7, NI - late9);
        } SEAM(pb + 7);
        if (IN(pb + 8)) _Pragma("unroll") for (int rep_ = 0; rep_ < REPS(pb + 8); ++rep_) { phase_ln_mix(F, l, Mrows); } SEAM(pb + 8);
        if (IN(pb + 9)) _Pragma("unroll") for (int rep_ = 0; rep_ < REPS(pb + 9); ++rep_) {
            pg8::ProbDense S{nullptr, 1024, WSP(const bf16, WS_H), (const bf16*)(wne + WNE_ROUT), Mrows / 256, 1, F.G, F.bid};
            pg8::EpiF32 E{WSP(float, WS_LOGIT), 256};
            pg8::gemm_phase<pg8::ProbDense, pg8::EpiF32>(ring, S, E, F.wave);
            if (late9 > 0 && F.bid >= Mrows / 256) phase_expert_prep(F, l, F.bid - Mrows / 256, rt_idle, NI - late9, NI);
        } SEAM(pb + 9);
        if (IN(pb + 10)) _Pragma("unroll") for (int rep_ = 0; rep_ < REPS(pb + 10); ++rep_) { phase_topk(F, l, Mrows); } SEAM(pb + 10);
        if (IN(pb + 11)) _Pragma("unroll") for (int rep_ = 0; rep_ < REPS(pb + 11); ++rep_) { phase_slots(F, l, Mrows); } SEAM(pb + 11);
        if (IN(pb + 12)) _Pragma("unroll") for (int rep_ = 0; rep_ < REPS(pb + 12); ++rep_) {
            moe_units_setup(F, 2, WSP(const int, WS_STOK));
            pg8::ProbGU S{(const LAS int*)(F.lds + pg8::XT_XI), 512  , WSP(const bf16, WS_H8), WSP(const bf16, WS_WGU), (const LAS int*)(F.lds + pg8::XT_UT)};
            pg8::EpiSwiglu E{WSP(unsigned char, WS_ACT), 1.f / WGU_SCALE};
            pg8::gemm_phase<pg8::ProbGU, pg8::EpiSwiglu, ALIGN_BIG, SKEW_BIG, -1, true>(ring, S, E, F.wave);
        } SEAM(pb + 12);
        if (IN(pb + 13)) _Pragma("unroll") for (int rep_ = 0; rep_ < REPS(pb + 13); ++rep_) {
            moe_units_setup(F, 4, WSP(const int, WS_SW));
            pg8::ProbDown S{nullptr, 128  , WSP(const bf16, WS_ACT), WSP(const bf16, WS_WD), (const LAS int*)(F.lds + pg8::XT_UT)};
            pg8::EpiDown E{WSP(unsigned char, WS_YSLOT), (const LAS float*)(F.lds + pg8::XT_XI), 16.f / (16.f * WGU_SCALE)};
            pg8::gemm_phase<pg8::ProbDown, pg8::EpiDown, ALIGN_BIG, SKEW_DOWN, 10, true>(ring, S, E, F.wave);
        } SEAM(pb + 13);
        if (IN(pb + 14)) _Pragma("unroll") for (int rep_ = 0; rep_ < REPS(pb + 14); ++rep_) { phase_combine(F, l, Mrows); } SEAM(pb + 14);
    }
#ifdef SUBSEL
    if (F.bid == 0 && F.wave == 0 && lane_id_() == 0) {
        volatile LAS unsigned* sb = (volatile LAS unsigned*)(F.lds + MISC_OFF + 288);
        float tot = 0.f; for (int k = SUBLO; k <= SUBHI; ++k) tot += (float)sb[k];
        unsigned code = 0, mul = 1;
        for (int k = 0; k < 3; ++k) { int d = tot > 0.f ? (int)((float)sb[SUBSEL + k] * 15.f / tot + 0.5f) : 0; d = d > 15 ? 15 : d; code += (unsigned)d * mul; mul *= 16u; }
        const unsigned long long t0 = wall_clock64(), dt = (unsigned long long)code * 4000ull;
        while (wall_clock64() - t0 < dt) __builtin_amdgcn_s_sleep(32);
    }
#endif
#ifdef TSMASK
    if (F.bid == 0 && F.wave == 0 && lane_id_() == 0) {
        volatile LAS unsigned long long* ts = (volatile LAS unsigned long long*)(F.lds + MISC_OFF + 16);
        unsigned long long sel = 0;
        for (int k = 0; k < NPHASE; ++k) { const int slot = k == 0 ? 0 : ((k - 1) % NPL) + 1; if ((TSMASK >> slot) & 1u) sel += ts[k + 1] - ts[k]; }
        const unsigned long long t0 = wall_clock64(), dt = sel * TSAMP;
        while (wall_clock64() - t0 < dt) __builtin_amdgcn_s_sleep(32);
    }
#endif
#undef IN
#undef SEAM
}

extern "C" void kernel_launch(void* const* d_in, const int* in_sizes, int n_in, void* d_out, int out_size, void* d_ws, size_t ws_size, hipStream_t stream) {
    static int grid = 0;
    if (grid == 0) {
        if (n_in != 27 || out_size != T_LAT * D || ws_size < WS_END) { fprintf(stderr, "kernel_launch: unexpected problem (n_in %d out %d ws %zu)\n", n_in, out_size, ws_size); grid = -1; return; }
        int dev = 0, cus = 0;
        if (hipGetDevice(&dev) != hipSuccess || hipDeviceGetAttribute(&cus, hipDeviceAttributeMultiprocessorCount, dev) != hipSuccess) { grid = -1; return; }
        if (hipFuncSetAttribute((const void*)mk_fwd, hipFuncAttributeMaxDynamicSharedMemorySize, LDS_BYTES) != hipSuccess) { fprintf(stderr, "kernel_launch: hipFuncSetAttribute failed\n"); grid = -1; return; }
        int per_cu = 0;
        if (hipOccupancyMaxActiveBlocksPerMultiprocessor(&per_cu, (const void*)mk_fwd, NWAVES * 64, LDS_BYTES) != hipSuccess || per_cu < 1) fprintf(stderr, "kernel_launch: occupancy query reports %d\n", per_cu);
        (void)hipGetLastError();
        grid = cus;
    }
    if (grid < 0) return;
    if (hipMemsetAsync((char*)d_ws + WS_CTL, 0, CTL_BYTES, stream) != hipSuccess) return;
    Args a{};
    for (int i = 0; i < 27; ++i) a.in[i] = (const float*)d_in[i];
    a.out = (float*)d_out; a.ws = (unsigned char*)d_ws;
#if MK_PER_PHASE
    for (int p = 0; p < NPHASE; ++p) { a.ph_lo = p; a.ph_hi = p + 1; hipLaunchKernelGGL(mk_fwd, dim3(grid), dim3(NWAVES * 64), LDS_BYTES, stream, a); }
#else
    a.ph_lo = 0; a.ph_hi = NPHASE;
    hipLaunchKernelGGL(mk_fwd, dim3(grid), dim3(NWAVES * 64), LDS_BYTES, stream, a);
#endif
}
```
